# Optimizing an MI355X kernel written in HIP

```python
import math
import jax, jax.numpy as jnp
from jax import lax
import numpy as np

D_MODEL = 1024
BATCH = 8
SEQ = 2048
DEPTH = 4
DEC_BATCH = 128
DEC_SEQ = 4
PAST_LEN = 16384
PAGE_SIZE = 128

D_PLE = 256
D_FF = 2048
S5_WIDTH = 512
S5_GROUP = 16
S5_GROUPS = S5_WIDTH // S5_GROUP
S5_STATE = 64
MLSTM_WIDTH = 1024
MLSTM_HEADS = 4
MLSTM_HEAD_DIM = MLSTM_WIDTH // MLSTM_HEADS
MLSTM_CHUNK = 128
CONV_WIDTH = 4
N_BRANCHES = 2
IN_COLS = S5_WIDTH + 4 * MLSTM_WIDTH + 2 * MLSTM_HEADS + N_BRANCHES * D_MODEL
EPS = 1e-6

kernel_name = 'hybrid_s5_mlstm_macaron_step'


def _rmsnorm(x, g):
    xf = x.astype(jnp.float32)
    y = xf * lax.rsqrt(jnp.mean(xf * xf, axis=-1, keepdims=True) + EPS) * g.astype(jnp.float32)
    return y.astype(x.dtype)


def _swiglu(x, w_gate, w_up, w_down):
    return (jax.nn.silu(x @ w_gate) * (x @ w_up)) @ w_down


def _combine(a, b):
    ar, ai, br, bi = a
    cr, ci, dr, di = b
    return (cr * ar - ci * ai, cr * ai + ci * ar, cr * br - ci * bi + dr, cr * bi + ci * br + di)


def _s5(u, h0_re, h0_im, lam_re, lam_im, log_dt, b_re, b_im, c_re, c_im, d_skip):
    f32 = jnp.float32
    Bsz, S, _ = u.shape
    uf = u.astype(f32).reshape(Bsz, S, S5_GROUPS, S5_GROUP)
    lre = lam_re.astype(f32)
    lim = lam_im.astype(f32)
    dt = jnp.exp(log_dt.astype(f32))[:, None]
    mag = jnp.exp(lre * dt)
    abar_re = mag * jnp.cos(lim * dt)
    abar_im = mag * jnp.sin(lim * dt)
    den = lre * lre + lim * lim
    pr = abar_re - 1.0
    w_re = (pr * lre + abar_im * lim) / den
    w_im = (abar_im * lre - pr * lim) / den
    br_ = b_re.astype(f32)
    bi_ = b_im.astype(f32)
    bb_re = w_re[..., None] * br_ - w_im[..., None] * bi_
    bb_im = w_re[..., None] * bi_ + w_im[..., None] * br_
    bu_re = jnp.einsum('bsgh,gnh->bsgn', uf, bb_re)
    bu_im = jnp.einsum('bsgh,gnh->bsgn', uf, bb_im)
    h0r = h0_re.astype(f32)
    h0i = h0_im.astype(f32)
    bu_re = bu_re.at[:, 0].add(abar_re * h0r - abar_im * h0i)
    bu_im = bu_im.at[:, 0].add(abar_re * h0i + abar_im * h0r)
    ar = jnp.broadcast_to(abar_re, bu_re.shape)
    ai = jnp.broadcast_to(abar_im, bu_re.shape)
    _, _, hr, hi = lax.associative_scan(_combine, (ar, ai, bu_re, bu_im), axis=1)
    y = (jnp.einsum('bsgn,ghn->bsgh', hr, c_re.astype(f32))
         - jnp.einsum('bsgn,ghn->bsgh', hi, c_im.astype(f32))
         + d_skip.astype(f32).reshape(S5_GROUPS, S5_GROUP) * uf)
    return y.reshape(Bsz, S, S5_WIDTH), hr[:, -1], hi[:, -1]


def _causal_conv(x_raw, buf, w, b):
    S = x_raw.shape[1]
    xp = jnp.concatenate([buf.astype(x_raw.dtype), x_raw], axis=1)
    out = b.astype(x_raw.dtype)
    for j in range(CONV_WIDTH):
        out = out + xp[:, j:j + S] * w[j].astype(x_raw.dtype)
    return out, xp[:, S:]


def _mlstm(q, k, v, log_i, log_f, c0, n0, m0):
    Bsz, S, H, DH = q.shape
    L = math.gcd(S, MLSTM_CHUNK)
    NC = S // L

    def chunks(t):
        t = t.reshape((Bsz, NC, L) + t.shape[2:])
        return jnp.moveaxis(jnp.moveaxis(t, 1, 0), 3, 2)

    tril = jnp.tril(jnp.ones((L, L), dtype=bool))

    def step(carry, inp):
        C, n, m = carry
        qc, kc, vc, li, lf = inp
        b = jnp.cumsum(lf, axis=-1)
        dmat = b[..., :, None] - b[..., None, :] + li[..., None, :]
        dmat = jnp.where(tril, dmat, -jnp.inf)
        inter = b + m[..., None]
        m_t = jnp.maximum(inter, jnp.max(dmat, axis=-1))
        w = jnp.exp(dmat - m_t[..., None])
        scores = jnp.einsum('bhtd,bhsd->bhts', qc, kc) * w
        a = jnp.exp(inter - m_t)
        num = (jnp.einsum('bhts,bhsd->bhtd', scores, vc)
               + a[..., None] * jnp.einsum('bhtk,bhkv->bhtv', qc, C))
        nq = jnp.sum(scores, axis=-1) + a * jnp.einsum('bhtk,bhk->bht', qc, n)
        h = num / jnp.maximum(jnp.abs(nq), jnp.exp(-m_t))[..., None]
        b_last = b[..., -1]
        g = b_last[..., None] - b + li
        m_new = jnp.maximum(b_last + m, jnp.max(g, axis=-1))
        wk = jnp.exp(g - m_new[..., None])
        decay = jnp.exp(b_last + m - m_new)
        C_new = decay[..., None, None] * C + jnp.einsum('bhs,bhsk,bhsv->bhkv', wk, kc, vc)
        n_new = decay[..., None] * n + jnp.einsum('bhs,bhsk->bhk', wk, kc)
        return (C_new, n_new, m_new), h

    carry0 = (c0.astype(jnp.float32), n0.astype(jnp.float32), m0.astype(jnp.float32))
    (C, n, m), hs = lax.scan(step, carry0, (chunks(q), chunks(k), chunks(v), chunks(log_i), chunks(log_f)))
    h = jnp.transpose(hs, (1, 0, 3, 2, 4)).reshape(Bsz, S, H, DH)
    return h, C, n, m


def _mixer(h, s5_re0, s5_im0, c0, n0, m0, conv0, lw):
    f32 = jnp.float32
    Bsz, S, _ = h.shape
    sizes = (S5_WIDTH, 2 * MLSTM_WIDTH, MLSTM_WIDTH, MLSTM_WIDTH, MLSTM_HEADS, MLSTM_HEADS, D_MODEL, D_MODEL)
    cuts = [int(c) for c in np.cumsum(sizes)[:-1]]
    u, qk_raw, v, o, ig, fg, gate_s5, gate_m = jnp.split(h @ lw['w_in'], cuts, axis=-1)
    y_s5, s5_re, s5_im = _s5(u, s5_re0, s5_im0, lw['s5_lambda_re'], lw['s5_lambda_im'], lw['s5_log_dt'],
                             lw['s5_b_re'], lw['s5_b_im'], lw['s5_c_re'], lw['s5_c_im'], lw['s5_d'])
    y_s5 = jax.nn.gelu(y_s5.astype(h.dtype))
    y_s5 = y_s5 * jax.nn.sigmoid(y_s5 @ lw['s5_w_glu'])
    qk, conv_new = _causal_conv(qk_raw, conv0, lw['conv_w'], lw['conv_b'])
    q, k = jnp.split(jax.nn.silu(qk), 2, axis=-1)
    shp = (Bsz, S, MLSTM_HEADS, MLSTM_HEAD_DIM)
    q = q.reshape(shp).astype(f32) * (MLSTM_HEAD_DIM ** -0.5)
    k = k.reshape(shp).astype(f32)
    v = v.reshape(shp).astype(f32)
    log_i = ig.astype(f32) + lw['b_igate'].astype(f32)
    log_f = jax.nn.log_sigmoid(fg.astype(f32) + lw['b_fgate'].astype(f32))
    hm, c_new, n_new, m_new = _mlstm(q, k, v, log_i, log_f, c0, n0, m0)
    hm = hm * lax.rsqrt(jnp.mean(hm * hm, axis=-1, keepdims=True) + EPS)
    hm = (hm.reshape(Bsz, S, MLSTM_WIDTH) * lw['g_mhead'].astype(f32)).astype(h.dtype) * jax.nn.sigmoid(o)
    merged = (jax.nn.sigmoid(gate_s5) * (y_s5 @ lw['w_s5_up'])
              + jax.nn.sigmoid(gate_m) * (hm @ lw['w_m_up']))
    return merged @ lw['w_out'], (s5_re, s5_im, c_new, n_new, m_new, conv_new)


def _layer(x, p, s5_re0, s5_im0, c0, n0, m0, conv0, lw):
    x = x + 0.5 * _swiglu(_rmsnorm(x, lw['g_ffn1']), lw['w1_gate'], lw['w1_up'], lw['w1_down'])
    mix, new_state = _mixer(_rmsnorm(x, lw['g_mix']), s5_re0, s5_im0, c0, n0, m0, conv0, lw)
    x = x + mix
    x = x + 0.5 * _swiglu(_rmsnorm(x, lw['g_ffn2']), lw['w2_gate'], lw['w2_up'], lw['w2_down'])
    gate = jax.nn.sigmoid(_rmsnorm(x, lw['g_ple']) @ lw['w_ple_gate'])
    x = x + (p.astype(x.dtype) @ lw['w_ple']) * gate
    return x, new_state


def setup_inputs(seed: int = 0) -> dict:
    key = jax.random.key(seed)
    ks = jax.random.split(key, 48)
    keys = [ks[i] for i in range(48)]

    def nk():
        return keys.pop(0)

    def nrm(shape, scale=1.0):
        return jax.random.normal(nk(), shape, jnp.float32) * scale

    def gain(shape):
        return 1.0 + nrm(shape, 0.02)

    L = DEPTH
    G, N = S5_GROUPS, S5_STATE
    H, DH = MLSTM_HEADS, MLSTM_HEAD_DIM
    n_idx = jnp.arange(N, dtype=jnp.float32)
    return {
        'x_prompt': nrm((BATCH, SEQ, D_MODEL)),
        'x_sample': nrm((DEC_BATCH, DEC_SEQ, D_MODEL)),
        'state_s5_re': nrm((L, DEC_BATCH, G, N), 0.1),
        'state_s5_im': nrm((L, DEC_BATCH, G, N), 0.1),
        'state_mlstm_c': nrm((L, DEC_BATCH, H, DH, DH), 0.1),
        'state_mlstm_n': nrm((L, DEC_BATCH, H, DH), 0.5),
        'state_mlstm_m': nrm((L, DEC_BATCH, H), 1.0),
        'state_conv': nrm((L, DEC_BATCH, CONV_WIDTH - 1, 2 * MLSTM_WIDTH)),
        'p_prompt': nrm((L, BATCH, SEQ, D_PLE)),
        'p_sample': nrm((L, DEC_BATCH, DEC_SEQ, D_PLE)),
        'g_ffn1': gain((L, D_MODEL)),
        'w1_gate': nrm((L, D_MODEL, D_FF), D_MODEL ** -0.5),
        'w1_up': nrm((L, D_MODEL, D_FF), D_MODEL ** -0.5),
        'w1_down': nrm((L, D_FF, D_MODEL), D_FF ** -0.5),
        'g_mix': gain((L, D_MODEL)),
        'w_in': nrm((L, D_MODEL, IN_COLS), D_MODEL ** -0.5),
        's5_lambda_re': -0.5 + nrm((L, G, N), 0.01),
        's5_lambda_im': math.pi * n_idx + nrm((L, G, N), 0.01),
        's5_log_dt': jax.random.uniform(nk(), (L, G), jnp.float32, math.log(1e-3), math.log(1e-1)),
        's5_b_re': nrm((L, G, N, S5_GROUP), S5_GROUP ** -0.5),
        's5_b_im': nrm((L, G, N, S5_GROUP), S5_GROUP ** -0.5),
        's5_c_re': nrm((L, G, S5_GROUP, N), N ** -0.5),
        's5_c_im': nrm((L, G, S5_GROUP, N), N ** -0.5),
        's5_d': nrm((L, S5_WIDTH)),
        's5_w_glu': nrm((L, S5_WIDTH, S5_WIDTH), S5_WIDTH ** -0.5),
        'w_s5_up': nrm((L, S5_WIDTH, D_MODEL), S5_WIDTH ** -0.5),
        'conv_w': nrm((L, CONV_WIDTH, 2 * MLSTM_WIDTH), CONV_WIDTH ** -0.5),
        'conv_b': nrm((L, 2 * MLSTM_WIDTH), 0.02),
        'b_igate': nrm((L, H), 0.1),
        'b_fgate': jax.random.uniform(nk(), (L, H), jnp.float32, 3.0, 6.0),
        'g_mhead': gain((L, MLSTM_WIDTH)),
        'w_m_up': nrm((L, MLSTM_WIDTH, D_MODEL), MLSTM_WIDTH ** -0.5),
        'w_out': nrm((L, D_MODEL, D_MODEL), D_MODEL ** -0.5),
        'g_ffn2': gain((L, D_MODEL)),
        'w2_gate': nrm((L, D_MODEL, D_FF), D_MODEL ** -0.5),
        'w2_up': nrm((L, D_MODEL, D_FF), D_MODEL ** -0.5),
        'w2_down': nrm((L, D_FF, D_MODEL), D_FF ** -0.5),
        'g_ple': gain((L, D_MODEL)),
        'w_ple': nrm((L, D_PLE, D_MODEL), D_PLE ** -0.5),
        'w_ple_gate': nrm((L, D_MODEL, D_MODEL), D_MODEL ** -0.5),
        'g_final': gain((D_MODEL,)),
    }


def reference(x_prompt, x_sample, state_s5_re, state_s5_im, state_mlstm_c, state_mlstm_n, state_mlstm_m,
              state_conv, p_prompt, p_sample, g_ffn1, w1_gate, w1_up, w1_down, g_mix, w_in,
              s5_lambda_re, s5_lambda_im, s5_log_dt, s5_b_re, s5_b_im, s5_c_re, s5_c_im, s5_d, s5_w_glu,
              w_s5_up, conv_w, conv_b, b_igate, b_fgate, g_mhead, w_m_up, w_out, g_ffn2, w2_gate, w2_up,
              w2_down, g_ple, w_ple, w_ple_gate, g_final):
    f32 = jnp.float32
    Bp = x_prompt.shape[0]
    H, DH = MLSTM_HEADS, MLSTM_HEAD_DIM
    z_s5 = jnp.zeros((Bp, S5_GROUPS, S5_STATE), f32)
    z_c = jnp.zeros((Bp, H, DH, DH), f32)
    z_n = jnp.zeros((Bp, H, DH), f32)
    z_m = jnp.zeros((Bp, H), f32)
    z_conv = jnp.zeros((Bp, CONV_WIDTH - 1, 2 * MLSTM_WIDTH), x_prompt.dtype)
    outs_p = [[] for _ in range(6)]
    outs_s = [[] for _ in range(6)]
    xp, xs = x_prompt, x_sample
    for i in range(DEPTH):
        lw = {
            'g_ffn1': g_ffn1[i], 'w1_gate': w1_gate[i], 'w1_up': w1_up[i], 'w1_down': w1_down[i],
            'g_mix': g_mix[i], 'w_in': w_in[i],
            's5_lambda_re': s5_lambda_re[i], 's5_lambda_im': s5_lambda_im[i], 's5_log_dt': s5_log_dt[i],
            's5_b_re': s5_b_re[i], 's5_b_im': s5_b_im[i], 's5_c_re': s5_c_re[i], 's5_c_im': s5_c_im[i],
            's5_d': s5_d[i], 's5_w_glu': s5_w_glu[i], 'w_s5_up': w_s5_up[i],
            'conv_w': conv_w[i], 'conv_b': conv_b[i], 'b_igate': b_igate[i], 'b_fgate': b_fgate[i],
            'g_mhead': g_mhead[i], 'w_m_up': w_m_up[i], 'w_out': w_out[i],
            'g_ffn2': g_ffn2[i], 'w2_gate': w2_gate[i], 'w2_up': w2_up[i], 'w2_down': w2_down[i],
            'g_ple': g_ple[i], 'w_ple': w_ple[i], 'w_ple_gate': w_ple_gate[i],
        }
        xp, st_p = _layer(xp, p_prompt[i], z_s5, z_s5, z_c, z_n, z_m, z_conv, lw)
        xs, st_s = _layer(xs, p_sample[i], state_s5_re[i], state_s5_im[i], state_mlstm_c[i],
                          state_mlstm_n[i], state_mlstm_m[i], state_conv[i], lw)
        for j in range(6):
            outs_p[j].append(st_p[j])
            outs_s[j].append(st_s[j])
    y_prompt = _rmsnorm(xp, g_final)
    y_sample = _rmsnorm(xs, g_final)
    return (y_prompt, y_sample,
            jnp.stack(outs_p[0]), jnp.stack(outs_p[1]), jnp.stack(outs_p[2]),
            jnp.stack(outs_p[3]), jnp.stack(outs_p[4]), jnp.stack(outs_p[5]),
            jnp.stack(outs_s[0]), jnp.stack(outs_s[1]), jnp.stack(outs_s[2]),
            jnp.stack(outs_s[3]), jnp.stack(outs_s[4]), jnp.stack(outs_s[5]))
```

```cpp
#include <hip/hip_runtime.h>
#include <cstdio>
#include <cstdint>

#define DI __device__ __forceinline__
#ifndef PROBE_MASK
#define PROBE_MASK 0
#endif
#ifndef FAST_GEMM
#define FAST_GEMM 1
#endif
#ifndef GEMM_ALIGN
#define GEMM_ALIGN true
#endif
#ifndef FAST_MLSTM
#define FAST_MLSTM 1
#endif
#ifndef FAST_S5
#define FAST_S5 1
#endif
typedef unsigned short bf16;
typedef unsigned int u32;
typedef __bf16 bf2_t __attribute__((ext_vector_type(2)));
typedef unsigned u32x4t __attribute__((ext_vector_type(4)));
#define LAS __attribute__((address_space(3)))

constexpr int D = 1024, FF = 2048, NL = 4;
constexpr int NBP = 8, SEQ = 2048, NBS = 128, SS = 4;
constexpr int MP = NBP * SEQ, MS = NBS * SS, M = MP + MS;
constexpr int NG = 32, NST = 64, S5W = 512;
constexpr int NH = 4, DH = 256, MW = 1024;
constexpr int INC = 6664, INN = 6656;
constexpr int DPLE = 256;
constexpr float EPS = 1e-6f;
constexpr int NTHR = 512, NWV = 8;
constexpr int PADK = 0;
constexpr int LDS_BYTES = 147456;
constexpr int MISC_OFF = LDS_BYTES - 256;

enum { I_XP = 0, I_XS, I_S5RE, I_S5IM, I_MC, I_MN, I_MM, I_CONV, I_PP, I_PS, I_GFFN1, I_W1G, I_W1U, I_W1D, I_GMIX, I_WIN, I_LRE, I_LIM, I_LDT,
       I_BRE, I_BIM, I_CRE, I_CIM, I_S5D, I_WGLU, I_WS5UP, I_CONVW, I_CONVB, I_BIG, I_BFG, I_GMH, I_WMUP, I_WOUT, I_GFFN2, I_W2G, I_W2U, I_W2D,
       I_GPLE, I_WPLE, I_WPG, I_GFIN, N_IN };

constexpr size_t O_Y = 0;
constexpr size_t O_S5RE_P = O_Y + (size_t)M * D;
constexpr size_t O_S5IM_P = O_S5RE_P + (size_t)NL * NBP * NG * NST;
constexpr size_t O_C_P = O_S5IM_P + (size_t)NL * NBP * NG * NST;
constexpr size_t O_N_P = O_C_P + (size_t)NL * NBP * NH * DH * DH;
constexpr size_t O_M_P = O_N_P + (size_t)NL * NBP * NH * DH;
constexpr size_t O_CONV_P = O_M_P + (size_t)NL * NBP * NH;
constexpr size_t O_S5RE_S = O_CONV_P + (size_t)NL * NBP * 3 * 2048;
constexpr size_t O_S5IM_S = O_S5RE_S + (size_t)NL * NBS * NG * NST;
constexpr size_t O_C_S = O_S5IM_S + (size_t)NL * NBS * NG * NST;
constexpr size_t O_N_S = O_C_S + (size_t)NL * NBS * NH * DH * DH;
constexpr size_t O_M_S = O_N_S + (size_t)NL * NBS * NH * DH;
constexpr size_t O_CONV_S = O_M_S + (size_t)NL * NBS * NH;
constexpr size_t O_END = O_CONV_S + (size_t)NL * NBS * 3 * 2048;
static_assert(O_END == 166037632ull, "output map");

constexpr size_t al256(size_t x) { return (x + 255) & ~(size_t)255; }
constexpr size_t WS_ZERO = 0, ZERO_BYTES = 32768;
constexpr size_t WS_BAR = 16384;
constexpr size_t LW_W1GU = 0;
constexpr size_t LW_W1D = LW_W1GU + (size_t)4096 * (1024 + PADK) * 2;
constexpr size_t LW_WIN = LW_W1D + (size_t)1024 * (2048 + PADK) * 2;
constexpr size_t LW_WG = LW_WIN + (size_t)INN * (1024 + PADK) * 2;
constexpr size_t LW_WGLU = LW_WG + (size_t)8 * 1024 * 4;
constexpr size_t LW_WS5UP = LW_WGLU + (size_t)512 * (512 + PADK) * 2;
constexpr size_t LW_WMUP = LW_WS5UP + (size_t)1024 * (512 + PADK) * 2;
constexpr size_t LW_WOUT = LW_WMUP + (size_t)1024 * (1024 + PADK) * 2;
constexpr size_t LW_W2GU = LW_WOUT + (size_t)1024 * (1024 + PADK) * 2;
constexpr size_t LW_W2D = LW_W2GU + (size_t)4096 * (1024 + PADK) * 2;
constexpr size_t LW_WPG = LW_W2D + (size_t)1024 * (2048 + PADK) * 2;
constexpr size_t LW_WPLE = LW_WPG + (size_t)1024 * (1024 + PADK) * 2;
constexpr size_t LW_END = LW_WPLE + (size_t)1024 * (256 + PADK) * 2;
constexpr size_t LW_STRIDE = al256(LW_END);
constexpr size_t WS_W = 1u << 20;
constexpr size_t WS_PB = al256(WS_W + NL * LW_STRIDE);
constexpr size_t WS_X = al256(WS_PB + (size_t)NL * M * DPLE * 2);
constexpr size_t WS_XB = al256(WS_X + (size_t)M * D * 4);
constexpr size_t WS_ACT = al256(WS_XB + (size_t)M * D * 2);
constexpr size_t WS_UP = al256(WS_ACT + (size_t)M * FF * 2);
constexpr size_t WS_US = al256(WS_UP + (size_t)NG * 1024 * 384 * 2);
constexpr size_t WS_QKR = al256(WS_US + (size_t)MS * 512 * 2);
constexpr size_t WS_V = al256(WS_QKR + (size_t)M * 2048 * 2);
constexpr size_t WS_OS = al256(WS_V + (size_t)M * 1024 * 2);
constexpr size_t WS_GS5 = al256(WS_OS + (size_t)M * 1024 * 2);
constexpr size_t WS_GM = al256(WS_GS5 + (size_t)M * 1024 * 2);
constexpr size_t WS_LI = al256(WS_GM + (size_t)M * 1024 * 2);
constexpr size_t WS_LF = al256(WS_LI + (size_t)M * 4 * 4);
constexpr size_t WS_Q = al256(WS_LF + (size_t)M * 4 * 4);
constexpr size_t WS_K = al256(WS_Q + (size_t)M * 1024 * 2);
constexpr size_t WS_H = al256(WS_K + (size_t)M * 1024 * 2);
constexpr size_t WS_YS5 = al256(WS_H + (size_t)M * 1024 * 4);
constexpr size_t WS_YG = al256(WS_YS5 + (size_t)M * 512 * 2);
constexpr size_t WS_HM = al256(WS_YG + (size_t)M * 512 * 2);
constexpr size_t WS_T5 = al256(WS_HM + (size_t)M * 1024 * 2);
constexpr size_t WS_MRG = al256(WS_T5 + (size_t)M * 1024 * 4);
constexpr size_t WS_GT = al256(WS_MRG + (size_t)M * 1024 * 2);
constexpr size_t WS_XB2 = al256(WS_GT + (size_t)M * 1024 * 2);
constexpr size_t WS_SSQ = al256(WS_XB2 + (size_t)M * D * 2);
constexpr size_t WS_NQI = al256(WS_SSQ + (size_t)17 * M * 16 * 4);
constexpr size_t WS_DCT = al256(WS_NQI + (size_t)MP * 4 * 4);
constexpr size_t WS_CTP = al256(WS_DCT + (size_t)512 * 65536 * 2);
constexpr size_t WS_DN = al256(WS_CTP + (size_t)512 * 65536 * 2);
constexpr size_t WS_NP = al256(WS_DN + (size_t)512 * 256 * 4);
constexpr size_t WS_DEC = al256(WS_NP + (size_t)512 * 256 * 4);
constexpr size_t WS_MNEW = al256(WS_DEC + 512 * 4);
constexpr size_t WS_NI = al256(WS_MNEW + 512 * 4);
constexpr size_t WS_S5K = al256(WS_NI + (size_t)MP * 1024 * 2);
constexpr size_t WS_S5E = al256(WS_S5K + (size_t)NL * 8192 * 384 * 2);
constexpr size_t WS_ES = al256(WS_S5E + (size_t)NL * 8192 * 256 * 2);
constexpr size_t WS_END = al256(WS_ES + (size_t)32768 * 128 * 4);
static_assert(WS_END < (size_t)2000 * 1024 * 1024, "d_ws map must fit 4 x the largest tensor");
static_assert(WS_GS5 == WS_OS + (size_t)M * 1024 * 2 && WS_GM == WS_GS5 + (size_t)M * 1024 * 2, "OS, GS5, GM consecutive");

DI float bf2f(bf16 b) { return __uint_as_float((u32)b << 16); }
DI float bflo(u32 w) { return __uint_as_float(w << 16); }
DI float bfhi(u32 w) { return __uint_as_float(w & 0xffff0000u); }
DI u32 f2bf(float f) { u32 u = __float_as_uint(f); return (u + 0x7fffu + ((u >> 16) & 1u)) >> 16; }
DI u32 pk2(float lo, float hi) { bf2_t v = {(__bf16)lo, (__bf16)hi}; return __builtin_bit_cast(u32, v); }
DI uint4 pk8(const float (&v)[8]) { uint4 o; o.x = pk2(v[0], v[1]); o.y = pk2(v[2], v[3]); o.z = pk2(v[4], v[5]); o.w = pk2(v[6], v[7]); return o; }
DI void unpk8(uint4 w, float (&v)[8]) { v[0] = bflo(w.x); v[1] = bfhi(w.x); v[2] = bflo(w.y); v[3] = bfhi(w.y); v[4] = bflo(w.z); v[5] = bfhi(w.z); v[6] = bflo(w.w); v[7] = bfhi(w.w); }
DI float sigm(float x) { return __builtin_amdgcn_rcpf(1.f + __expf(-x)); }
DI float wave_sum(float v) {
#pragma unroll
    for (int o = 1; o < 64; o <<= 1) v += __shfl_xor(v, o);
    return v;
}
DI float fdot2(u32 a, u32 b, float c) { return __builtin_amdgcn_fdot2_f32_bf16(__builtin_bit_cast(bf2_t, a), __builtin_bit_cast(bf2_t, b), c, false); }
DI float dot8(uint4 a, uint4 b, float c) { c = fdot2(a.x, b.x, c); c = fdot2(a.y, b.y, c); c = fdot2(a.z, b.z, c); c = fdot2(a.w, b.w, c); return c; }
DI float gelu_tanh(float x) { const float u = 0.7978845608028654f * (x + 0.044715f * x * x * x); const float e = __expf(2.f * u); const float th = 1.f - 2.f * __builtin_amdgcn_rcpf(e + 1.f); return 0.5f * x * (1.f + th); }

DI size_t up_off(int row, int col) { const int b = row >> 11, t = row & 2047, c = t >> 4, s = t & 15, g = col >> 4, j = col & 15; return ((size_t)(g * 1024 + b * 128 + c)) * 384 + s * 16 + j; }

struct Args { const float* in[N_IN]; float* out; unsigned char* ws; int lo, hi; };
static_assert(sizeof(Args) == (N_IN + 2) * 8 + 8, "Args has no padding");

#define CAS4 __attribute__((address_space(4)))
#define GAS __attribute__((address_space(1)))
DI const float* inptr(int i) { const CAS4 char* ka = (const CAS4 char*)__builtin_amdgcn_kernarg_segment_ptr(); asm volatile("" : "+s"(ka)); const GAS float* g = *(const GAS float* const CAS4*)(ka + 8 * i); return (const float*)g; }
DI void lds_sync() { asm volatile("s_waitcnt lgkmcnt(0)" ::: "memory"); __builtin_amdgcn_s_barrier(); asm volatile("" ::: "memory"); }
struct Ctx {
    float* out; unsigned char* ws;
    int tid, lane, wave, gtid, gthreads, gwave, gwaves, nblk, blk;
};
DI bf16* wsb(const Ctx& c, size_t off) { return (bf16*)(c.ws + off); }
DI float* wsf(const Ctx& c, size_t off) { return (float*)(c.ws + off); }
DI float* ssq_ptr(const Ctx& c, int idx) { return (float*)(c.ws + WS_SSQ) + (size_t)idx * M * 16; }
DI float rstd_of(const float* P, int row) {
    const float4* p = (const float4*)(P + (size_t)row * 16); const float4 a = p[0], b = p[1], c2 = p[2], d = p[3];
    const float s = (((a.x + a.y) + (a.z + a.w)) + ((b.x + b.y) + (b.z + b.w))) + (((c2.x + c2.y) + (c2.z + c2.w)) + ((d.x + d.y) + (d.z + d.w)));
    return rsqrtf(s * (1.f / D) + EPS);
}

#define XB_TMO      128
#define XB_XCNT(j)  (256  + 64 * (j))
#define XB_XSUB(j)  (1280 + 64 * (j))
#define XB_XGEN(j)  (2304 + 64 * (j))
#define XB_TOP      3328
#define XB_TOPGEN   3392
#define XCD_BAR_WORDS 3456
#define XB_SPIN_CAP (1u << 22)

__device__ __forceinline__ unsigned xb_ld(unsigned* p)              { return __hip_atomic_load(p, __ATOMIC_RELAXED, __HIP_MEMORY_SCOPE_AGENT); }
__device__ __forceinline__ unsigned xb_add(unsigned* p, unsigned v) { return __hip_atomic_fetch_add(p, v, __ATOMIC_RELAXED, __HIP_MEMORY_SCOPE_AGENT); }
__device__ __forceinline__ unsigned xb_xcc_id() { return (unsigned)__builtin_amdgcn_s_getreg((3 << 11) | 20) & 0xFu; }
#define XB_SPIN(cond, bar) do { unsigned _sp = 0; while (cond) { __builtin_amdgcn_s_sleep(1); \
    if ((++_sp & 255u) == 0u) { if (xb_ld(&(bar)[XB_TMO])) break; if (_sp > XB_SPIN_CAP) { atomicAdd(&(bar)[XB_TMO], 1u); break; } } } } while (0)

struct XcdBarrier {
    unsigned* bar; unsigned x;
    volatile LAS unsigned* st;
};

__device__ __forceinline__ XcdBarrier xcd_barrier_post(unsigned* bar, volatile LAS unsigned* st, bool is_t0  ) {
    XcdBarrier b; b.bar = bar; b.x = xb_xcc_id(); b.st = st;
    if (is_t0) (void)xb_add(&bar[XB_XCNT(b.x)], 1u);
    return b;
}
__device__ __forceinline__ void xcd_barrier_complete(unsigned* bar, unsigned x, unsigned& nloc, unsigned& nx) {
    const unsigned G = gridDim.x * gridDim.y * gridDim.z;
    unsigned sum, cnt, mine, sp = 0u;
    for (;;) {
        sum = 0u; cnt = 0u; mine = 0u;
#pragma unroll
        for (unsigned j = 0; j < 16; ++j) { const unsigned c = xb_ld(&bar[XB_XCNT(j)]); sum += c; cnt += (c > 0u) ? 1u : 0u; mine = (j == x) ? c : mine; }
        if (sum == G) break;
        __builtin_amdgcn_s_sleep(1);
        if ((++sp & 255u) == 0u) { if (xb_ld(&bar[XB_TMO])) break; if (sp > XB_SPIN_CAP) { atomicAdd(&bar[XB_TMO], 1u); break; } }
    }
    nloc = mine > 0u ? mine : 1u; nx = cnt > 0u ? cnt : 1u;
}

__device__ __forceinline__ void xcd_barrier(const XcdBarrier& b, bool is_t0  ) {
    asm volatile("s_waitcnt vmcnt(0)" ::: "memory");
    __syncthreads();
    if (is_t0) {
        unsigned* bar = b.bar;
        __builtin_amdgcn_s_waitcnt(0);
        unsigned nloc = b.st[0], nx = b.st[1];
        if (nloc == 0u) { xcd_barrier_complete(bar, b.x, nloc, nx); b.st[0] = nloc; b.st[1] = nx; }
        const unsigned old = xb_add(&bar[XB_XSUB(b.x)], 1u);
        const unsigned gen = old / nloc;
        if (old + 1u == (gen + 1u) * nloc) {
            __builtin_amdgcn_fence(__ATOMIC_RELEASE, "agent");
            asm volatile("s_waitcnt vmcnt(0)" ::: "memory");
            const unsigned og = xb_add(&bar[XB_TOP], 1u);
            const unsigned tg = og / nx;
            if (og + 1u == (tg + 1u) * nx) xb_add(&bar[XB_TOPGEN], 1u);
            else XB_SPIN(xb_ld(&bar[XB_TOPGEN]) == tg, bar);
            __builtin_amdgcn_fence(__ATOMIC_ACQUIRE, "agent");
            xb_add(&bar[XB_XGEN(b.x)], 1u);
            asm volatile("s_waitcnt vmcnt(0)" ::: "memory");
        } else {
            XB_SPIN(xb_ld(&bar[XB_XGEN(b.x)]) == gen, bar);
            __builtin_amdgcn_fence(__ATOMIC_ACQUIRE, "agent");
            asm volatile("s_waitcnt vmcnt(0)" ::: "memory");
        }
    }
    __syncthreads();
}

namespace pg8 {
#define PG8_LAS __attribute__((address_space(3)))
typedef unsigned short bf16_t;
typedef short bf16x8 __attribute__((ext_vector_type(8)));
typedef float f32x4 __attribute__((ext_vector_type(4)));
typedef unsigned u32x4 __attribute__((ext_vector_type(4)));
constexpr int BM = 256, BK = 64, HALF = 128, HTB = HALF * BK * 2  , STAGE_BYTES = 8 * HTB, NXCD = 8, WGM = 8;

__host__ __device__ __forceinline__ int lds_byte(int r, int c) { const int st = (r >> 4) * 2 + (c >> 5), rr = r & 15, cc = c & 31, ob = rr * 64 + cc * 2; return st * 1024 + (ob ^ (((ob >> 9) & 1) << 5)); }
__host__ __device__ __forceinline__ void stage_rc(int b, int& R, int& C) { const int st = b / 1024, sb = b % 1024, swz = sb ^ (((sb >> 9) & 1) << 5); R = (st >> 1) * 16 + swz / 64; C = (st & 1) * 32 + (swz % 64) / 2; }
__host__ __device__ __forceinline__ int perm32(int rho) { const int n = rho >> 4, i = rho & 15; return 8 * (i >> 2) + 4 * n + (i & 3); }

struct Unit { int pm, pn; };
struct Gemm { const bf16_t* A; const bf16_t* Bt; int M, N, K, lda, ldb; };

struct StaticOrder {
    int nM, nN, nwg, G, c;
    __host__ __device__ void init(int M, int N, int G_, int c_) { nM = M / BM; nN = N / BM; nwg = nM * nN; G = G_; c = c_; }
    __host__ __device__ bool next(int i, Unit& u) const {
        const long L = (long)i * G + c; if (L >= nwg) return false;
        int wgid = (int)L; { const int q = nwg / NXCD, r = nwg % NXCD, xcd = wgid % NXCD, off = wgid / NXCD; wgid = (xcd < r ? xcd * (q + 1) : r * (q + 1) + (xcd - r) * q) + off; }
        const int nig = WGM * nN, gid = wgid / nig, fm = gid * WGM, gsz = (nM - fm) < WGM ? (nM - fm) : WGM;
        u.pm = fm + ((wgid % nig) % gsz); u.pn = (wgid % nig) / gsz; return true;
    }
    __device__ __forceinline__ void a_ready(const Unit&) const {}
    __device__ __forceinline__ void done(const Unit&) const {}
};

template <class Epi, class Sched, bool ALIGN_EPI = false, bool SP2 = false>
__device__ __forceinline__ void gemm_phase(PG8_LAS unsigned char* lds, const Gemm g, const Sched& S, const Epi& E, int tid_in) {
    int tid_ = tid_in; asm volatile("" : "+v"(tid_));
    const int tid = tid_, wid = __builtin_amdgcn_readfirstlane(tid >> 6), lane = tid & 63, wr = wid >> 2, wc = wid & 3, fr = lane & 15, fq = lane >> 4;
    const int K = g.K, nt = K / BK;
    unsigned voffA[2], voffB[2];
#pragma unroll
    for (int i = 0; i < 2; ++i) { int R, C; stage_rc(tid * 16 + i * 8192, R, C); const int Rb = Epi::PERM ? ((R & ~31) + perm32(R & 31)) : R;
        voffA[i] = (unsigned)(R * g.lda + C) * 2u; voffB[i] = (unsigned)(Rb * g.ldb + C) * 2u; }
    const size_t kstep = (size_t)(BK * 2);
    const size_t hstepA = (size_t)HALF * g.lda * 2, hstepB = (size_t)HALF * g.ldb * 2;
    const size_t tstepA = 2 * hstepA, tstepB = 2 * hstepB;
    const unsigned ldsw = (unsigned)wid * 1024u;
    const int aoff = lds_byte(wr * 64 + fr, fq * 8), boff = lds_byte(wc * 32 + fr, fq * 8);
#define PG8_SA(b, h) (((b) * 2 + (h)) * HTB)
#define PG8_SB(b, h) ((4 + (b) * 2 + (h)) * HTB)
#define PG8_STAGE(bufoff, gbase, voff) do { _Pragma("unroll") for (int _i = 0; _i < 2; ++_i) \
        __builtin_amdgcn_global_load_lds((const unsigned*)((const char*)(gbase) + (voff)[_i]), (PG8_LAS unsigned*)(lds + (bufoff) + ldsw + _i * 8192), 16, 0, 0); } while (0)
#define PG8_LDA(dst, b, h) do { _Pragma("unroll") for (int m = 0; m < 4; ++m) _Pragma("unroll") for (int k = 0; k < 2; ++k) dst[m][k] = *(const PG8_LAS bf16x8*)(lds + PG8_SA(b, h) + aoff + m * 2048 + k * 1024); } while (0)
#define PG8_LDB(dst, b, h) do { _Pragma("unroll") for (int n = 0; n < 2; ++n) _Pragma("unroll") for (int k = 0; k < 2; ++k) dst[n][k] = *(const PG8_LAS bf16x8*)(lds + PG8_SB(b, h) + boff + n * 2048 + k * 1024); } while (0)
#define PG8_MMA(ai, bj, At, Bt) do { __builtin_amdgcn_s_setprio(1); _Pragma("unroll") for (int m = 0; m < 4; ++m) _Pragma("unroll") for (int n = 0; n < 2; ++n) _Pragma("unroll") for (int k = 0; k < 2; ++k) \
        acc[ai][bj][m][n] = __builtin_amdgcn_mfma_f32_16x16x32_bf16(Bt[n][k], At[m][k], acc[ai][bj][m][n], 0, 0, 0); __builtin_amdgcn_s_setprio(0); } while (0)
#define PG8_WAIT_V(n) asm volatile("s_waitcnt vmcnt(" #n ")" ::: "memory")
#define PG8_WAIT_L(n) asm volatile("s_waitcnt lgkmcnt(" #n ")" ::: "memory")
#define PG8_BAR __builtin_amdgcn_s_barrier()
#define PG8_SCHED __builtin_amdgcn_sched_barrier(0)
    Unit cur, nxt; int ui = 0;
    if (!S.next(0, cur)) return;
    f32x4 acc[2][2][4][2];
#pragma unroll
    for (int a = 0; a < 2; ++a)
#pragma unroll
        for (int b = 0; b < 2; ++b)
#pragma unroll
            for (int m = 0; m < 4; ++m)
#pragma unroll
                for (int n = 0; n < 2; ++n) acc[a][b][m][n] = (f32x4){0.f, 0.f, 0.f, 0.f};
    bf16x8 At[4][2], B0[2][2], B1[2][2];
    const char* cA = (const char*)g.A + (size_t)cur.pm * tstepA; const char* cB = (const char*)g.Bt + (size_t)cur.pn * tstepB;
    S.a_ready(cur);
    if constexpr (SP2) {
        PG8_STAGE(PG8_SB(0, 0), cB, voffB); PG8_STAGE(PG8_SB(0, 1), cB + hstepB, voffB); PG8_STAGE(PG8_SA(0, 0), cA, voffA); PG8_STAGE(PG8_SA(0, 1), cA + hstepA, voffA);
        if (wr == 1) PG8_BAR;
        PG8_WAIT_V(2); PG8_BAR;
        PG8_STAGE(PG8_SB(1, 0), cB + kstep, voffB); PG8_STAGE(PG8_SA(1, 0), cA + kstep, voffA); PG8_STAGE(PG8_SB(1, 1), cB + hstepB + kstep, voffB);
        PG8_WAIT_V(6); PG8_BAR;
    } else {
        PG8_STAGE(PG8_SB(0, 0), cB, voffB); PG8_STAGE(PG8_SA(0, 0), cA, voffA); PG8_STAGE(PG8_SB(0, 1), cB + hstepB, voffB); PG8_STAGE(PG8_SA(0, 1), cA + hstepA, voffA);
        if (wr == 1) PG8_BAR;
        PG8_WAIT_V(4); PG8_BAR;
        PG8_STAGE(PG8_SB(1, 0), cB + kstep, voffB); PG8_STAGE(PG8_SA(1, 0), cA + kstep, voffA); PG8_STAGE(PG8_SB(1, 1), cB + hstepB + kstep, voffB);
        PG8_WAIT_V(6); PG8_BAR;
    }
    for (;;) {
        const bool has_next = S.next(ui + 1, nxt);
        const char* nA = has_next ? (const char*)g.A + (size_t)nxt.pm * tstepA : cA; const char* nB = has_next ? (const char*)g.Bt + (size_t)nxt.pn * tstepB : cB;
#pragma unroll 1
        for (int t = 0; t < nt; t += 2) {
            const bool last = (t == nt - 2);
            const char* a1 = cA + (size_t)(t + 1) * kstep;
            const char* a2 = last ? nA : cA + (size_t)(t + 2) * kstep; const char* b2 = last ? nB : cB + (size_t)(t + 2) * kstep;
            const char* a3 = a2 + kstep; const char* b3 = b2 + kstep;
            if (last && has_next) S.a_ready(nxt);
            if constexpr (SP2) {
            PG8_LDB(B0, 0, 0); PG8_LDB(B1, 0, 1); PG8_SCHED; PG8_LDA(At, 0, 0); PG8_STAGE(PG8_SA(1, 1), a1 + hstepA, voffA);
            PG8_WAIT_V(8); PG8_WAIT_L(0); PG8_BAR; PG8_MMA(0, 0, At, B0); PG8_MMA(0, 1, At, B1); PG8_BAR; PG8_SCHED;
            PG8_LDA(At, 0, 1); PG8_STAGE(PG8_SB(0, 0), b2, voffB); PG8_STAGE(PG8_SB(0, 1), b2 + hstepB, voffB); PG8_STAGE(PG8_SA(0, 0), a2, voffA);
            PG8_WAIT_V(8); PG8_WAIT_L(0); PG8_BAR; PG8_MMA(1, 0, At, B0); PG8_MMA(1, 1, At, B1); PG8_BAR; PG8_SCHED;
            PG8_LDB(B0, 1, 0); PG8_LDB(B1, 1, 1); PG8_SCHED; PG8_LDA(At, 1, 0); PG8_STAGE(PG8_SA(0, 1), a2 + hstepA, voffA);
            PG8_WAIT_V(8); PG8_WAIT_L(0); PG8_BAR; PG8_MMA(0, 0, At, B0); PG8_MMA(0, 1, At, B1); PG8_BAR; PG8_SCHED;
            PG8_LDA(At, 1, 1); PG8_STAGE(PG8_SB(1, 0), b3, voffB); PG8_STAGE(PG8_SB(1, 1), b3 + hstepB, voffB); PG8_STAGE(PG8_SA(1, 0), a3, voffA);
            PG8_WAIT_V(8); PG8_WAIT_L(0); PG8_BAR; PG8_MMA(1, 0, At, B0); PG8_MMA(1, 1, At, B1); PG8_BAR; PG8_SCHED;
            } else {
            PG8_LDB(B0, 0, 0); PG8_SCHED; PG8_LDA(At, 0, 0); PG8_STAGE(PG8_SA(1, 1), a1 + hstepA, voffA);
            PG8_WAIT_L(8); PG8_BAR; PG8_WAIT_L(0); PG8_MMA(0, 0, At, B0); PG8_BAR; PG8_SCHED;
            PG8_LDB(B1, 0, 1); PG8_STAGE(PG8_SB(0, 0), b2, voffB);
            PG8_BAR; PG8_WAIT_L(0); PG8_MMA(0, 1, At, B1); PG8_BAR;
            PG8_LDA(At, 0, 1); PG8_STAGE(PG8_SA(0, 0), a2, voffA);
            PG8_BAR; PG8_WAIT_L(0); PG8_MMA(1, 0, At, B0); PG8_BAR; PG8_SCHED;
            PG8_STAGE(PG8_SB(0, 1), b2 + hstepB, voffB);
            PG8_WAIT_V(6); PG8_BAR; PG8_MMA(1, 1, At, B1); PG8_BAR;
            PG8_LDB(B0, 1, 0); PG8_SCHED; PG8_LDA(At, 1, 0); PG8_STAGE(PG8_SA(0, 1), a2 + hstepA, voffA);
            PG8_WAIT_L(8); PG8_BAR; PG8_WAIT_L(0); PG8_MMA(0, 0, At, B0); PG8_BAR; PG8_SCHED;
            PG8_LDB(B1, 1, 1); PG8_STAGE(PG8_SB(1, 0), b3, voffB);
            PG8_BAR; PG8_WAIT_L(0); PG8_MMA(0, 1, At, B1); PG8_BAR;
            PG8_LDA(At, 1, 1); PG8_STAGE(PG8_SA(1, 0), a3, voffA);
            PG8_BAR; PG8_WAIT_L(0); PG8_MMA(1, 0, At, B0); PG8_BAR; PG8_SCHED;
            PG8_STAGE(PG8_SB(1, 1), b3 + hstepB, voffB);
            PG8_WAIT_V(6); PG8_BAR; PG8_MMA(1, 1, At, B1); PG8_BAR;
            }
        }
        if constexpr (ALIGN_EPI) { if (wr == 0) PG8_BAR; }
        if constexpr (!Epi::AFTER_DRAIN) { E(acc, cur, wr, wc, fr, fq, ui); S.done(cur); }
        if (!has_next) break;
#pragma unroll
        for (int a = 0; a < 2; ++a)
#pragma unroll
            for (int b = 0; b < 2; ++b)
#pragma unroll
                for (int m = 0; m < 4; ++m)
#pragma unroll
                    for (int n = 0; n < 2; ++n) acc[a][b][m][n] = (f32x4){0.f, 0.f, 0.f, 0.f};
        cur = nxt; cA = nA; cB = nB; ++ui;
        if constexpr (ALIGN_EPI) { if (wr == 1) PG8_BAR; }
    }
    PG8_WAIT_V(0);
    if constexpr (!ALIGN_EPI) { if (wr == 0) PG8_BAR; }
    PG8_BAR;
    if constexpr (Epi::AFTER_DRAIN) { E.fused(acc, cur, wr, wc, fr, fq, lds, wid, lane); S.done(cur); }
#undef PG8_SA
#undef PG8_SB
#undef PG8_STAGE
#undef PG8_LDA
#undef PG8_LDB
#undef PG8_MMA
#undef PG8_WAIT_V
#undef PG8_WAIT_L
#undef PG8_BAR
#undef PG8_SCHED
}
}
struct PF0 {};
struct ESwiGLU {
    static constexpr int ID = 1; static constexpr bool NEEDS_RS = true; static constexpr bool PAIRED = true;
    const float* ssq_in; bf16* act;
    typedef PF0 PF; DI PF load(int, int) const { return PF0{}; }
    DI const float* ssq_src() const { return ssq_in; } DI float pre(int row) const { return rstd_of(ssq_in, row); }
    DI float operator()(int row, int col, const float (&a)[8], const float (&b)[8], float rs, const PF&) const {
        float o[8];
#pragma unroll
        for (int i = 0; i < 8; ++i) { const float g = a[i] * rs, u = b[i] * rs; o[i] = g * sigm(g) * u; }
        *(uint4*)(act + (size_t)row * FF + col) = pk8(o);
        return 0.f;
    }
};
struct EResid {
    static constexpr int ID = 2; static constexpr bool NEEDS_RS = false; static constexpr bool PAIRED = false;
    const bf16* XBin; bf16* XBout; float scale;
    struct PF { uint4 x; };
    DI PF load(int row, int col) const { PF p; p.x = *(const uint4*)(XBin + (size_t)row * D + col); return p; }
    DI const float* ssq_src() const { return nullptr; } DI float pre(int) const { return 0.f; }
    DI float operator()(int row, int col, const float (&a)[8], const float (&)[8], float, const PF& p) const {
        float o[8]; unpk8(p.x, o);
        float s = 0.f;
#pragma unroll
        for (int i = 0; i < 8; ++i) { o[i] += scale * a[i]; s += o[i] * o[i]; }
        *(uint4*)(XBout + (size_t)row * D + col) = pk8(o);
        return s;
    }
};
struct EWin {
    static constexpr int ID = 3; static constexpr bool NEEDS_RS = true; static constexpr bool PAIRED = false;
    const float* ssq_in; bf16 *UP, *US, *QKR, *V, *OS;
    typedef PF0 PF; DI PF load(int, int) const { return PF0{}; }
    DI const float* ssq_src() const { return ssq_in; } DI float pre(int row) const { return rstd_of(ssq_in, row); }
    DI float operator()(int row, int col, const float (&a)[8], const float (&)[8], float rs, const PF&) const {
        float o[8];
#pragma unroll
        for (int i = 0; i < 8; ++i) o[i] = a[i] * rs;
        if (col < 512) {
            if (row < MP) *(uint4*)(UP + up_off(row, col)) = pk8(o);
            else *(uint4*)(US + (size_t)(row - MP) * 512 + col) = pk8(o);
        } else if (col < 2560) { *(uint4*)(QKR + (size_t)row * 2048 + (col - 512)) = pk8(o); }
        else if (col < 3584) { *(uint4*)(V + (size_t)row * 1024 + (col - 2560)) = pk8(o); }
        else {
#pragma unroll
            for (int i = 0; i < 8; ++i) o[i] = sigm(o[i]);
            const int seg = (col - 3584) >> 10, cc = (col - 3584) & 1023;
            *(uint4*)(OS + (size_t)seg * ((size_t)M * 1024) + (size_t)row * 1024 + cc) = pk8(o);
        }
        return 0.f;
    }
};
struct EGlu {
    static constexpr int ID = 4; static constexpr bool NEEDS_RS = false; static constexpr bool PAIRED = false;
    const bf16* YS5; bf16* YG;
    struct PF { uint4 y; };
    DI PF load(int row, int col) const { PF p; p.y = *(const uint4*)(YS5 + (size_t)row * 512 + col); return p; }
    DI const float* ssq_src() const { return nullptr; } DI float pre(int) const { return 0.f; }
    DI float operator()(int row, int col, const float (&a)[8], const float (&)[8], float, const PF& p) const {
        float y[8]; unpk8(p.y, y);
#pragma unroll
        for (int i = 0; i < 8; ++i) y[i] = y[i] * sigm(a[i]);
        *(uint4*)(YG + (size_t)row * 512 + col) = pk8(y);
        return 0.f;
    }
};
struct ET5 {
    static constexpr int ID = 5; static constexpr bool NEEDS_RS = false; static constexpr bool PAIRED = false;
    const bf16* GS5; bf16* T5;
    struct PF { uint4 g; };
    DI PF load(int row, int col) const { PF p; p.g = *(const uint4*)(GS5 + (size_t)row * 1024 + col); return p; }
    DI const float* ssq_src() const { return nullptr; } DI float pre(int) const { return 0.f; }
    DI float operator()(int row, int col, const float (&a)[8], const float (&)[8], float, const PF& p) const {
        float g[8]; unpk8(p.g, g);
#pragma unroll
        for (int i = 0; i < 8; ++i) g[i] *= a[i];
        *(uint4*)(T5 + (size_t)row * 1024 + col) = pk8(g);
        return 0.f;
    }
};
struct EMerged {
    static constexpr int ID = 6; static constexpr bool NEEDS_RS = false; static constexpr bool PAIRED = false;
    const bf16* T5; const bf16* GM; bf16* MRG;
    struct PF { uint4 t, g; };
    DI PF load(int row, int col) const { PF p; p.t = *(const uint4*)(T5 + (size_t)row * 1024 + col); p.g = *(const uint4*)(GM + (size_t)row * 1024 + col); return p; }
    DI const float* ssq_src() const { return nullptr; } DI float pre(int) const { return 0.f; }
    DI float operator()(int row, int col, const float (&a)[8], const float (&)[8], float, const PF& p) const {
        float g[8], o[8]; unpk8(p.g, g); unpk8(p.t, o);
#pragma unroll
        for (int i = 0; i < 8; ++i) o[i] += g[i] * a[i];
        *(uint4*)(MRG + (size_t)row * 1024 + col) = pk8(o);
        return 0.f;
    }
};
struct EGate {
    static constexpr int ID = 7; static constexpr bool NEEDS_RS = true; static constexpr bool PAIRED = false;
    const float* ssq_in; bf16* GT;
    typedef PF0 PF; DI PF load(int, int) const { return PF0{}; }
    DI const float* ssq_src() const { return ssq_in; } DI float pre(int row) const { return rstd_of(ssq_in, row); }
    DI float operator()(int row, int col, const float (&a)[8], const float (&)[8], float rs, const PF&) const {
        float o[8];
#pragma unroll
        for (int i = 0; i < 8; ++i) o[i] = sigm(a[i] * rs);
        *(uint4*)(GT + (size_t)row * 1024 + col) = pk8(o);
        return 0.f;
    }
};
struct EPle {
    static constexpr int ID = 8; static constexpr bool NEEDS_RS = false; static constexpr bool PAIRED = false;
    const bf16* XBin; bf16* XBout; const bf16* GT; float scale;
    struct PF { uint4 x, g; };
    DI PF load(int row, int col) const { PF p; p.x = *(const uint4*)(XBin + (size_t)row * D + col); p.g = *(const uint4*)(GT + (size_t)row * 1024 + col); return p; }
    DI const float* ssq_src() const { return nullptr; } DI float pre(int) const { return 0.f; }
    DI float operator()(int row, int col, const float (&a)[8], const float (&)[8], float, const PF& p) const {
        float g[8], o[8]; unpk8(p.g, g); unpk8(p.x, o);
        float s = 0.f;
#pragma unroll
        for (int i = 0; i < 8; ++i) { o[i] += scale * g[i] * a[i]; s += o[i] * o[i]; }
        *(uint4*)(XBout + (size_t)row * D + col) = pk8(o);
        return s;
    }
};

template <class F>
DI void gemm_ref(const Ctx& c, const bf16* A, int lda, const bf16* Bt, int ldb, int Mrows, int Ncols, int K, const F& f, float* ssq_out) {
    const int ng = Ncols >> 3;
    const long items = (long)Mrows * ng;
    for (long it = c.gtid; it < items; it += c.gthreads) {
        const int row = (int)(it % Mrows), c0 = (int)(it / Mrows) * 8;
        float a[8], b[8];
#pragma unroll
        for (int j = 0; j < 8; ++j) { a[j] = 0.f; b[j] = 0.f; }
        const bf16* ar = A + (size_t)row * lda;
        const int br0 = F::PAIRED ? ((c0 >> 7) * 256 + (c0 & 127)) : c0;
        const bf16* br = Bt + (size_t)br0 * ldb;
        for (int k0 = 0; k0 < K; k0 += 8) {
            const uint4 av = *(const uint4*)(ar + k0);
#pragma unroll
            for (int j = 0; j < 8; ++j) {
                a[j] = dot8(av, *(const uint4*)(br + (size_t)j * ldb + k0), a[j]);
                if (F::PAIRED) b[j] = dot8(av, *(const uint4*)(br + (size_t)(128 + j) * ldb + k0), b[j]);
            }
        }
        (void)f(row, c0, a, b, f.pre(row), f.load(row, c0)); (void)ssq_out;
    }
}

DI void tr_mat(const Ctx& c, bf16* dst, int N, int K, const float* srcA, const float* srcB, int Nsrc, const float* gain, int mode, int cut, int skip) {
    const long total = (long)N * (K >> 3);
    for (long idx = c.gtid; idx < total; idx += c.gthreads) {
        const int n = (int)(idx % N), kg = (int)(idx / N);
        const float* s; int sc;
        if (mode == 1) { const int tile = n >> 8, l = n & 255; s = l < 128 ? srcA : srcB; sc = tile * 128 + (l & 127); }
        else { s = srcA; sc = n + (n >= cut ? skip : 0); }
        float v[8];
#pragma unroll
        for (int i = 0; i < 8; ++i) { const int k = kg * 8 + i; float w = s[(size_t)k * Nsrc + sc]; if (gain) w *= gain[k]; v[i] = w; }
        *(uint4*)(dst + (size_t)n * (K + PADK) + kg * 8) = pk8(v);
    }
}
DI void tr_tile(LAS float* scr, const float* W, int Nsrc, int scol0, const float* gain, bf16* dst, int K, int n0, int k0, int lane) {
    float wv[32];
#pragma unroll
    for (int i = 0; i < 32; ++i) wv[i] = W[(size_t)(k0 + 2 * i + (lane >> 5)) * Nsrc + scol0 + (lane & 31)];
    if (gain) {
#pragma unroll
        for (int i = 0; i < 32; ++i) wv[i] *= gain[k0 + 2 * i + (lane >> 5)];
    }
#pragma unroll
    for (int i = 0; i < 32; ++i) scr[(2 * i + (lane >> 5)) * 33 + (lane & 31)] = wv[i];
    asm volatile("s_waitcnt lgkmcnt(0)" ::: "memory");
    const int ch = lane & 7;
#pragma unroll
    for (int j = 0; j < 4; ++j) {
        const int n = (lane >> 3) + 8 * j; const LAS float* sp = scr + (8 * ch) * 33 + n;
        float v[8];
#pragma unroll
        for (int i = 0; i < 8; ++i) v[i] = sp[i * 33];
        *(uint4*)(dst + (size_t)(n0 + n) * (K + PADK) + k0 + 8 * ch) = pk8(v);
    }
    asm volatile("s_waitcnt lgkmcnt(0)" ::: "memory");
}
DI void stage_prologue(const Args& a, const Ctx& c, unsigned char* lds_) {
    LAS float* scr = (LAS float*)lds_ + c.wave * (64 * 33);
    constexpr int T_W1GU = 16 * 128, T_W1D = 32 * 32, T_WIN = 16 * (INN / 32), T_WGLU = 8 * 16, T_WS5UP = 8 * 32, T_SQ = 16 * 32, T_WPLE = 4 * 32;
    constexpr int T_LAYER = 2 * T_W1GU + 2 * T_W1D + T_WIN + T_WGLU + T_WS5UP + 3 * T_SQ + T_WPLE;
    for (int it = c.gwave; it < NL * T_LAYER; it += c.gwaves) {
        const int l = it / T_LAYER; int r = it % T_LAYER;
        unsigned char* lw = c.ws + WS_W + (size_t)l * LW_STRIDE;
        if (r < 2 * T_W1GU) {
            const int which = r / T_W1GU; r %= T_W1GU; const int kb = r / 128, nb = r % 128, n0 = nb * 32, tile = n0 >> 8, lrow = n0 & 255;
            const float* src = inptr(which ? (lrow < 128 ? I_W2G : I_W2U) : (lrow < 128 ? I_W1G : I_W1U)) + (size_t)l * D * FF;
            tr_tile(scr, src, FF, tile * 128 + (lrow & 127), inptr(which ? I_GFFN2 : I_GFFN1) + l * D, (bf16*)(lw + (which ? LW_W2GU : LW_W1GU)), 1024, n0, kb * 64, c.lane); continue; }
        r -= 2 * T_W1GU;
        if (r < 2 * T_W1D) { const int which = r / T_W1D; r %= T_W1D; const int kb = r / 32, nb = r % 32;
            tr_tile(scr, inptr(which ? I_W2D : I_W1D) + (size_t)l * FF * D, D, nb * 32, nullptr, (bf16*)(lw + (which ? LW_W2D : LW_W1D)), 2048, nb * 32, kb * 64, c.lane); continue; }
        r -= 2 * T_W1D;
        if (r < T_WIN) { const int kb = r / (INN / 32), nb = r % (INN / 32), n0 = nb * 32;
            tr_tile(scr, inptr(I_WIN) + (size_t)l * D * INC, INC, n0 + (n0 >= 4608 ? 8 : 0), inptr(I_GMIX) + l * D, (bf16*)(lw + LW_WIN), 1024, n0, kb * 64, c.lane); continue; }
        r -= T_WIN;
        if (r < T_WGLU) { const int kb = r / 16, nb = r % 16; tr_tile(scr, inptr(I_WGLU) + (size_t)l * 512 * 512, 512, nb * 32, nullptr, (bf16*)(lw + LW_WGLU), 512, nb * 32, kb * 64, c.lane); continue; }
        r -= T_WGLU;
        if (r < T_WS5UP) { const int kb = r / 32, nb = r % 32; tr_tile(scr, inptr(I_WS5UP) + (size_t)l * 512 * 1024, 1024, nb * 32, nullptr, (bf16*)(lw + LW_WS5UP), 512, nb * 32, kb * 64, c.lane); continue; }
        r -= T_WS5UP;
        if (r < 3 * T_SQ) { const int which = r / T_SQ; r %= T_SQ; const int kb = r / 32, nb = r % 32;
            const float* src = inptr(which == 0 ? I_WMUP : (which == 1 ? I_WOUT : I_WPG)) + (size_t)l * 1024 * 1024;
            const float* gain = which == 2 ? inptr(I_GPLE) + l * D : nullptr;
            tr_tile(scr, src, 1024, nb * 32, gain, (bf16*)(lw + (which == 0 ? LW_WMUP : (which == 1 ? LW_WOUT : LW_WPG))), 1024, nb * 32, kb * 64, c.lane); continue; }
        r -= 3 * T_SQ;
        { const int kb = r / 32, nb = r % 32; tr_tile(scr, inptr(I_WPLE) + (size_t)l * 256 * 1024, 1024, nb * 32, nullptr, (bf16*)(lw + LW_WPLE), 256, nb * 32, kb * 64, c.lane); }
    }
    for (int l = 0; l < NL; ++l) {
        float* wg = (float*)(c.ws + WS_W + (size_t)l * LW_STRIDE + LW_WG);
        for (int idx = c.gtid; idx < 8 * 1024; idx += c.gthreads) { const int j = idx >> 10, k = idx & 1023; wg[idx] = inptr(I_WIN)[(size_t)l * D * INC + (size_t)k * INC + 4608 + j] * inptr(I_GMIX)[l * D + k]; }
    }
    bf16* XB = wsb(c, WS_XB); float* ssq0 = ssq_ptr(c, 0);
    for (int row = c.gwave; row < M; row += c.gwaves) {
        const float* src = row < MP ? inptr(I_XP) + (size_t)row * D : inptr(I_XS) + (size_t)(row - MP) * D;
        float s = 0.f;
#pragma unroll
        for (int j = 0; j < 4; ++j) {
            const int col = (c.lane + 64 * j) * 4;
            const float4 v = *(const float4*)(src + col);
            uint2 w; w.x = pk2(v.x, v.y); w.y = pk2(v.z, v.w); *(uint2*)(XB + (size_t)row * D + col) = w;
            s += v.x * v.x + v.y * v.y + v.z * v.z + v.w * v.w;
        }
        s = wave_sum(s);
        if (c.lane < 16) ssq0[(size_t)row * 16 + c.lane] = c.lane == 0 ? s : 0.f;
    }
    bf16* PB = wsb(c, WS_PB);
    const long tp = (long)NL * M * (DPLE / 8);
    for (long idx = c.gtid; idx < tp; idx += c.gthreads) {
        const int cg = (int)(idx % (DPLE / 8)); const long rl = idx / (DPLE / 8); const int row = (int)(rl % M), l = (int)(rl / M);
        const float* src = row < MP ? inptr(I_PP) + ((size_t)l * MP + row) * DPLE + cg * 8 : inptr(I_PS) + ((size_t)l * MS + (row - MP)) * DPLE + cg * 8;
        const float4 a = *(const float4*)src, b = *(const float4*)(src + 4);
        float v[8] = {a.x, a.y, a.z, a.w, b.x, b.y, b.z, b.w};
        *(uint4*)(PB + ((size_t)l * M + row) * DPLE + cg * 8) = pk8(v);
    }
}

DI void conv_row(const float (&w)[4][8], const float (&bias)[8], const float (&x0)[8], const float (&x1)[8], const float (&x2)[8], const float (&x3)[8], int c0, size_t row, bf16* Q, bf16* Kb) {
    float o[8];
#pragma unroll
    for (int i = 0; i < 8; ++i) { const float v = bias[i] + w[0][i] * x0[i] + w[1][i] * x1[i] + w[2][i] * x2[i] + w[3][i] * x3[i]; o[i] = v * sigm(v) * (c0 < 1024 ? 0.0625f : 1.f); }
    if (c0 < 1024) *(uint4*)(Q + row * 1024 + c0) = pk8(o); else *(uint4*)(Kb + row * 1024 + (c0 - 1024)) = pk8(o);
}
DI void stage_conv(const Args& a, const Ctx& c, int l) {
    const bf16* QKR = wsb(c, WS_QKR); bf16* Q = wsb(c, WS_Q); bf16* Kb = wsb(c, WS_K);
    const float* cw = inptr(I_CONVW) + (size_t)l * 4 * 2048; const float* cb = inptr(I_CONVB) + (size_t)l * 2048;
    const float* st = inptr(I_CONV) + (size_t)l * NBS * 3 * 2048;
    constexpr int NPI = NBP * 256 * 64, NSI = NBS * 256;
    for (int it = c.gtid; it < NPI + NSI; it += c.gthreads) {
        const bool smp = it >= NPI; const int j = smp ? it - NPI : it, cg = j & 255, c0 = cg * 8;
        float w[4][8], bias[8];
#pragma unroll
        for (int q = 0; q < 4; ++q) { const float4 w0 = *(const float4*)(cw + q * 2048 + c0), w1 = *(const float4*)(cw + q * 2048 + c0 + 4); w[q][0] = w0.x; w[q][1] = w0.y; w[q][2] = w0.z; w[q][3] = w0.w; w[q][4] = w1.x; w[q][5] = w1.y; w[q][6] = w1.z; w[q][7] = w1.w; }
        { const float4 b0 = *(const float4*)(cb + c0), b1 = *(const float4*)(cb + c0 + 4); bias[0] = b0.x; bias[1] = b0.y; bias[2] = b0.z; bias[3] = b0.w; bias[4] = b1.x; bias[5] = b1.y; bias[6] = b1.z; bias[7] = b1.w; }
        float x0[8], x1[8], x2[8];
        if (!smp) {
            const int seg = (j >> 8) & 63, b = j >> 14, t0 = seg * 32; const size_t rb = (size_t)b * SEQ + t0;
            if (t0 == 0) {
#pragma unroll
                for (int i = 0; i < 8; ++i) { x0[i] = 0.f; x1[i] = 0.f; x2[i] = 0.f; }
            } else { unpk8(*(const uint4*)(QKR + (rb - 3) * 2048 + c0), x0); unpk8(*(const uint4*)(QKR + (rb - 2) * 2048 + c0), x1); unpk8(*(const uint4*)(QKR + (rb - 1) * 2048 + c0), x2); }
#pragma unroll 1
            for (int t8 = 0; t8 < 32; t8 += 8) {
                uint4 xr[8];
#pragma unroll
                for (int i = 0; i < 8; ++i) xr[i] = *(const uint4*)(QKR + (rb + t8 + i) * 2048 + c0);
#pragma unroll
                for (int i = 0; i < 8; ++i) {
                    float x3[8]; unpk8(xr[i], x3);
                    conv_row(w, bias, x0, x1, x2, x3, c0, rb + t8 + i, Q, Kb);
#pragma unroll
                    for (int e = 0; e < 8; ++e) { x0[e] = x1[e]; x1[e] = x2[e]; x2[e] = x3[e]; }
                }
            }
            if (seg == 63) {
                float* o = c.out + O_CONV_P + (((size_t)l * NBP + b) * 3) * 2048 + c0;
                *(float4*)o = make_float4(x0[0], x0[1], x0[2], x0[3]); *(float4*)(o + 4) = make_float4(x0[4], x0[5], x0[6], x0[7]);
                *(float4*)(o + 2048) = make_float4(x1[0], x1[1], x1[2], x1[3]); *(float4*)(o + 2048 + 4) = make_float4(x1[4], x1[5], x1[6], x1[7]);
                *(float4*)(o + 4096) = make_float4(x2[0], x2[1], x2[2], x2[3]); *(float4*)(o + 4096 + 4) = make_float4(x2[4], x2[5], x2[6], x2[7]);
            }
        } else {
            const int bs = j >> 8; const size_t rb = (size_t)MP + (size_t)bs * SS;
            const float* sp = st + (size_t)bs * 3 * 2048 + c0;
            { const float4 p0 = *(const float4*)sp, p1 = *(const float4*)(sp + 4); x0[0] = p0.x; x0[1] = p0.y; x0[2] = p0.z; x0[3] = p0.w; x0[4] = p1.x; x0[5] = p1.y; x0[6] = p1.z; x0[7] = p1.w; }
            { const float4 p0 = *(const float4*)(sp + 2048), p1 = *(const float4*)(sp + 2048 + 4); x1[0] = p0.x; x1[1] = p0.y; x1[2] = p0.z; x1[3] = p0.w; x1[4] = p1.x; x1[5] = p1.y; x1[6] = p1.z; x1[7] = p1.w; }
            { const float4 p0 = *(const float4*)(sp + 4096), p1 = *(const float4*)(sp + 4096 + 4); x2[0] = p0.x; x2[1] = p0.y; x2[2] = p0.z; x2[3] = p0.w; x2[4] = p1.x; x2[5] = p1.y; x2[6] = p1.z; x2[7] = p1.w; }
            uint4 xr[4];
#pragma unroll
            for (int i = 0; i < 4; ++i) xr[i] = *(const uint4*)(QKR + (rb + i) * 2048 + c0);
#pragma unroll
            for (int i = 0; i < 4; ++i) {
                float x3[8]; unpk8(xr[i], x3);
                conv_row(w, bias, x0, x1, x2, x3, c0, rb + i, Q, Kb);
#pragma unroll
                for (int e = 0; e < 8; ++e) { x0[e] = x1[e]; x1[e] = x2[e]; x2[e] = x3[e]; }
            }
            float* o = c.out + O_CONV_S + (((size_t)l * NBS + bs) * 3) * 2048 + c0;
            *(float4*)o = make_float4(x0[0], x0[1], x0[2], x0[3]); *(float4*)(o + 4) = make_float4(x0[4], x0[5], x0[6], x0[7]);
            *(float4*)(o + 2048) = make_float4(x1[0], x1[1], x1[2], x1[3]); *(float4*)(o + 2048 + 4) = make_float4(x1[4], x1[5], x1[6], x1[7]);
            *(float4*)(o + 4096) = make_float4(x2[0], x2[1], x2[2], x2[3]); *(float4*)(o + 4096 + 4) = make_float4(x2[4], x2[5], x2[6], x2[7]);
        }
    }
}

DI void stage_gates(const Args& a, const Ctx& c, int l, const float* ssq_in, const bf16* XB) {
    const float* wg = (const float*)(c.ws + WS_W + (size_t)l * LW_STRIDE + LW_WG);
    float* LI = wsf(c, WS_LI); float* LF = wsf(c, WS_LF);
    float w[8][16];
#pragma unroll
    for (int j = 0; j < 8; ++j)
#pragma unroll
        for (int q = 0; q < 4; ++q) { const float4 wv = *(const float4*)(wg + j * 1024 + c.lane * 16 + 4 * q); w[j][4 * q] = wv.x; w[j][4 * q + 1] = wv.y; w[j][4 * q + 2] = wv.z; w[j][4 * q + 3] = wv.w; }
    const float bi = c.lane < 4 ? inptr(I_BIG)[l * 4 + c.lane] : 0.f, bfg = c.lane < 4 ? inptr(I_BFG)[l * 4 + c.lane] : 0.f;
    int row = c.gwave;
    uint4 n0 = make_uint4(0, 0, 0, 0), n1 = n0;
    if (row < M) { n0 = *(const uint4*)(XB + (size_t)row * D + c.lane * 16); n1 = *(const uint4*)(XB + (size_t)row * D + c.lane * 16 + 8); }
    for (; row < M; row += c.gwaves) {
        float x[16];
        { float t0[8], t1[8]; unpk8(n0, t0); unpk8(n1, t1);
#pragma unroll
          for (int i = 0; i < 8; ++i) { x[i] = t0[i]; x[8 + i] = t1[i]; } }
        const int nr = row + c.gwaves;
        if (nr < M) { n0 = *(const uint4*)(XB + (size_t)nr * D + c.lane * 16); n1 = *(const uint4*)(XB + (size_t)nr * D + c.lane * 16 + 8); }
        float acc[8];
#pragma unroll
        for (int j = 0; j < 8; ++j) {
            float s = 0.f;
#pragma unroll
            for (int q = 0; q < 16; ++q) s += w[j][q] * x[q];
            acc[j] = wave_sum(s);
        }
        const float rstd = rstd_of(ssq_in, row);
        if (c.lane < 4) {
            float ig = acc[0]; ig = c.lane == 1 ? acc[1] : ig; ig = c.lane == 2 ? acc[2] : ig; ig = c.lane == 3 ? acc[3] : ig;
            float fg = acc[4]; fg = c.lane == 1 ? acc[5] : fg; fg = c.lane == 2 ? acc[6] : fg; fg = c.lane == 3 ? acc[7] : fg;
            LI[(size_t)row * 4 + c.lane] = ig * rstd + bi;
            const float z = fg * rstd + bfg;
            LF[(size_t)row * 4 + c.lane] = (z >= 0.f) ? -__logf(1.f + __expf(-z)) : (z - __logf(1.f + __expf(z)));
        }
    }
}

DI void stage_s5_ref(const Args& a, const Ctx& c, int l, unsigned char* lds) {
    float* hst = (float*)lds + c.wave * 128;
    const bf16* UP = wsb(c, WS_UP); const bf16* US = wsb(c, WS_US); bf16* YS5 = wsb(c, WS_YS5);
    const int nitems = (NBP + NBS) * NG;
    for (int it = (FAST_S5 ? NBP * NG : 0) + c.gwave; it < nitems; it += c.gwaves) {
        const int seq = it / NG, g = it % NG, n = c.lane;
        const float lre = inptr(I_LRE)[((size_t)l * NG + g) * NST + n], lim = inptr(I_LIM)[((size_t)l * NG + g) * NST + n];
        const float dt = expf(inptr(I_LDT)[l * NG + g]);
        const float mag = expf(lre * dt), ar = mag * cosf(lim * dt), ai = mag * sinf(lim * dt);
        const float den = lre * lre + lim * lim, pr = ar - 1.f;
        const float wre = (pr * lre + ai * lim) / den, wim = (ai * lre - pr * lim) / den;
        float bbr[16], bbi[16];
        { const float* bre = inptr(I_BRE) + (((size_t)l * NG + g) * NST + n) * 16; const float* bim = inptr(I_BIM) + (((size_t)l * NG + g) * NST + n) * 16;
#pragma unroll
          for (int j = 0; j < 16; ++j) { const float r = bre[j], i = bim[j]; bbr[j] = wre * r - wim * i; bbi[j] = wre * i + wim * r; } }
        const int hh = c.lane & 15, part = c.lane >> 4;
        float cre[16], cim[16];
        { const float* pr_ = inptr(I_CRE) + (((size_t)l * NG + g) * 16 + hh) * NST + part * 16; const float* pi_ = inptr(I_CIM) + (((size_t)l * NG + g) * 16 + hh) * NST + part * 16;
#pragma unroll
          for (int i = 0; i < 16; ++i) { cre[i] = pr_[i]; cim[i] = pi_[i]; } }
        const float dsk = inptr(I_S5D)[l * S5W + g * 16 + hh];
        float hr = 0.f, hi = 0.f; int S, row0;
        if (seq < NBP) { S = SEQ; row0 = seq * SEQ; }
        else { const int bs = seq - NBP; S = SS; row0 = MP + bs * SS; hr = inptr(I_S5RE)[(((size_t)l * NBS + bs) * NG + g) * NST + n]; hi = inptr(I_S5IM)[(((size_t)l * NBS + bs) * NG + g) * NST + n]; }
        for (int t = 0; t < S; ++t) {
            const int row = row0 + t;
            const bf16* up = row < MP ? UP + up_off(row, g * 16) : US + (size_t)(row - MP) * 512 + g * 16;
            float u[16];
            { float t0[8], t1[8]; unpk8(*(const uint4*)up, t0); unpk8(*(const uint4*)(up + 8), t1);
#pragma unroll
              for (int i = 0; i < 8; ++i) { u[i] = t0[i]; u[8 + i] = t1[i]; } }
            float bur = 0.f, bui = 0.f;
#pragma unroll
            for (int j = 0; j < 16; ++j) { bur += bbr[j] * u[j]; bui += bbi[j] * u[j]; }
            const float nr = ar * hr - ai * hi + bur, ni = ar * hi + ai * hr + bui;
            hr = nr; hi = ni;
            hst[2 * n] = hr; hst[2 * n + 1] = hi;
            asm volatile("s_waitcnt lgkmcnt(0)" ::: "memory");
            float y = 0.f;
#pragma unroll
            for (int i = 0; i < 16; ++i) { const float2 hv = *(const float2*)(hst + 2 * (part * 16 + i)); y += cre[i] * hv.x - cim[i] * hv.y; }
            asm volatile("s_waitcnt lgkmcnt(0)" ::: "memory");
            y += __shfl_xor(y, 16); y += __shfl_xor(y, 32);
            y += dsk * bf2f(up[hh]);
            if (c.lane < 16) YS5[(size_t)row * 512 + g * 16 + hh] = (bf16)f2bf(gelu_tanh(y));
        }
        float* ore = c.out + (seq < NBP ? O_S5RE_P + (((size_t)l * NBP + seq) * NG + g) * NST : O_S5RE_S + (((size_t)l * NBS + (seq - NBP)) * NG + g) * NST);
        float* oim = c.out + (seq < NBP ? O_S5IM_P + (((size_t)l * NBP + seq) * NG + g) * NST : O_S5IM_S + (((size_t)l * NBS + (seq - NBP)) * NG + g) * NST);
        ore[n] = hr; oim[n] = hi;
    }
}

DI void stage_s5_sample(const Args& a, const Ctx& c, int l, unsigned char* lds_) {
    LAS float* hst = (LAS float*)lds_ + c.wave * 128;
    const bf16* US = wsb(c, WS_US); bf16* YS5 = wsb(c, WS_YS5);
    for (int it = c.gwave; it < NG * (NBS / 2); it += c.gwaves) {
        const int g = it & 31, bsp = it >> 5, n = c.lane;
        const float lre = inptr(I_LRE)[((size_t)l * NG + g) * NST + n], lim = inptr(I_LIM)[((size_t)l * NG + g) * NST + n];
        const float dt = expf(inptr(I_LDT)[l * NG + g]);
        const float mag = expf(lre * dt), ar = mag * cosf(lim * dt), ai = mag * sinf(lim * dt);
        const float den = lre * lre + lim * lim, pr = ar - 1.f;
        const float wre = (pr * lre + ai * lim) / den, wim = (ai * lre - pr * lim) / den;
        float bbr[16], bbi[16];
        { const float4* bre = (const float4*)(inptr(I_BRE) + (((size_t)l * NG + g) * NST + n) * 16); const float4* bim = (const float4*)(inptr(I_BIM) + (((size_t)l * NG + g) * NST + n) * 16);
#pragma unroll
          for (int j = 0; j < 4; ++j) { const float4 r = bre[j], i = bim[j];
              bbr[4 * j] = wre * r.x - wim * i.x; bbi[4 * j] = wre * i.x + wim * r.x; bbr[4 * j + 1] = wre * r.y - wim * i.y; bbi[4 * j + 1] = wre * i.y + wim * r.y;
              bbr[4 * j + 2] = wre * r.z - wim * i.z; bbi[4 * j + 2] = wre * i.z + wim * r.z; bbr[4 * j + 3] = wre * r.w - wim * i.w; bbi[4 * j + 3] = wre * i.w + wim * r.w; } }
        const int hh = c.lane & 15, part = c.lane >> 4;
        float cre[16], cim[16];
        { const float4* pr_ = (const float4*)(inptr(I_CRE) + (((size_t)l * NG + g) * 16 + hh) * NST + part * 16); const float4* pi_ = (const float4*)(inptr(I_CIM) + (((size_t)l * NG + g) * 16 + hh) * NST + part * 16);
#pragma unroll
          for (int i = 0; i < 4; ++i) { const float4 r = pr_[i], m = pi_[i]; cre[4 * i] = r.x; cre[4 * i + 1] = r.y; cre[4 * i + 2] = r.z; cre[4 * i + 3] = r.w; cim[4 * i] = m.x; cim[4 * i + 1] = m.y; cim[4 * i + 2] = m.z; cim[4 * i + 3] = m.w; } }
        const float dsk = inptr(I_S5D)[l * S5W + g * 16 + hh];
#pragma unroll 1
        for (int s2 = 0; s2 < 2; ++s2) {
            const int bs = 2 * bsp + s2;
            float hr = inptr(I_S5RE)[(((size_t)l * NBS + bs) * NG + g) * NST + n], hi = inptr(I_S5IM)[(((size_t)l * NBS + bs) * NG + g) * NST + n];
#pragma unroll
            for (int t = 0; t < SS; ++t) {
                const int row = MP + bs * SS + t;
                const bf16* up = US + (size_t)(row - MP) * 512 + g * 16;
                float u[16];
                { float t0[8], t1[8]; unpk8(*(const uint4*)up, t0); unpk8(*(const uint4*)(up + 8), t1);
#pragma unroll
                  for (int i = 0; i < 8; ++i) { u[i] = t0[i]; u[8 + i] = t1[i]; } }
                float bur = 0.f, bui = 0.f;
#pragma unroll
                for (int j = 0; j < 16; ++j) { bur += bbr[j] * u[j]; bui += bbi[j] * u[j]; }
                const float nr = ar * hr - ai * hi + bur, ni = ar * hi + ai * hr + bui;
                hr = nr; hi = ni;
                hst[2 * n] = hr; hst[2 * n + 1] = hi;
                asm volatile("s_waitcnt lgkmcnt(0)" ::: "memory");
                float y = 0.f;
#pragma unroll
                for (int i = 0; i < 16; ++i) { const float hvx = hst[2 * (part * 16 + i)], hvy = hst[2 * (part * 16 + i) + 1]; y += cre[i] * hvx - cim[i] * hvy; }
                asm volatile("s_waitcnt lgkmcnt(0)" ::: "memory");
                y += __shfl_xor(y, 16); y += __shfl_xor(y, 32);
                y += dsk * bf2f(up[hh]);
                if (c.lane < 16) YS5[(size_t)row * 512 + g * 16 + hh] = (bf16)f2bf(gelu_tanh(y));
            }
            c.out[O_S5RE_S + (((size_t)l * NBS + bs) * NG + g) * NST + n] = hr;
            c.out[O_S5IM_S + (((size_t)l * NBS + bs) * NG + g) * NST + n] = hi;
        }
    }
}

DI void stage_mlstm_ref(const Args& a, const Ctx& c, int l, unsigned char* lds) {
    float* Cs = (float*)lds;
    float* ns = Cs + 256 * 64;
    float* red = ns + 256;
    float* nqr = red + 512;
    const bf16* Q = wsb(c, WS_Q); const bf16* Kb = wsb(c, WS_K); const bf16* V = wsb(c, WS_V);
    const float* LI = wsf(c, WS_LI); const float* LF = wsf(c, WS_LF); float* Hh = wsf(c, WS_H);
    const int v = c.tid & 63, kg = c.tid >> 6;
    const int nitems = (NBP + NBS) * NH * 4;
    for (int it = c.blk; it < nitems; it += c.nblk) {
        const int seq = it >> 4, h = (it >> 2) & 3, vb = it & 3;
        int S, row0; float m = 0.f;
        __syncthreads();
        if (seq < NBP) {
            S = SEQ; row0 = seq * SEQ;
#pragma unroll 4
            for (int kk = 0; kk < 32; ++kk) Cs[(kg * 32 + kk) * 64 + v] = 0.f;
            if (c.tid < 256) ns[c.tid] = 0.f;
        } else {
            const int bs = seq - NBP; S = SS; row0 = MP + bs * SS;
            const float* c0 = inptr(I_MC) + (((size_t)l * NBS + bs) * NH + h) * DH * DH;
#pragma unroll 4
            for (int kk = 0; kk < 32; ++kk) Cs[(kg * 32 + kk) * 64 + v] = c0[(size_t)(kg * 32 + kk) * DH + vb * 64 + v];
            if (c.tid < 256) ns[c.tid] = inptr(I_MN)[(((size_t)l * NBS + bs) * NH + h) * DH + c.tid];
            m = inptr(I_MM)[((size_t)l * NBS + bs) * NH + h];
        }
        __syncthreads();
        for (int t = 0; t < S; ++t) {
            const int row = row0 + t;
            const float li = LI[(size_t)row * 4 + h], lf = LF[(size_t)row * 4 + h];
            const float mn = fmaxf(lf + m, li), fd = __expf(lf + m - mn), iw = __expf(li - mn);
            m = mn;
            const bf16* qp = Q + (size_t)row * 1024 + h * 256; const bf16* kp = Kb + (size_t)row * 1024 + h * 256;
            const float vv = bf2f(V[(size_t)row * 1024 + h * 256 + vb * 64 + v]) * iw;
            float part = 0.f;
#pragma unroll
            for (int q8 = 0; q8 < 4; ++q8) {
                float qf[8], kf[8];
                unpk8(*(const uint4*)(qp + kg * 32 + q8 * 8), qf); unpk8(*(const uint4*)(kp + kg * 32 + q8 * 8), kf);
#pragma unroll
                for (int i = 0; i < 8; ++i) { float* cp = Cs + (kg * 32 + q8 * 8 + i) * 64 + v; const float cn = fd * (*cp) + kf[i] * vv; *cp = cn; part += qf[i] * cn; }
            }
            red[kg * 64 + v] = part;
            if (c.tid < 256) {
                const float nn = fd * ns[c.tid] + iw * bf2f(kp[c.tid]); ns[c.tid] = nn;
                const float pq = wave_sum(bf2f(qp[c.tid]) * nn);
                if (c.lane == 0) nqr[c.wave] = pq;
            }
            __syncthreads();
            if (c.tid < 64) {
                float num = 0.f;
#pragma unroll
                for (int g8 = 0; g8 < 8; ++g8) num += red[g8 * 64 + c.tid];
                const float nq = (nqr[0] + nqr[1]) + (nqr[2] + nqr[3]);
                Hh[(size_t)row * 1024 + h * 256 + vb * 64 + c.tid] = num / fmaxf(fabsf(nq), __expf(-m));
            }
            __syncthreads();
        }
        float* oc = c.out + (seq < NBP ? O_C_P + (((size_t)l * NBP + seq) * NH + h) * DH * DH : O_C_S + (((size_t)l * NBS + (seq - NBP)) * NH + h) * DH * DH);
#pragma unroll 4
        for (int kk = 0; kk < 32; ++kk) oc[(size_t)(kg * 32 + kk) * DH + vb * 64 + v] = Cs[(kg * 32 + kk) * 64 + v];
        if (vb == 0) {
            float* on = c.out + (seq < NBP ? O_N_P + (((size_t)l * NBP + seq) * NH + h) * DH : O_N_S + (((size_t)l * NBS + (seq - NBP)) * NH + h) * DH);
            if (c.tid < 256) on[c.tid] = ns[c.tid];
            if (c.tid == 0) { float* om = c.out + (seq < NBP ? O_M_P + ((size_t)l * NBP + seq) * NH + h : O_M_S + ((size_t)l * NBS + (seq - NBP)) * NH + h); *om = m; }
        }
    }
    __syncthreads();
}

DI void stage_headnorm(const Args& a, const Ctx& c, int l, int row_lo) {
    const float* Hh = wsf(c, WS_H); const bf16* OS = wsb(c, WS_OS); bf16* HM = wsb(c, WS_HM);
    const float* gm = inptr(I_GMH) + (size_t)l * MW;
    for (int it = row_lo * NH + c.gwave; it < M * NH; it += c.gwaves) {
        const int row = it >> 2, h = it & 3; const size_t off = (size_t)row * 1024 + h * 256 + c.lane * 4;
        const float4 x = *(const float4*)(Hh + off);
        const float ss = wave_sum(x.x * x.x + x.y * x.y + x.z * x.z + x.w * x.w);
        const float rs = rsqrtf(ss * (1.f / DH) + EPS);
        const float4 g = *(const float4*)(gm + h * 256 + c.lane * 4);
        const uint2 ow = *(const uint2*)(OS + off);
        uint2 w; w.x = pk2(x.x * rs * g.x * bflo(ow.x), x.y * rs * g.y * bfhi(ow.x)); w.y = pk2(x.z * rs * g.z * bflo(ow.y), x.w * rs * g.w * bfhi(ow.y));
        *(uint2*)(HM + off) = w;
    }
}

DI void stage_final(const Args& a, const Ctx& c, const bf16* XB) {
    const float* ssq = ssq_ptr(c, 16); const float* gf = inptr(I_GFIN);
    for (int row = c.gwave; row < M; row += c.gwaves) {
        const float rstd = rstd_of(ssq, row);
#pragma unroll
        for (int j = 0; j < 2; ++j) {
            const int col = (c.lane + 64 * j) * 8;
            float x[8]; unpk8(*(const uint4*)(XB + (size_t)row * D + col), x);
            const float4 g0 = *(const float4*)(gf + col), g1 = *(const float4*)(gf + col + 4);
            float* o = c.out + O_Y + (size_t)row * D + col;
            *(float4*)o = make_float4(x[0] * rstd * g0.x, x[1] * rstd * g0.y, x[2] * rstd * g0.z, x[3] * rstd * g0.w);
            *(float4*)(o + 4) = make_float4(x[4] * rstd * g1.x, x[5] * rstd * g1.y, x[6] * rstd * g1.z, x[7] * rstd * g1.w);
        }
    }
}

DI void stage_ssq(const Ctx& c, float* ssq_out, const bf16* XB) {
    for (int row = c.gwave; row < M; row += c.gwaves) {
        float s = 0.f;
#pragma unroll
        for (int j = 0; j < 2; ++j) { float x[8]; unpk8(*(const uint4*)(XB + (size_t)row * D + (c.lane + 64 * j) * 8), x);
#pragma unroll
            for (int i = 0; i < 8; ++i) s += x[i] * x[i]; }
        s = wave_sum(s);
        if (c.lane < 16) ssq_out[(size_t)row * 16 + c.lane] = c.lane == 0 ? s : 0.f;
    }
}

template <class F> struct EpiA {
    static constexpr bool PERM = true, AFTER_DRAIN = false;
    F f; float* ssq_part;
    LAS float* rc;
    DI void operator()(const pg8::f32x4 (&acc)[2][2][4][2], const pg8::Unit& u, int wr, int wc, int fr, int fq, int ui) const {
        float rsv[8];
        if (F::NEEDS_RS) {
            bool hit = false;
            if (ui != 0) { const int tg = ((const LAS int*)rc)[256]; hit = (tg & 0xffff) == u.pm && (tg >> 16) <= ui; }
            if (hit) {
#pragma unroll
                for (int i = 0; i < 8; ++i) rsv[i] = rc[(i >> 2) * 128 + wr * 64 + (i & 3) * 16 + fr];
            } else {
                const float* P = f.ssq_src(); pg8::f32x4 q[8];
#pragma unroll
                for (int i = 0; i < 8; ++i) q[i] = *(const pg8::f32x4*)(P + (size_t)(u.pm * 256 + (i >> 2) * 128 + wr * 64 + (i & 3) * 16 + fr) * 16 + 4 * fq);
#pragma unroll
                for (int i = 0; i < 8; ++i) { float t = (q[i][0] + q[i][1]) + (q[i][2] + q[i][3]); t += __shfl_xor(t, 16); t += __shfl_xor(t, 32); rsv[i] = rsqrtf(t * (1.f / D) + EPS); }
                if (wc == 0 && fq == 0) {
#pragma unroll
                    for (int i = 0; i < 8; ++i) rc[(i >> 2) * 128 + wr * 64 + (i & 3) * 16 + fr] = rsv[i];
                    if (wr == 0 && fr == 0) ((LAS int*)rc)[256] = u.pm | ((ui + 1) << 16);
                }
            }
        } else {
#pragma unroll
            for (int i = 0; i < 8; ++i) rsv[i] = 0.f;
        }
        constexpr int NC = F::PAIRED ? 8 : 16;
        constexpr int PD = sizeof(typename F::PF) <= 4 ? 1 : (sizeof(typename F::PF) <= 16 ? 8 : 4);
        const int colb = F::PAIRED ? (u.pn * 128 + wc * 32 + 8 * fq) : (u.pn * 256 + wc * 32 + 8 * fq);
        typename F::PF ring[PD];
#pragma unroll
        for (int q = 0; q < PD && q < NC; ++q) {
            const int g8n = F::PAIRED ? q : (q >> 1), bjn = F::PAIRED ? 0 : (q & 1);
            int rown = u.pm * 256 + (g8n >> 2) * 128 + wr * 64 + (g8n & 3) * 16 + fr; asm volatile("" : "+v"(rown)); ring[q] = f.load(rown, colb + bjn * 128);
        }
        float srow = 0.f;
#pragma unroll
        for (int q = 0; q < NC; ++q) {
            const int g8 = F::PAIRED ? q : (q >> 1), bj = F::PAIRED ? 0 : (q & 1), ai = g8 >> 2, m = g8 & 3;
            int row = u.pm * 256 + ai * 128 + wr * 64 + m * 16 + fr; asm volatile("" : "+v"(row));
            const typename F::PF pf = ring[q % PD];
            if (q + PD < NC) { const int g8n = F::PAIRED ? (q + PD) : ((q + PD) >> 1), bjn = F::PAIRED ? 0 : ((q + PD) & 1);
                               int rown = u.pm * 256 + (g8n >> 2) * 128 + wr * 64 + (g8n & 3) * 16 + fr; asm volatile("" : "+v"(rown)); ring[q % PD] = f.load(rown, colb + bjn * 128); }
            const float rs = rsv[g8];
            float s;
            if (F::PAIRED) {
                const float a[8] = {acc[ai][0][m][0][0], acc[ai][0][m][0][1], acc[ai][0][m][0][2], acc[ai][0][m][0][3], acc[ai][0][m][1][0], acc[ai][0][m][1][1], acc[ai][0][m][1][2], acc[ai][0][m][1][3]};
                const float b[8] = {acc[ai][1][m][0][0], acc[ai][1][m][0][1], acc[ai][1][m][0][2], acc[ai][1][m][0][3], acc[ai][1][m][1][0], acc[ai][1][m][1][1], acc[ai][1][m][1][2], acc[ai][1][m][1][3]};
                s = f(row, colb, a, b, rs, pf);
            } else {
                const float a[8] = {acc[ai][bj][m][0][0], acc[ai][bj][m][0][1], acc[ai][bj][m][0][2], acc[ai][bj][m][0][3], acc[ai][bj][m][1][0], acc[ai][bj][m][1][1], acc[ai][bj][m][1][2], acc[ai][bj][m][1][3]};
                s = f(row, colb + bj * 128, a, a, rs, pf);
            }
            srow = (F::PAIRED || bj == 0) ? s : srow + s;
            if (ssq_part && (F::PAIRED || bj == 1)) { float t = srow; t += __shfl_xor(t, 16); t += __shfl_xor(t, 32); if (fq == 0) ssq_part[(size_t)row * 16 + u.pn * 4 + wc] = t; }
            asm volatile("" ::: "memory");
        }
    }
};
template <class F>
DI void gemm_fast(const Ctx& c, unsigned char* lds, const bf16* A, int lda, const bf16* Bt, int ldb, int Mrows, int Nbt, int K, const F& f, float* ssq_part) {
    pg8::Gemm g{A, Bt, Mrows, Nbt, K, lda, ldb};
    pg8::StaticOrder S; S.init(Mrows, Nbt, c.nblk, c.blk);
    EpiA<F> E{f, ssq_part, (LAS float*)((LAS unsigned char*)lds + pg8::STAGE_BYTES)};
    pg8::gemm_phase<EpiA<F>, pg8::StaticOrder, GEMM_ALIGN, true>((PG8_LAS unsigned char*)lds, g, S, E, c.tid);
}

template <class F, int WR, int TR, int WC, int KS>
DI void gemm_thin(const Ctx& c, unsigned char* lds_, const bf16* A, int lda, const bf16* Bt, int ldb, int Ncols, int K, const F& f, float* ssq_part) {
    static_assert(WR * WC * KS == 8, "eight waves");
    constexpr int NB = F::PAIRED ? 4 : 2, UR = WR * TR * 16, UC = WC * 32, UB = F::PAIRED ? 2 * UC : UC, RT = UR + UB, NRB = MS / UR, NI = RT * 32 / NTHR, TP = 528;
    static_assert(RT * 32 % NTHR == 0 && RT * TP + 8192 + 1024 <= MISC_OFF, "thin GEMM LDS map");
    LAS unsigned char* lds = (LAS unsigned char*)lds_;
    LAS unsigned char* sA = lds; LAS unsigned char* sB = lds + UR * TP;
    LAS pg8::f32x4* red = (LAS pg8::f32x4*)(lds + RT * TP);
    LAS float* ssqr = (LAS float*)(lds + RT * TP + 8192);
    const int tid = c.tid, lane = c.lane, l15 = lane & 15, q4 = lane >> 4, w = c.wave, wc = w % WC, wr = (w / WC) % WR, ks = w / (WC * WR), wg = w % (WC * WR);
    const int ncb = Ncols / UC, nch = K >> 8;
    const int upx = (NRB * ncb) >> 3, xcd = c.blk & 7, bpx = c.nblk >> 3;
    for (int ui = c.blk >> 3; ui < upx; ui += bpx) {
        const int u = xcd * upx + ui;
        const int rb = u % NRB, cb = u / NRB, r0u = rb * UR, c0u = cb * UC;
        const bf16* src[NI];
#pragma unroll
        for (int i = 0; i < NI; ++i) {
            const int it = tid + NTHR * i, row = it >> 5, seg = it & 31;
            if (row < UR) src[i] = A + (size_t)(r0u + row) * lda + seg * 8;
            else { const int j = row - UR; int brow;
                   if (F::PAIRED) brow = (c0u >> 7) * 256 + (c0u & 127) + (j < UC ? j : 128 + (j - UC)); else brow = c0u + j;
                   src[i] = Bt + (size_t)brow * ldb + seg * 8; }
        }
        uint4 pre[NI];
#pragma unroll
        for (int i = 0; i < NI; ++i) pre[i] = *(const uint4*)(src[i]);
        pg8::f32x4 acc[TR][NB];
#pragma unroll
        for (int tr = 0; tr < TR; ++tr)
#pragma unroll
            for (int n = 0; n < NB; ++n) acc[tr][n] = (pg8::f32x4){0.f, 0.f, 0.f, 0.f};
        float prv[TR]; typename F::PF pfv[TR];
#pragma unroll
        for (int tr = 0; tr < TR; ++tr) { const int row = MP + r0u + wr * TR * 16 + tr * 16 + l15, col = c0u + wc * 32 + 8 * q4; prv[tr] = f.pre(row); pfv[tr] = f.load(row, col); }
        for (int kc = 0; kc < nch; ++kc) {
            lds_sync();
#pragma unroll
            for (int i = 0; i < NI; ++i) { const int it = tid + NTHR * i; *(LAS u32x4t*)(lds + (it >> 5) * TP + (it & 31) * 16) = (u32x4t){pre[i].x, pre[i].y, pre[i].z, pre[i].w}; }
            lds_sync();
            if (kc + 1 < nch) {
#pragma unroll
                for (int i = 0; i < NI; ++i) pre[i] = *(const uint4*)(src[i] + (kc + 1) * 256);
            }
#pragma unroll
            for (int kk = 0; kk < 8 / KS; ++kk) {
                const int kof = ((ks * (8 / KS) + kk) * 32 + 8 * q4) * 2;
                pg8::bf16x8 av[TR], bv[NB];
#pragma unroll
                for (int tr = 0; tr < TR; ++tr) av[tr] = *(const LAS pg8::bf16x8*)(sA + (wr * TR * 16 + tr * 16 + l15) * TP + kof);
#pragma unroll
                for (int n = 0; n < NB; ++n) bv[n] = *(const LAS pg8::bf16x8*)(sB + (wc * 32 + 8 * (l15 >> 2) + 4 * (n & 1) + (l15 & 3) + (n >> 1) * UC) * TP + kof);
#pragma unroll
                for (int tr = 0; tr < TR; ++tr)
#pragma unroll
                    for (int n = 0; n < NB; ++n) acc[tr][n] = __builtin_amdgcn_mfma_f32_16x16x32_bf16(bv[n], av[tr], acc[tr][n], 0, 0, 0);
            }
        }
        const int r0 = r0u + wr * TR * 16, c0 = c0u + wc * 32;
        if (KS > 1) {
            lds_sync();
            if (ks > 0) {
#pragma unroll
                for (int tr = 0; tr < TR; ++tr)
#pragma unroll
                    for (int n = 0; n < NB; ++n) red[(((ks - 1) * (WR * WC) + wg) * (TR * NB) + tr * NB + n) * 64 + lane] = acc[tr][n];
            }
            lds_sync();
            if (ks == 0) {
#pragma unroll
                for (int kk = 1; kk < KS; ++kk)
#pragma unroll
                    for (int tr = 0; tr < TR; ++tr)
#pragma unroll
                        for (int n = 0; n < NB; ++n) acc[tr][n] += red[(((kk - 1) * (WR * WC) + wg) * (TR * NB) + tr * NB + n) * 64 + lane];
            }
        }
        float ssv[TR];
#pragma unroll
        for (int tr = 0; tr < TR; ++tr) {
            ssv[tr] = 0.f;
            if (ks == 0) {
                const int row = MP + r0 + tr * 16 + l15, col = c0 + 8 * q4;
                const float a8[8] = {acc[tr][0][0], acc[tr][0][1], acc[tr][0][2], acc[tr][0][3], acc[tr][1][0], acc[tr][1][1], acc[tr][1][2], acc[tr][1][3]};
                if (F::PAIRED) { const float b8[8] = {acc[tr][NB - 2][0], acc[tr][NB - 2][1], acc[tr][NB - 2][2], acc[tr][NB - 2][3], acc[tr][NB - 1][0], acc[tr][NB - 1][1], acc[tr][NB - 1][2], acc[tr][NB - 1][3]}; ssv[tr] = f(row, col, a8, b8, prv[tr], pfv[tr]); }
                else ssv[tr] = f(row, col, a8, a8, prv[tr], pfv[tr]);
            }
        }
        if (ssq_part) {
            lds_sync();
#pragma unroll
            for (int tr = 0; tr < TR; ++tr) { float s = ssv[tr]; s += __shfl_xor(s, 16); s += __shfl_xor(s, 32); if (ks == 0 && q4 == 0) ssqr[wc * UR + wr * TR * 16 + tr * 16 + l15] = s; }
            lds_sync();
            if (c.tid < UR) ssq_part[(size_t)(MP + rb * UR + c.tid) * 16 + cb] = ssqr[c.tid] + ssqr[UR + c.tid];
        }
    }
}
typedef short s16x4 __attribute__((ext_vector_type(4)));
using pg8::bf16x8; using pg8::f32x4;
constexpr int PT = 528, PHB = 272;
constexpr int L_Q = 0, L_P = 0, L_VH = 35840, L_K = 71680, L_F = 139264;
constexpr int F_AL = 0, F_PM = 128, F_BT = 256, F_QN = 384, F_NQP = 512, F_SUM = 1024  , F_NP = 1056, F_SSP = 1312, F_END = 1824;
static_assert(L_P + 128 * PHB <= L_VH && L_VH + 128 * PHB <= L_K && L_K + 128 * PT <= L_F && L_F + F_END * 4 <= MISC_OFF, "mLSTM LDS map");
constexpr size_t UNIT_E = 65536;

#define MFMA16(a, b, c) __builtin_amdgcn_mfma_f32_16x16x32_bf16((a), (b), (c), 0, 0, 0)
#define TR_2F(o, a, P4) asm volatile("ds_read_b64_tr_b16 %0, %4\n\tds_read_b64_tr_b16 %1, %4 offset:" #P4 "\n\tds_read_b64_tr_b16 %2, %4 offset:32\n\tds_read_b64_tr_b16 %3, %4 offset:32+" #P4 "\n\ts_waitcnt lgkmcnt(0)" \
    : "=&v"(o[0]), "=&v"(o[1]), "=&v"(o[2]), "=&v"(o[3]) : "v"(a) : "memory")
#define TR_4F(o, a, P4) asm volatile("ds_read_b64_tr_b16 %0, %8\n\tds_read_b64_tr_b16 %1, %8 offset:" #P4 "\n\tds_read_b64_tr_b16 %2, %8 offset:32\n\tds_read_b64_tr_b16 %3, %8 offset:32+" #P4 "\n\t" \
    "ds_read_b64_tr_b16 %4, %8 offset:64\n\tds_read_b64_tr_b16 %5, %8 offset:64+" #P4 "\n\tds_read_b64_tr_b16 %6, %8 offset:96\n\tds_read_b64_tr_b16 %7, %8 offset:96+" #P4 "\n\ts_waitcnt lgkmcnt(0)" \
    : "=&v"(o[0]), "=&v"(o[1]), "=&v"(o[2]), "=&v"(o[3]), "=&v"(o[4]), "=&v"(o[5]), "=&v"(o[6]), "=&v"(o[7]) : "v"(a) : "memory")
typedef unsigned u32x4n __attribute__((ext_vector_type(4)));
typedef unsigned u32x2n __attribute__((ext_vector_type(2)));
DI uint4 lds_ld16(const LAS unsigned char* p) { const u32x4n v = *(const LAS u32x4n*)p; return make_uint4(v[0], v[1], v[2], v[3]); }
DI void lds_st16(LAS unsigned char* p, uint4 v) { *(LAS u32x4n*)p = (u32x4n){v.x, v.y, v.z, v.w}; }
DI void lds_st8(LAS unsigned char* p, uint2 v) { *(LAS u32x2n*)p = (u32x2n){v.x, v.y}; }
DI f32x4 lds_ldf4(const LAS float* p) { return *(const LAS f32x4*)p; }
DI void lds_stf4(LAS float* p, float4 v) { *(LAS f32x4*)p = (f32x4){v.x, v.y, v.z, v.w}; }
DI bf16x8 cat8(s16x4 lo, s16x4 hi) { return __builtin_shufflevector(lo, hi, 0, 1, 2, 3, 4, 5, 6, 7); }

DI void load_tile(LAS unsigned char* lds, int lbase, int lpitch, const bf16* g, int gpitch, int rows, int lgc, int tid) {
    const int total = rows << lgc;
    for (int idx = tid; idx < total; idx += NTHR) {
        const int r = idx >> lgc, chn = idx & ((1 << lgc) - 1);
        const uint4 v = *(const uint4*)(g + (size_t)r * gpitch + chn * 8);
        lds_st16(lds + lbase + r * lpitch + chn * 16, v);
    }
}
template <int NI> DI void tile_fetch(uint4 (&r)[NI], const bf16* g, int gpitch, int lgc, int tid) {
#pragma unroll
    for (int i = 0; i < NI; ++i) { const int idx = tid + NTHR * i, rr = idx >> lgc, chn = idx & ((1 << lgc) - 1); r[i] = *(const uint4*)(g + (size_t)rr * gpitch + chn * 8); }
}
template <int NI> DI void tile_store(LAS unsigned char* lds, int lbase, int lpitch, const uint4 (&r)[NI], int lgc, int tid) {
#pragma unroll
    for (int i = 0; i < NI; ++i) { const int idx = tid + NTHR * i, rr = idx >> lgc, chn = idx & ((1 << lgc) - 1); lds_st16(lds + lbase + rr * lpitch + chn * 16, r[i]); }
}
DI void gate_part1(const float* LI, const float* LF, int seq_row0, int h, int ch, LAS float* F, int lane, int wave) {
#pragma unroll
    for (int rep = 0; rep < 2; ++rep) {
        const int cc = wave + 8 * rep;
        if (cc <= ch) {
            const size_t r0 = (size_t)(seq_row0 + cc * 128 + 2 * lane);
            const float lf0 = LF[r0 * 4 + h], lf1 = LF[(r0 + 1) * 4 + h], li0 = LI[r0 * 4 + h], li1 = LI[(r0 + 1) * 4 + h];
            const float ps = lf0 + lf1; float incl = ps;
#pragma unroll
            for (int o = 1; o < 64; o <<= 1) { const float t = __shfl_up(incl, o); if (lane >= o) incl += t; }
            const float b0 = (incl - ps) + lf0, b1 = incl;
            const float a0 = li0 - b0, a1 = li1 - b1;
            float cm = fmaxf(a0, a1);
#pragma unroll
            for (int o = 1; o < 64; o <<= 1) { const float t = __shfl_up(cm, o); if (lane >= o) cm = fmaxf(cm, t); }
            if (lane == 63) { F[F_SUM + 2 * cc] = incl; F[F_SUM + 2 * cc + 1] = cm; }
            if (cc == ch) {
                float prev = __shfl_up(cm, 1); if (lane == 0) prev = -3.0e38f;
                F[F_AL + 2 * lane] = a0; F[F_AL + 2 * lane + 1] = a1;
                F[F_PM + 2 * lane] = fmaxf(prev, a0); F[F_PM + 2 * lane + 1] = cm;
                F[F_BT + 2 * lane] = b0; F[F_BT + 2 * lane + 1] = b1;
            }
        }
    }
}
DI float gate_mprev(const LAS float* F, int ch) {
    float m = 0.f;
    for (int cc = 0; cc < ch; ++cc) m = F[F_SUM + 2 * cc] + fmaxf(m, F[F_SUM + 2 * cc + 1]);
    return m;
}

template <int PM>
DI void mlstm_A_unit(const Ctx& c, unsigned char* lds_, int u) {
    LAS unsigned char* lds = (LAS unsigned char*)lds_;
    LAS float* F = (LAS float*)(lds + L_F);
    const unsigned ldsb = (unsigned)(size_t)lds_;
    const int b = u >> 6, h = (u >> 4) & 3, ch = u & 15, row0 = b * SEQ + ch * 128;
    const int tid = c.tid, lane = c.lane, wr = c.wave >> 2, wc = c.wave & 3, l15 = lane & 15, q4 = lane >> 4;
    const bf16* Qg = wsb(c, WS_Q) + (size_t)row0 * 1024 + h * 256; const bf16* Kg = wsb(c, WS_K) + (size_t)row0 * 1024 + h * 256; const bf16* Vg = wsb(c, WS_V) + (size_t)row0 * 1024 + h * 256;
    { uint4 tq[8], tk[8];
      tile_fetch<8>(tq, Qg, 1024, 5, tid); tile_fetch<8>(tk, Kg, 1024, 5, tid);
      tile_store<8>(lds, L_Q, PT, tq, 5, tid); tile_store<8>(lds, L_K, PT, tk, 5, tid); }
    uint4 vpre[4]; tile_fetch<4>(vpre, Vg, 1024, 4, tid);
    gate_part1(wsf(c, WS_LI), wsf(c, WS_LF), b * SEQ, h, ch, F, lane, c.wave);
    lds_sync();
    const float mprev = gate_mprev(F, ch), pml = fmaxf(mprev, F[F_SUM + 2 * ch + 1]), blast = F[F_SUM + 2 * ch];
    f32x4 acc[2][4];
#pragma unroll
    for (int si = 0; si < 2; ++si)
#pragma unroll
        for (int ti = 0; ti < 4; ++ti) acc[si][ti] = (f32x4){0.f, 0.f, 0.f, 0.f};
#pragma unroll 4
    for (int ks = 0; ks < 8; ++ks) {
        bf16x8 a[2], bq[4];
#pragma unroll
        for (int si = 0; si < 2; ++si) a[si] = *(const LAS bf16x8*)(lds + L_K + (32 * wc + 16 * si + l15) * PT + (32 * ks + 8 * q4) * 2);
#pragma unroll
        for (int ti = 0; ti < 4; ++ti) bq[ti] = *(const LAS bf16x8*)(lds + L_Q + (64 * wr + 16 * ti + l15) * PT + (32 * ks + 8 * q4) * 2);
#pragma unroll
        for (int si = 0; si < 2; ++si)
#pragma unroll
            for (int ti = 0; ti < 4; ++ti) acc[si][ti] = MFMA16(a[si], bq[ti], acc[si][ti]);
    }
    uint2 pp[2][4];
#pragma unroll
    for (int ti = 0; ti < 4; ++ti) {
        const int t = 64 * wr + 16 * ti + l15; const float pmt = fmaxf(mprev, F[F_PM + t]); float nqs = 0.f;
#pragma unroll
        for (int si = 0; si < 2; ++si) {
            const int s0 = 32 * wc + 16 * si + 4 * q4;
            const f32x4 al4 = lds_ldf4(F + F_AL + s0); const float4 al = make_float4(al4[0], al4[1], al4[2], al4[3]);
            const float p0 = (s0 + 0 <= t) ? acc[si][ti][0] * __expf(al.x - pmt) : 0.f;
            const float p1 = (s0 + 1 <= t) ? acc[si][ti][1] * __expf(al.y - pmt) : 0.f;
            const float p2 = (s0 + 2 <= t) ? acc[si][ti][2] * __expf(al.z - pmt) : 0.f;
            const float p3 = (s0 + 3 <= t) ? acc[si][ti][3] * __expf(al.w - pmt) : 0.f;
            nqs += (p0 + p1) + (p2 + p3);
            pp[si][ti].x = pk2(p0, p1); pp[si][ti].y = pk2(p2, p3);
        }
        nqs += __shfl_xor(nqs, 16); nqs += __shfl_xor(nqs, 32);
        if (q4 == 0) F[F_NQP + t * 4 + wc] = nqs;
    }
    lds_sync();
#pragma unroll
    for (int ti = 0; ti < 4; ++ti)
#pragma unroll
        for (int si = 0; si < 2; ++si) lds_st8(lds + L_P + (64 * wr + 16 * ti + l15) * PHB + (32 * wc + 16 * si + 4 * q4) * 2, pp[si][ti]);
    {
        const int s = tid >> 2, seg = tid & 3; const float wk = __expf(F[F_AL + s] - pml);
#pragma unroll
        for (int j = 0; j < 8; ++j) {
            LAS unsigned char* p = lds + L_K + s * PT + (seg * 64 + j * 8) * 2;
            float x[8]; unpk8(lds_ld16(p), x);
#pragma unroll
            for (int i = 0; i < 8; ++i) x[i] *= wk;
            lds_st16(p, pk8(x));
        }
    }
    tile_store<4>(lds, L_VH, PHB, vpre, 4, tid);
    tile_fetch<4>(vpre, Vg + 128, 1024, 4, tid);
    lds_sync();
    if (PM & 2) {
    if (tid < 128) wsf(c, WS_NQI)[(size_t)(row0 + tid) * 4 + h] = (F[F_NQP + tid * 4 + 0] + F[F_NQP + tid * 4 + 1]) + (F[F_NQP + tid * 4 + 2] + F[F_NQP + tid * 4 + 3]);
    if (tid < 256) {
        float s = 0.f;
#pragma unroll 8
        for (int r = 0; r < 128; ++r) s += bf2f(*(const LAS bf16*)(lds + L_K + r * PT + tid * 2));
        wsf(c, WS_DN)[(size_t)u * 256 + tid] = s;
    }
    if (tid == 0) { wsf(c, WS_DEC)[u] = __expf(mprev - pml); wsf(c, WS_MNEW)[u] = blast + pml; }
    }
    bf16* NI = wsb(c, WS_NI); bf16* DCT = wsb(c, WS_DCT) + (size_t)u * UNIT_E;
    for (int half = 0; half < 2; ++half) {
        if (half) { lds_sync(); tile_store<4>(lds, L_VH, PHB, vpre, 4, tid); lds_sync(); }
        if (PM & 4) {
            f32x4 a2[2][4];
#pragma unroll
            for (int vi = 0; vi < 2; ++vi)
#pragma unroll
                for (int ti = 0; ti < 4; ++ti) a2[vi][ti] = (f32x4){0.f, 0.f, 0.f, 0.f};
#pragma unroll
            for (int ks = 0; ks < 4; ++ks) {
                s16x4 o[4]; const unsigned va = ldsb + L_VH + (32 * ks + 8 * q4 + (l15 >> 2)) * PHB + (32 * wc + 4 * (lane & 3)) * 2;
                TR_2F(o, va, 1088);
                const bf16x8 av0 = cat8(o[0], o[1]), av1 = cat8(o[2], o[3]);
                bf16x8 bp[4];
#pragma unroll
                for (int ti = 0; ti < 4; ++ti) bp[ti] = *(const LAS bf16x8*)(lds + L_P + (64 * wr + 16 * ti + l15) * PHB + (32 * ks + 8 * q4) * 2);
#pragma unroll
                for (int ti = 0; ti < 4; ++ti) { a2[0][ti] = MFMA16(av0, bp[ti], a2[0][ti]); a2[1][ti] = MFMA16(av1, bp[ti], a2[1][ti]); }
            }
#pragma unroll
            for (int ti = 0; ti < 4; ++ti)
#pragma unroll
                for (int vi = 0; vi < 2; ++vi)
                    { uint2 w2; w2.x = pk2(a2[vi][ti][0], a2[vi][ti][1]); w2.y = pk2(a2[vi][ti][2], a2[vi][ti][3]); if (PM & 8) *(uint2*)(NI + (size_t)(row0 + 64 * wr + 16 * ti + l15) * 1024 + h * 256 + 128 * half + 32 * wc + 16 * vi + 4 * q4) = w2; else if (w2.x == 0x12345678u) NI[0] = (bf16)w2.y; }
        }
        if (PM & 16) {
            f32x4 a3[4][4];
#pragma unroll
            for (int ki = 0; ki < 4; ++ki)
#pragma unroll
                for (int vi = 0; vi < 4; ++vi) a3[ki][vi] = (f32x4){0.f, 0.f, 0.f, 0.f};
#pragma unroll
            for (int ks = 0; ks < 4; ++ks) {
                s16x4 ok[8], ov[8];
                const unsigned ka = ldsb + L_K + (32 * ks + 8 * q4 + (l15 >> 2)) * PT + (64 * wc + 4 * (lane & 3)) * 2;
                const unsigned va = ldsb + L_VH + (32 * ks + 8 * q4 + (l15 >> 2)) * PHB + (64 * wr + 4 * (lane & 3)) * 2;
                TR_4F(ok, ka, 2112); TR_4F(ov, va, 1088);
#pragma unroll
                for (int ki = 0; ki < 4; ++ki)
#pragma unroll
                    for (int vi = 0; vi < 4; ++vi) a3[ki][vi] = MFMA16(cat8(ok[2 * ki], ok[2 * ki + 1]), cat8(ov[2 * vi], ov[2 * vi + 1]), a3[ki][vi]);
            }
#pragma unroll
            for (int vi = 0; vi < 4; ++vi)
#pragma unroll
                for (int ki = 0; ki < 4; ++ki) {
                    uint2 w; w.x = pk2(a3[ki][vi][0], a3[ki][vi][1]); w.y = pk2(a3[ki][vi][2], a3[ki][vi][3]);
                    if (PM & 32) *(uint2*)(DCT + (size_t)(128 * half + 64 * wr + 16 * vi + l15) * 256 + 64 * wc + 16 * ki + 4 * q4) = w; else if (w.x == 0x12345678u) DCT[0] = (bf16)w.y;
                }
        }
    }
    lds_sync();
}

DI void mlstm_B(const Ctx& c, int l, unsigned char* lds_) {
    const bf16* __restrict__ DCT = wsb(c, WS_DCT); bf16* __restrict__ CTP = wsb(c, WS_CTP); const float* __restrict__ DEC = wsf(c, WS_DEC);
    LAS float* T = (LAS float*)lds_;
    for (int it = c.blk; it < 32 * 8; it += c.nblk) {
        const int bh = it >> 3, vb = it & 7, v = c.tid >> 4, k0 = (c.tid & 15) * 16;
        const size_t e = (size_t)(vb * 32 + v) * 256 + k0;
        float C[16];
#pragma unroll
        for (int i = 0; i < 16; ++i) C[i] = 0.f;
#pragma unroll 1
        for (int c4 = 0; c4 < 16; c4 += 4) {
        uint4 dd[4][2]; float dc[4];
#pragma unroll
        for (int j = 0; j < 4; ++j) { const size_t u = (size_t)bh * 16 + c4 + j; dd[j][0] = *(const uint4*)(DCT + u * UNIT_E + e); dd[j][1] = *(const uint4*)(DCT + u * UNIT_E + e + 8); dc[j] = DEC[u]; }
#pragma unroll
        for (int j = 0; j < 4; ++j) {
            const size_t u = (size_t)bh * 16 + c4 + j;
            { float lo[8], hi[8];
#pragma unroll
              for (int i = 0; i < 8; ++i) { lo[i] = C[i]; hi[i] = C[8 + i]; }
              *(uint4*)(CTP + u * UNIT_E + e) = pk8(lo); *(uint4*)(CTP + u * UNIT_E + e + 8) = pk8(hi); }
            const float dec = dc[j]; float d0[8], d1[8]; unpk8(dd[j][0], d0); unpk8(dd[j][1], d1);
#pragma unroll
            for (int i = 0; i < 8; ++i) { C[i] = dec * C[i] + d0[i]; C[8 + i] = dec * C[8 + i] + d1[i]; }
        }
        }
        lds_sync();
#pragma unroll
        for (int i = 0; i < 16; ++i) T[v * 257 + k0 + i] = C[i];
        lds_sync();
        float* oc = c.out + O_C_P + ((size_t)l * NBP * NH + bh) * UNIT_E + vb * 32;
        {
            const int k = c.tid >> 1, vh = (c.tid & 1) * 16;
#pragma unroll
            for (int q = 0; q < 4; ++q) *(float4*)(oc + (size_t)k * 256 + vh + 4 * q) = make_float4(T[(vh + 4 * q) * 257 + k], T[(vh + 4 * q + 1) * 257 + k], T[(vh + 4 * q + 2) * 257 + k], T[(vh + 4 * q + 3) * 257 + k]);
        }
    }
    const float* DN = wsf(c, WS_DN); float* NPv = wsf(c, WS_NP);
    for (int it = c.gtid; it < 32 * 256; it += c.gthreads) {
        const int bh = it >> 8, k = it & 255; float n = 0.f;
        for (int ch = 0; ch < 16; ++ch) { const size_t u = (size_t)bh * 16 + ch; NPv[u * 256 + k] = n; n = DEC[u] * n + DN[u * 256 + k]; }
        c.out[O_N_P + ((size_t)l * NBP * NH + bh) * DH + k] = n;
        if (k == 0) c.out[O_M_P + (size_t)l * NBP * NH + bh] = wsf(c, WS_MNEW)[(size_t)bh * 16 + 15];
    }
    lds_sync();
}

DI void mlstm_C_unit(const Ctx& c, unsigned char* lds_, int u, const float* gmh) {
    LAS unsigned char* lds = (LAS unsigned char*)lds_;
    LAS float* F = (LAS float*)(lds + L_F);
    const int b = u >> 6, h = (u >> 4) & 3, ch = u & 15, row0 = b * SEQ + ch * 128;
    const int tid = c.tid, lane = c.lane, wr = c.wave >> 2, wc = c.wave & 3, l15 = lane & 15, q4 = lane >> 4;
    const bf16* Qg = wsb(c, WS_Q) + (size_t)row0 * 1024 + h * 256; const bf16* CT = wsb(c, WS_CTP) + (size_t)u * UNIT_E;
    { uint4 tq[8], tk[8];
      tile_fetch<8>(tq, Qg, 1024, 5, tid); tile_fetch<8>(tk, CT, 256, 5, tid);
      tile_store<8>(lds, L_Q, PT, tq, 5, tid); tile_store<8>(lds, L_K, PT, tk, 5, tid); }
    if (tid < 256) F[F_NP + tid] = wsf(c, WS_NP)[(size_t)u * 256 + tid];
    gate_part1(wsf(c, WS_LI), wsf(c, WS_LF), b * SEQ, h, ch, F, lane, c.wave);
    lds_sync();
    const float mprev = gate_mprev(F, ch);
    uint4 cpre[8]; tile_fetch<8>(cpre, CT + 128 * 256, 256, 5, tid);
    {
        const int t = tid >> 2, kq = tid & 3; float s = 0.f;
#pragma unroll
        for (int j = 0; j < 8; ++j) {
            float x[8]; unpk8(lds_ld16(lds + L_Q + t * PT + (kq * 64 + j * 8) * 2), x);
#pragma unroll
            for (int i = 0; i < 8; ++i) s += x[i] * F[F_NP + kq * 64 + j * 8 + i];
        }
        s += __shfl_xor(s, 1); s += __shfl_xor(s, 2);
        if (kq == 0) F[F_QN + t] = s;
    }
    uint2 nip[2][2][4];
    { const bf16* NIp = wsb(c, WS_NI);
#pragma unroll
      for (int ti = 0; ti < 4; ++ti)
#pragma unroll
          for (int hf = 0; hf < 2; ++hf)
#pragma unroll
              for (int vi = 0; vi < 2; ++vi) nip[hf][vi][ti] = *(const uint2*)(NIp + (size_t)(row0 + 64 * wr + 16 * ti + l15) * 1024 + h * 256 + 128 * hf + 32 * wc + 16 * vi + 4 * q4); }
    f32x4 acc[2][2][4];
#pragma unroll
    for (int hf = 0; hf < 2; ++hf)
#pragma unroll
        for (int vi = 0; vi < 2; ++vi)
#pragma unroll
            for (int ti = 0; ti < 4; ++ti) acc[hf][vi][ti] = (f32x4){0.f, 0.f, 0.f, 0.f};
#pragma unroll
    for (int hf = 0; hf < 2; ++hf) {
        if (hf) { lds_sync(); tile_store<8>(lds, L_K, PT, cpre, 5, tid); lds_sync(); }
#pragma unroll 4
        for (int ks = 0; ks < 8; ++ks) {
            bf16x8 a[2], bq[4];
#pragma unroll
            for (int vi = 0; vi < 2; ++vi) a[vi] = *(const LAS bf16x8*)(lds + L_K + (32 * wc + 16 * vi + l15) * PT + (32 * ks + 8 * q4) * 2);
#pragma unroll
            for (int ti = 0; ti < 4; ++ti) bq[ti] = *(const LAS bf16x8*)(lds + L_Q + (64 * wr + 16 * ti + l15) * PT + (32 * ks + 8 * q4) * 2);
#pragma unroll
            for (int vi = 0; vi < 2; ++vi)
#pragma unroll
                for (int ti = 0; ti < 4; ++ti) acc[hf][vi][ti] = MFMA16(a[vi], bq[ti], acc[hf][vi][ti]);
        }
    }
    const float* NQI = wsf(c, WS_NQI);
#pragma unroll
    for (int ti = 0; ti < 4; ++ti) {
        const int t = 64 * wr + 16 * ti + l15; const size_t row = (size_t)(row0 + t);
        const float pmt = fmaxf(mprev, F[F_PM + t]), at = __expf(mprev - pmt);
        const float nq = NQI[row * 4 + h] + at * F[F_QN + t];
        const float inv = 1.f / fmaxf(fabsf(nq), __expf(-(F[F_BT + t] + pmt)));
        float ss = 0.f;
#pragma unroll
        for (int hf = 0; hf < 2; ++hf)
#pragma unroll
            for (int vi = 0; vi < 2; ++vi) {
                const uint2 nw = nip[hf][vi][ti]; const f32x4 ni = (f32x4){bflo(nw.x), bfhi(nw.x), bflo(nw.y), bfhi(nw.y)};
                const f32x4 hv = (ni + acc[hf][vi][ti] * at) * inv;
                acc[hf][vi][ti] = hv; ss += (hv[0] * hv[0] + hv[1] * hv[1]) + (hv[2] * hv[2] + hv[3] * hv[3]);
            }
        ss += __shfl_xor(ss, 16); ss += __shfl_xor(ss, 32);
        if (q4 == 0) F[F_SSP + t * 4 + wc] = ss;
    }
    lds_sync();
    const bf16* OS = wsb(c, WS_OS); bf16* HM = wsb(c, WS_HM);
#pragma unroll
    for (int ti = 0; ti < 4; ++ti) {
        const int t = 64 * wr + 16 * ti + l15; const size_t row = (size_t)(row0 + t);
        const float rs = rsqrtf(((F[F_SSP + t * 4 + 0] + F[F_SSP + t * 4 + 1]) + (F[F_SSP + t * 4 + 2] + F[F_SSP + t * 4 + 3])) * (1.f / DH) + EPS);
#pragma unroll
        for (int hf = 0; hf < 2; ++hf)
#pragma unroll
            for (int vi = 0; vi < 2; ++vi) {
                const int col = h * 256 + 128 * hf + 32 * wc + 16 * vi + 4 * q4;
                const float4 g = *(const float4*)(gmh + col); const uint2 ow = *(const uint2*)(OS + row * 1024 + col);
                const f32x4 hv = acc[hf][vi][ti];
                uint2 w; w.x = pk2(hv[0] * rs * g.x * bflo(ow.x), hv[1] * rs * g.y * bfhi(ow.x)); w.y = pk2(hv[2] * rs * g.z * bflo(ow.y), hv[3] * rs * g.w * bfhi(ow.y));
                *(uint2*)(HM + row * 1024 + col) = w;
            }
    }
    lds_sync();
}

template <bool first, bool has>
DI void mlstm_sample_item(const Ctx& c, unsigned char* lds_, int l, int it, float4 (&Cr)[32], int nxt) {
    LAS float* F = (LAS float*)lds_;
    LAS float* red = F;
    LAS float* qs = F + 2048;
    LAS float* ksm = F + 3072;
    LAS float* nqr = F + 4096;
    const int bs = it >> 2, h = it & 3, row0 = MP + bs * SS, tid = c.tid, kg = c.wave, v0 = c.lane * 4;
    const bf16* Q = wsb(c, WS_Q); const bf16* Kb = wsb(c, WS_K); const bf16* V = wsb(c, WS_V);
    const float* LI = wsf(c, WS_LI); const float* LF = wsf(c, WS_LF); float* Hh = wsf(c, WS_H);
    lds_sync();
    for (int idx = tid; idx < 1024; idx += NTHR) { const int t = idx >> 8, k = idx & 255; qs[idx] = bf2f(Q[(size_t)(row0 + t) * 1024 + h * 256 + k]); ksm[idx] = bf2f(Kb[(size_t)(row0 + t) * 1024 + h * 256 + k]); }
    const float* cn = inptr(I_MC) + ((size_t)l * NBS * NH + nxt) * UNIT_E;
    if (first) {
        const float* c0 = inptr(I_MC) + ((size_t)l * NBS * NH + it) * UNIT_E;
#pragma unroll
        for (int i = 0; i < 32; ++i) { const f32x4 t4 = __builtin_nontemporal_load((const f32x4*)(c0 + (size_t)(kg * 32 + i) * 256 + v0)); Cr[i] = make_float4(t4[0], t4[1], t4[2], t4[3]); }
    }
    float* oc = c.out + O_C_S + (((size_t)l * NBS + bs) * NH + h) * UNIT_E;
    float nval = 0.f; if (tid < 256) nval = inptr(I_MN)[(((size_t)l * NBS + bs) * NH + h) * DH + tid];
    float m = inptr(I_MM)[((size_t)l * NBS + bs) * NH + h];
    lds_sync();
#pragma unroll
    for (int t = 0; t < 4; ++t) {
        const size_t row = (size_t)(row0 + t);
        const float li = LI[row * 4 + h], lf = LF[row * 4 + h];
        const float mn = fmaxf(lf + m, li), fd = __expf(lf + m - mn), iw = __expf(li - mn); m = mn;
        const uint2 vw = *(const uint2*)(V + row * 1024 + h * 256 + v0);
        const float4 vv = make_float4(bflo(vw.x) * iw, bfhi(vw.x) * iw, bflo(vw.y) * iw, bfhi(vw.y) * iw);
        float4 part = make_float4(0.f, 0.f, 0.f, 0.f);
#pragma unroll
        for (int g = 0; g < 8; ++g) {
#pragma unroll
            for (int i = 4 * g; i < 4 * g + 4; ++i) {
                const float kk = ksm[t * 256 + kg * 32 + i], qq = qs[t * 256 + kg * 32 + i];
                Cr[i].x = fd * Cr[i].x + kk * vv.x; Cr[i].y = fd * Cr[i].y + kk * vv.y; Cr[i].z = fd * Cr[i].z + kk * vv.z; Cr[i].w = fd * Cr[i].w + kk * vv.w;
                part.x += qq * Cr[i].x; part.y += qq * Cr[i].y; part.z += qq * Cr[i].z; part.w += qq * Cr[i].w;
            }
            if (t == 3) {
#pragma unroll
                for (int i = 4 * g; i < 4 * g + 4; ++i) { const f32x4 t4 = {Cr[i].x, Cr[i].y, Cr[i].z, Cr[i].w}; __builtin_nontemporal_store(t4, (f32x4*)(oc + (size_t)(kg * 32 + i) * 256 + v0)); }
                asm volatile("" : "+v"(part.x), "+v"(part.y), "+v"(part.z), "+v"(part.w) :: "memory");
                if (has) {
#pragma unroll
                    for (int i = 4 * g; i < 4 * g + 4; ++i) { const f32x4 n4 = __builtin_nontemporal_load((const f32x4*)(cn + (size_t)(kg * 32 + i) * 256 + v0)); Cr[i] = make_float4(n4[0], n4[1], n4[2], n4[3]); }
                }
            }
        }
        lds_stf4(red + kg * 256 + v0, part);
        if (tid < 256) { nval = fd * nval + iw * ksm[t * 256 + tid]; const float pq = wave_sum(qs[t * 256 + tid] * nval); if (c.lane == 0) nqr[c.wave] = pq; }
        lds_sync();
        if (tid < 256) {
            float num = 0.f;
#pragma unroll
            for (int g8 = 0; g8 < 8; ++g8) num += red[g8 * 256 + tid];
            const float nq = (nqr[0] + nqr[1]) + (nqr[2] + nqr[3]);
            Hh[row * 1024 + h * 256 + tid] = num / fmaxf(fabsf(nq), __expf(-m));
        }
        lds_sync();
    }
    if (tid < 256) c.out[O_N_S + (((size_t)l * NBS + bs) * NH + h) * DH + tid] = nval;
    if (tid == 0) c.out[O_M_S + ((size_t)l * NBS + bs) * NH + h] = m;
}

DI void stage_mlstm_A(const Ctx& c, int l, unsigned char* lds) {
    for (int u = c.blk; u < NBP * NH * 16; u += c.nblk) mlstm_A_unit<63>(c, lds, u);
#ifdef PROBE_PARTS
    for (int u = c.blk; u < NBP * NH * 16; u += c.nblk) mlstm_A_unit<PROBE_PARTS>(c, lds, u);
#endif
    if (c.blk < NBS * NH) {
        float4 Cr[32];
        const int it1 = c.blk + c.nblk; const bool has1 = it1 < NBS * NH;
        if (has1) { mlstm_sample_item<true, true>(c, lds, l, c.blk, Cr, it1); mlstm_sample_item<false, false>(c, lds, l, it1, Cr, it1); }
        else mlstm_sample_item<true, false>(c, lds, l, c.blk, Cr, c.blk);
    }
    lds_sync();
}
DI void stage_mlstm_C(const Ctx& c, int l, unsigned char* lds) {
    const float* gmh = inptr(I_GMH) + (size_t)l * MW;
    for (int u = c.blk; u < NBP * NH * 16; u += c.nblk) mlstm_C_unit(c, lds, u, gmh);
}
struct DiagOrder {
    int G, c;
    DI bool next(int i, pg8::Unit& u) const { const int L = i * G + c; if (L >= 128) return false; u.pm = L; u.pn = L >> 2; return true; }
    DI void a_ready(const pg8::Unit&) const {}
    DI void done(const pg8::Unit&) const {}
};
struct EEs5 {
    static constexpr int ID = 9; static constexpr bool NEEDS_RS = false; static constexpr bool PAIRED = false;
    float* ES;
    typedef PF0 PF; DI PF load(int, int) const { return PF0{}; }
    DI const float* ssq_src() const { return nullptr; } DI float pre(int) const { return 0.f; }
    DI float operator()(int row, int col, const float (&a)[8], const float (&)[8], float, const PF&) const {
        const int cl = col & 255;
        if (cl < 128) { float* p = ES + (size_t)row * 128 + cl; *(float4*)p = make_float4(a[0], a[1], a[2], a[3]); *(float4*)(p + 4) = make_float4(a[4], a[5], a[6], a[7]); }
        return 0.f;
    }
};
struct EYs5 {
    static constexpr int ID = 10; static constexpr bool NEEDS_RS = false; static constexpr bool PAIRED = false;
    bf16* YS5;
    typedef PF0 PF; DI PF load(int, int) const { return PF0{}; }
    DI const float* ssq_src() const { return nullptr; } DI float pre(int) const { return 0.f; }
    DI float operator()(int row, int col, const float (&a)[8], const float (&)[8], float, const PF&) const {
        const int cl = col & 255, t = cl >> 4, hh0 = cl & 15, g = row >> 10, b = (row >> 7) & 7, ch = row & 127;
        float o[8];
#pragma unroll
        for (int i = 0; i < 8; ++i) o[i] = gelu_tanh(a[i]);
        *(uint4*)(YS5 + (size_t)(b * SEQ + ch * 16 + t) * 512 + g * 16 + hh0) = pk8(o);
        return 0.f;
    }
};
template <class F>
DI void gemm_diag(const Ctx& c, unsigned char* lds, const bf16* A, int lda, const bf16* Bt, int ldb, int K, const F& f) {
    pg8::Gemm g{A, Bt, 32768, 8192, K, lda, ldb};
    DiagOrder S{c.nblk, c.blk};
    EpiA<F> E{f, nullptr};
    pg8::gemm_phase<EpiA<F>, DiagOrder, true, true>((PG8_LAS unsigned char*)lds, g, S, E, c.tid);
}

DI void s5_build_item(const Ctx& c, unsigned char* lds_, int item) {
    LAS float* PWr = (LAS float*)lds_;
    LAS float* PWi = PWr + 17 * 64;
    LAS float* BBr = PWi + 17 * 64;
    LAS float* BBi = BBr + 1024;
    LAS float* CCr = BBi + 1024;
    LAS float* CCi = CCr + 1024;
    LAS float* KT = CCi + 1024;
    const int half = item & 1, l = item >> 6, g = (item >> 1) & 31, tid = c.tid;
    __syncthreads();
    if (tid < 64) {
        const int n = tid;
        const float lre = inptr(I_LRE)[((size_t)l * NG + g) * NST + n], lim = inptr(I_LIM)[((size_t)l * NG + g) * NST + n];
        const float dt = expf(inptr(I_LDT)[l * NG + g]);
        for (int tau = 0; tau <= 16; ++tau) { const float mag = expf((float)tau * lre * dt), th = (float)tau * (lim * dt); PWr[tau * 64 + n] = mag * cosf(th); PWi[tau * 64 + n] = mag * sinf(th); }
        const float mag = expf(lre * dt), ar = mag * cosf(lim * dt), ai = mag * sinf(lim * dt);
        const float den = lre * lre + lim * lim, pr = ar - 1.f;
        const float wre = (pr * lre + ai * lim) / den, wim = (ai * lre - pr * lim) / den;
        const float* bre = inptr(I_BRE) + (((size_t)l * NG + g) * NST + n) * 16; const float* bim = inptr(I_BIM) + (((size_t)l * NG + g) * NST + n) * 16;
        for (int j = 0; j < 16; ++j) { const float r = bre[j], i = bim[j]; BBr[n * 16 + j] = wre * r - wim * i; BBi[n * 16 + j] = wre * i + wim * r; }
    }
    for (int idx = tid; idx < 1024; idx += NTHR) { CCr[idx] = inptr(I_CRE)[((size_t)l * NG + g) * 1024 + idx]; CCi[idx] = inptr(I_CIM)[((size_t)l * NG + g) * 1024 + idx]; }
    __syncthreads();
    if (half == 0) for (int idx = tid; idx < 4096; idx += NTHR) {
        const int tau = idx >> 8, hh = (idx >> 4) & 15, j = idx & 15; float s = 0.f;
        for (int n = 0; n < 64; ++n) {
            const float cr = CCr[hh * 64 + n], ci = CCi[hh * 64 + n], pr = PWr[tau * 64 + n], pi = PWi[tau * 64 + n];
            const float xr = cr * pr - ci * pi, xi = cr * pi + ci * pr;
            s += xr * BBr[n * 16 + j] - xi * BBi[n * 16 + j];
        }
        KT[idx] = s;
    }
    __syncthreads();
    bf16* Km = wsb(c, WS_S5K) + ((size_t)l * 8192 + (size_t)g * 256) * 384;
    bf16* Em = wsb(c, WS_S5E) + ((size_t)l * 8192 + (size_t)g * 256) * 256;
    const float* dsk = inptr(I_S5D) + (size_t)l * S5W + g * 16;
    for (int idx = tid + (half ? 256 * 32 : 0); idx < (half ? 256 * 48 : 256 * 32); idx += NTHR) {
        const int r = idx & 255, chn = idx >> 8, t = r >> 4, hh = r & 15, kk0 = chn * 8; float v[8];
        if (kk0 < 256) {
            const int s = kk0 >> 4, j0 = kk0 & 15;
#pragma unroll
            for (int i = 0; i < 8; ++i) { float x = 0.f; if (s <= t) { x = KT[((t - s) * 16 + hh) * 16 + j0 + i]; if (s == t && j0 + i == hh) x += dsk[hh]; } v[i] = x; }
        } else {
            const int n0 = (kk0 - 256) & 63; const bool im = (kk0 - 256) >= 64;
#pragma unroll
            for (int i = 0; i < 8; ++i) { const int n = n0 + i; const float cr = CCr[hh * 64 + n], ci = CCi[hh * 64 + n], pr = PWr[(t + 1) * 64 + n], pi = PWi[(t + 1) * 64 + n]; v[i] = im ? -(cr * pi + ci * pr) : (cr * pr - ci * pi); }
        }
        *(uint4*)(Km + (size_t)r * 384 + kk0) = pk8(v);
    }
    if (half == 1) for (int idx = tid; idx < 256 * 32; idx += NTHR) {
        const int r = idx >> 5, chn = idx & 31, kk0 = chn * 8, s = kk0 >> 4, j0 = kk0 & 15; float v[8];
#pragma unroll
        for (int i = 0; i < 8; ++i) {
            float x = 0.f;
            if (r < 128) { const int n = r & 63; const float pr = PWr[(15 - s) * 64 + n], pi = PWi[(15 - s) * 64 + n], br = BBr[n * 16 + j0 + i], bi = BBi[n * 16 + j0 + i]; x = (r < 64) ? (pr * br - pi * bi) : (pr * bi + pi * br); }
            v[i] = x;
        }
        *(uint4*)(Em + (size_t)r * 256 + kk0) = pk8(v);
    }
}
DI void stage_s5_build(const Ctx& c, unsigned char* lds) { for (int it = c.blk; it < NL * NG * 2; it += c.nblk) s5_build_item(c, lds, it); __syncthreads(); }

DI void stage_s5_carry(const Ctx& c, int l, unsigned char* lds_) {
    const float* __restrict__ ES = wsf(c, WS_ES); bf16* __restrict__ UP = wsb(c, WS_UP);
    LAS float* segr = (LAS float*)lds_; LAS float* segi = segr + 512;
    for (int it = c.blk; it < NBP * NG; it += c.nblk) {
        const int b = it >> 5, g = it & 31, n = c.lane, w = c.wave;
        const float lre = inptr(I_LRE)[((size_t)l * NG + g) * NST + n], lim = inptr(I_LIM)[((size_t)l * NG + g) * NST + n];
        const float dt = expf(inptr(I_LDT)[l * NG + g]);
        const float m16 = expf(16.f * lre * dt), t16 = 16.f * (lim * dt), ar = m16 * cosf(t16), ai = m16 * sinf(t16);
        const float m256 = expf(256.f * lre * dt), t256 = 256.f * (lim * dt), Ar = m256 * cosf(t256), Ai = m256 * sinf(t256);
        const size_t rbase = (size_t)g * 1024 + (size_t)b * 128 + (size_t)w * 16;
        float er[16], ei[16];
#pragma unroll
        for (int j = 0; j < 16; ++j) { er[j] = ES[(rbase + j) * 128 + n]; ei[j] = ES[(rbase + j) * 128 + 64 + n]; }
        float pr[16], pi[16]; float hr = 0.f, hi = 0.f;
#pragma unroll
        for (int j = 0; j < 16; ++j) { pr[j] = hr; pi[j] = hi; const float nr = ar * hr - ai * hi + er[j], ni = ar * hi + ai * hr + ei[j]; hr = nr; hi = ni; }
        lds_sync();
        segr[w * 64 + n] = hr; segi[w * 64 + n] = hi;
        lds_sync();
        float sr = 0.f, si = 0.f;
        for (int ww = 0; ww < w; ++ww) { const float nr = Ar * sr - Ai * si + segr[ww * 64 + n], ni = Ar * si + Ai * sr + segi[ww * 64 + n]; sr = nr; si = ni; }
        float qr = 1.f, qi = 0.f;
#pragma unroll
        for (int j = 0; j < 16; ++j) {
            const float xr = pr[j] + (qr * sr - qi * si), xi = pi[j] + (qr * si + qi * sr);
            UP[(rbase + j) * 384 + 256 + n] = (bf16)f2bf(xr); UP[(rbase + j) * 384 + 320 + n] = (bf16)f2bf(xi);
            const float tr = qr * ar - qi * ai, ti = qr * ai + qi * ar; qr = tr; qi = ti;
        }
        if (w == 7) {
            c.out[O_S5RE_P + (((size_t)l * NBP + b) * NG + g) * NST + n] = hr + (qr * sr - qi * si);
            c.out[O_S5IM_P + (((size_t)l * NBP + b) * NG + g) * NST + n] = hi + (qr * si + qi * sr);
        }
    }
    lds_sync();
}
#ifndef MULTI_LAUNCH
#define MULTI_LAUNCH 0
#endif
#if FAST_GEMM
#ifndef ONLY_EPI
#define ONLY_EPI 0
#endif
#ifndef THIN_SAMPLE
#define THIN_SAMPLE 1
#endif
#define RUN_GEMM(A_, lda_, Bt_, ldb_, M_, Nc_, K_, e_, ssq_) do { if constexpr (ONLY_EPI == 0 || decltype(e_)::ID == ONLY_EPI) { \
    if (!(((PROBE_MASK >> 27) & 1) && rep_ == 1)) gemm_fast(c, lds, A_, lda_, Bt_, (ldb_) + PADK, ((THIN_SAMPLE && (Nc_) != INN && (Nc_) != 512) ? MP : (M_)), (e_.PAIRED ? 2 * (Nc_) : (Nc_)), K_, e_, ssq_); \
    if (THIN_SAMPLE && (Nc_) != INN && (Nc_) != 512 && !(((PROBE_MASK >> 26) & 1) && rep_ == 1)) for (int r_ = 0; r_ < ((((PROBE_MASK >> 20) & 1) && (decltype(e_)::ID == 1 || decltype(e_)::ID == 3 || decltype(e_)::ID == 4)) ? 3 : 1); ++r_) { \
        if (e_.PAIRED) gemm_thin<decltype(e_), 4, 1, 2, 1>(c, lds, (A_) + (size_t)MP * (lda_), lda_, Bt_, (ldb_) + PADK, Nc_, K_, e_, ssq_); \
        else if ((Nc_) == INN) gemm_thin<decltype(e_), 4, 2, 2, 1>(c, lds, (A_) + (size_t)MP * (lda_), lda_, Bt_, (ldb_) + PADK, Nc_, K_, e_, ssq_); \
        else gemm_thin<decltype(e_), 2, 1, 2, 2>(c, lds, (A_) + (size_t)MP * (lda_), lda_, Bt_, (ldb_) + PADK, Nc_, K_, e_, ssq_); } } } while (0)
#define SSQ_PHASE(p_)
constexpr int PH_PER_LAYER = 11 + (FAST_MLSTM ? 1 : 0);
#else
#define RUN_GEMM(A_, lda_, Bt_, ldb_, M_, Nc_, K_, e_, ssq_) gemm_ref(c, A_, lda_, Bt_, (ldb_) + PADK, M_, Nc_, K_, e_, ssq_)
#define SSQ_PHASE(p_) PH_BEGIN(0) stage_ssq(c, p_, XB); PH_END
constexpr int PH_PER_LAYER = 15 + (FAST_MLSTM ? 1 : 0);
#endif
constexpr int PH_TOTAL = 1 + NL * PH_PER_LAYER + 1;

__global__ void __launch_bounds__(NTHR, 2) fwd(Args args) {
    extern __shared__ __attribute__((aligned(16))) unsigned char lds[];
#define MKCTX Ctx c; { int ln_; asm volatile("v_mbcnt_lo_u32_b32 %0, -1, 0\n\tv_mbcnt_hi_u32_b32 %0, -1, %0" : "=v"(ln_)); int ws_ = wave_s; asm volatile("" : "+s"(ws_)); \
    { int z_ = 0; asm volatile("" : "+s"(z_)); c.out = args.out + z_; c.ws = args.ws + z_; }     \
    c.tid = ws_ * 64 + ln_; c.lane = ln_; c.wave = ws_; \
    { int b_ = blockIdx.x; asm volatile("" : "+s"(b_)); c.blk = b_; } c.nblk = gridDim.x; c.gtid = c.blk * NTHR + c.tid; c.gthreads = c.nblk * NTHR; c.gwave = c.blk + c.nblk * c.wave; c.gwaves = c.nblk * NWV; }
    volatile LAS unsigned* MISC = (volatile LAS unsigned*)((LAS unsigned char*)lds + MISC_OFF);
    const int wave_s = __builtin_amdgcn_readfirstlane(threadIdx.x >> 6);
    if (threadIdx.x < 32) MISC[threadIdx.x] = 0u;
    __syncthreads();
    if (!MULTI_LAUNCH) (void)xcd_barrier_post((unsigned*)(args.ws + WS_BAR), MISC + 8, threadIdx.x == 0);
    const int lo = args.lo, hi = args.hi;
    int gp = 0;
#ifndef PROBE_MASK
#define PROBE_MASK 0
#endif
#define PH_BEGIN(id_) if (lo <= gp && gp < hi) { for (int rep_ = 0; rep_ < (((PROBE_MASK >> (id_)) & 1) ? 2 : 1); ++rep_) { { MKCTX LAYER_PTRS
#define PH_FRESH } { MKCTX LAYER_PTRS
#define PH_END   } if (gp + 1 < hi) { MKCTX XcdBarrier b_; b_.bar = (unsigned*)(c.ws + WS_BAR); b_.x = xb_xcc_id(); b_.st = (volatile LAS unsigned*)((LAS unsigned char*)lds + MISC_OFF) + 8; xcd_barrier(b_, c.tid == 0); } } } ++gp;

#define LAYER_PTRS
    PH_BEGIN(1) stage_prologue(args, c, lds);
#if FAST_S5
    PH_FRESH stage_s5_build(c, lds);
#endif
    PH_END
#undef LAYER_PTRS
#define LAYER_PTRS unsigned char* lw = c.ws + WS_W + (size_t)l * LW_STRIDE; bf16* XB = (bf16*)(c.ws + ((l & 1) ? WS_XB2 : WS_XB)); bf16* XBn = (bf16*)(c.ws + ((l & 1) ? WS_XB : WS_XB2)); float* X = (float*)(c.ws + WS_X); (void)lw; (void)XB; (void)XBn; (void)X;

    for (int l = 0; l < NL; ++l) {
        PH_BEGIN(2) { ESwiGLU e{ssq_ptr(c, 4 * l + 0), wsb(c, WS_ACT)}; RUN_GEMM(XB, D, (const bf16*)(lw + LW_W1GU), D, M, FF, D, e, nullptr); } PH_END
        PH_BEGIN(3) { EResid e{XB, XB, rep_ ? 0.f : 0.5f}; RUN_GEMM(wsb(c, WS_ACT), FF, (const bf16*)(lw + LW_W1D), FF, M, D, FF, e, ssq_ptr(c, 4 * l + 1)); } PH_END
        SSQ_PHASE(ssq_ptr(c, 4 * l + 1))
        PH_BEGIN(4) { EWin e{ssq_ptr(c, 4 * l + 1), wsb(c, WS_UP), wsb(c, WS_US), wsb(c, WS_QKR), wsb(c, WS_V), wsb(c, WS_OS)};
                   RUN_GEMM(XB, D, (const bf16*)(lw + LW_WIN), D, M, INN, D, e, nullptr); } PH_END
        PH_BEGIN(5)
#if FAST_S5
                 { EEs5 e{wsf(c, WS_ES)}; gemm_diag(c, lds, wsb(c, WS_UP), 384, wsb(c, WS_S5E) + (size_t)l * 8192 * 256, 256, 256, e); }
        PH_FRESH
#endif
                 stage_conv(args, c, l); stage_gates(args, c, l, ssq_ptr(c, 4 * l + 1), XB); PH_END
#if FAST_MLSTM
        PH_BEGIN(6) stage_mlstm_A(c, l, lds);
#if FAST_S5
        PH_FRESH for (int r_ = 0; r_ < (((PROBE_MASK >> 23) & 1) ? 2 : 1); ++r_) stage_s5_carry(c, l, lds);
#endif
        PH_FRESH stage_s5_sample(args, c, l, lds); PH_END
        PH_BEGIN(7)
#if FAST_S5
                 { EYs5 e{wsb(c, WS_YS5)}; gemm_diag(c, lds, wsb(c, WS_UP), 384, wsb(c, WS_S5K) + (size_t)l * 8192 * 384, 384, 384, e); }
        PH_FRESH
#endif
                 mlstm_B(c, l, lds); PH_END
        PH_BEGIN(8) stage_mlstm_C(c, l, lds); stage_headnorm(args, c, l, MP);
#else
        PH_BEGIN(9) stage_mlstm_ref(args, c, l, lds); stage_s5_ref(args, c, l, lds); PH_END
        PH_BEGIN(10) stage_headnorm(args, c, l, 0);
#endif
                 { EGlu e{wsb(c, WS_YS5), wsb(c, WS_YG)}; RUN_GEMM(wsb(c, WS_YS5), 512, (const bf16*)(lw + LW_WGLU), 512, M, 512, 512, e, nullptr); } PH_END
        PH_BEGIN(11) { ET5 e{wsb(c, WS_GS5), wsb(c, WS_T5)}; RUN_GEMM(wsb(c, WS_YG), 512, (const bf16*)(lw + LW_WS5UP), 512, M, D, 512, e, nullptr); }
                 { EMerged e{wsb(c, WS_T5), wsb(c, WS_GM), wsb(c, WS_MRG)}; RUN_GEMM(wsb(c, WS_HM), 1024, (const bf16*)(lw + LW_WMUP), 1024, M, D, 1024, e, nullptr); } PH_END
        PH_BEGIN(12) { EResid e{XB, XB, rep_ ? 0.f : 1.0f}; RUN_GEMM(wsb(c, WS_MRG), 1024, (const bf16*)(lw + LW_WOUT), 1024, M, D, 1024, e, ssq_ptr(c, 4 * l + 2)); } PH_END
        SSQ_PHASE(ssq_ptr(c, 4 * l + 2))
        PH_BEGIN(13) { ESwiGLU e{ssq_ptr(c, 4 * l + 2), wsb(c, WS_ACT)}; RUN_GEMM(XB, D, (const bf16*)(lw + LW_W2GU), D, M, FF, D, e, nullptr); } PH_END
        PH_BEGIN(14) { EResid e{XB, XB, rep_ ? 0.f : 0.5f}; RUN_GEMM(wsb(c, WS_ACT), FF, (const bf16*)(lw + LW_W2D), FF, M, D, FF, e, ssq_ptr(c, 4 * l + 3)); } PH_END
        SSQ_PHASE(ssq_ptr(c, 4 * l + 3))
        PH_BEGIN(15) { EGate e{ssq_ptr(c, 4 * l + 3), wsb(c, WS_GT)}; RUN_GEMM(XB, D, (const bf16*)(lw + LW_WPG), D, M, D, D, e, nullptr); }
                 { EPle e{XB, XBn, wsb(c, WS_GT), rep_ ? 0.f : 1.f}; RUN_GEMM(wsb(c, WS_PB) + (size_t)l * M * DPLE, DPLE, (const bf16*)(lw + LW_WPLE), DPLE, M, D, DPLE, e, ssq_ptr(c, 4 * l + 4)); } PH_END
        SSQ_PHASE(ssq_ptr(c, 4 * l + 4))
    }
#undef LAYER_PTRS
#define LAYER_PTRS
    PH_BEGIN(16) stage_final(args, c, wsb(c, (NL & 1) ? WS_XB2 : WS_XB)); PH_END
#undef LAYER_PTRS
#undef PH_BEGIN
#undef PH_END
}

extern "C" void kernel_launch(void* const* d_in, const int* in_sizes, int n_in, void* d_out, int out_size, void* d_ws, size_t ws_size, hipStream_t stream) {
    static int grid = 0;
    if (grid == 0) {
        if (n_in != N_IN || (size_t)out_size != O_END || ws_size < WS_END) { fprintf(stderr, "kernel_launch: unexpected shapes (n_in %d, out %d, ws %zu)\n", n_in, out_size, ws_size); grid = -1; return; }
        int dev = 0, cus = 0, per_cu = 0;
        if (hipGetDevice(&dev) != hipSuccess || hipDeviceGetAttribute(&cus, hipDeviceAttributeMultiprocessorCount, dev) != hipSuccess) { grid = -1; return; }
        if (hipFuncSetAttribute((const void*)fwd, hipFuncAttributeMaxDynamicSharedMemorySize, LDS_BYTES) != hipSuccess) { fprintf(stderr, "kernel_launch: hipFuncSetAttribute failed\n"); grid = -1; return; }
        if (hipOccupancyMaxActiveBlocksPerMultiprocessor(&per_cu, (const void*)fwd, NTHR, LDS_BYTES) != hipSuccess || per_cu < 1) { fprintf(stderr, "kernel_launch: occupancy query says %d\n", per_cu); per_cu = 1; }
        (void)hipGetLastError();
        if (2 * cus < NBS * NH) { fprintf(stderr, "kernel_launch: %d CUs, the sample-state stream is written for >= %d workgroups\n", cus, NBS * NH / 2); grid = -1; return; }
        grid = cus;
    }
    if (grid < 0) return;
    (void)hipMemsetAsync((char*)d_ws + WS_ZERO, 0, ZERO_BYTES, stream);
    Args a{};
    for (int i = 0; i < N_IN; ++i) a.in[i] = (const float*)d_in[i];
    a.out = (float*)d_out; a.ws = (unsigned char*)d_ws;
#if MULTI_LAUNCH
    for (int p = 0; p < PH_TOTAL; ++p) { a.lo = p; a.hi = p + 1; hipLaunchKernelGGL(fwd, dim3(grid), dim3(NTHR), LDS_BYTES, stream, a); }
#else
    a.lo = 0; a.hi = PH_TOTAL;
    hipLaunchKernelGGL(fwd, dim3(grid), dim3(NTHR), LDS_BYTES, stream, a);
#endif
    const hipError_t le = hipPeekAtLastError();
    if (le != hipSuccess) fprintf(stderr, "kernel_launch: launch failed: %s\n", hipGetErrorName(le));
}
```

```cpp
#include <hip/hip_runtime.h>
#include <cstdio>
#include <cstdint>

#define DI __device__ __forceinline__
#ifndef PROBE_MASK
#define PROBE_MASK 0
#endif
#ifndef FAST_GEMM
#define FAST_GEMM 1
#endif
#ifndef GEMM_ALIGN
#define GEMM_ALIGN true
#endif
#ifndef FAST_MLSTM
#define FAST_MLSTM 1
#endif
#ifndef FAST_S5
#define FAST_S5 1
#endif
typedef unsigned short bf16;
typedef unsigned int u32;
typedef __bf16 bf2_t __attribute__((ext_vector_type(2)));
typedef unsigned u32x4t __attribute__((ext_vector_type(4)));
#define LAS __attribute__((address_space(3)))

constexpr int D = 1024, FF = 2048, NL = 4;
constexpr int NBP = 8, SEQ = 2048, NBS = 128, SS = 4;
constexpr int MP = NBP * SEQ, MS = NBS * SS, M = MP + MS;
constexpr int NG = 32, NST = 64, S5W = 512;
constexpr int NH = 4, DH = 256, MW = 1024;
constexpr int INC = 6664, INN = 6656;
constexpr int DPLE = 256;
constexpr float EPS = 1e-6f;
constexpr int NTHR = 512, NWV = 8;
constexpr int PADK = 0;
constexpr int LDS_BYTES = 147456;
constexpr int MISC_OFF = LDS_BYTES - 256;

enum { I_XP = 0, I_XS, I_S5RE, I_S5IM, I_MC, I_MN, I_MM, I_CONV, I_PP, I_PS, I_GFFN1, I_W1G, I_W1U, I_W1D, I_GMIX, I_WIN, I_LRE, I_LIM, I_LDT,
       I_BRE, I_BIM, I_CRE, I_CIM, I_S5D, I_WGLU, I_WS5UP, I_CONVW, I_CONVB, I_BIG, I_BFG, I_GMH, I_WMUP, I_WOUT, I_GFFN2, I_W2G, I_W2U, I_W2D,
       I_GPLE, I_WPLE, I_WPG, I_GFIN, N_IN };

constexpr size_t O_Y = 0;
constexpr size_t O_S5RE_P = O_Y + (size_t)M * D;
constexpr size_t O_S5IM_P = O_S5RE_P + (size_t)NL * NBP * NG * NST;
constexpr size_t O_C_P = O_S5IM_P + (size_t)NL * NBP * NG * NST;
constexpr size_t O_N_P = O_C_P + (size_t)NL * NBP * NH * DH * DH;
constexpr size_t O_M_P = O_N_P + (size_t)NL * NBP * NH * DH;
constexpr size_t O_CONV_P = O_M_P + (size_t)NL * NBP * NH;
constexpr size_t O_S5RE_S = O_CONV_P + (size_t)NL * NBP * 3 * 2048;
constexpr size_t O_S5IM_S = O_S5RE_S + (size_t)NL * NBS * NG * NST;
constexpr size_t O_C_S = O_S5IM_S + (size_t)NL * NBS * NG * NST;
constexpr size_t O_N_S = O_C_S + (size_t)NL * NBS * NH * DH * DH;
constexpr size_t O_M_S = O_N_S + (size_t)NL * NBS * NH * DH;
constexpr size_t O_CONV_S = O_M_S + (size_t)NL * NBS * NH;
constexpr size_t O_END = O_CONV_S + (size_t)NL * NBS * 3 * 2048;
static_assert(O_END == 166037632ull, "output map");

constexpr size_t al256(size_t x) { return (x + 255) & ~(size_t)255; }
constexpr size_t WS_ZERO = 0, ZERO_BYTES = 32768;
constexpr size_t WS_BAR = 16384;
constexpr size_t LW_W1GU = 0;
constexpr size_t LW_W1D = LW_W1GU + (size_t)4096 * (1024 + PADK) * 2;
constexpr size_t LW_WIN = LW_W1D + (size_t)1024 * (2048 + PADK) * 2;
constexpr size_t LW_WG = LW_WIN + (size_t)INN * (1024 + PADK) * 2;
constexpr size_t LW_WGLU = LW_WG + (size_t)8 * 1024 * 4;
constexpr size_t LW_WS5UP = LW_WGLU + (size_t)512 * (512 + PADK) * 2;
constexpr size_t LW_WMUP = LW_WS5UP + (size_t)1024 * (512 + PADK) * 2;
constexpr size_t LW_WOUT = LW_WMUP + (size_t)1024 * (1024 + PADK) * 2;
constexpr size_t LW_W2GU = LW_WOUT + (size_t)1024 * (1024 + PADK) * 2;
constexpr size_t LW_W2D = LW_W2GU + (size_t)4096 * (1024 + PADK) * 2;
constexpr size_t LW_WPG = LW_W2D + (size_t)1024 * (2048 + PADK) * 2;
constexpr size_t LW_WPLE = LW_WPG + (size_t)1024 * (1024 + PADK) * 2;
constexpr size_t LW_END = LW_WPLE + (size_t)1024 * (256 + PADK) * 2;
constexpr size_t LW_STRIDE = al256(LW_END);
constexpr size_t WS_W = 1u << 20;
constexpr size_t WS_PB = al256(WS_W + NL * LW_STRIDE);
constexpr size_t WS_X = al256(WS_PB + (size_t)NL * M * DPLE * 2);
constexpr size_t WS_XB = al256(WS_X + (size_t)M * D * 4);
constexpr size_t WS_ACT = al256(WS_XB + (size_t)M * D * 2);
constexpr size_t WS_UP = al256(WS_ACT + (size_t)M * FF * 2);
constexpr size_t WS_US = al256(WS_UP + (size_t)NG * 1024 * 384 * 2);
constexpr size_t WS_QKR = al256(WS_US + (size_t)MS * 512 * 2);
constexpr size_t WS_V = al256(WS_QKR + (size_t)M * 2048 * 2);
constexpr size_t WS_OS = al256(WS_V + (size_t)M * 1024 * 2);
constexpr size_t WS_GS5 = al256(WS_OS + (size_t)M * 1024 * 2);
constexpr size_t WS_GM = al256(WS_GS5 + (size_t)M * 1024 * 2);
constexpr size_t WS_LI = al256(WS_GM + (size_t)M * 1024 * 2);
constexpr size_t WS_LF = al256(WS_LI + (size_t)M * 4 * 4);
constexpr size_t WS_Q = al256(WS_LF + (size_t)M * 4 * 4);
constexpr size_t WS_K = al256(WS_Q + (size_t)M * 1024 * 2);
constexpr size_t WS_H = al256(WS_K + (size_t)M * 1024 * 2);
constexpr size_t WS_YS5 = al256(WS_H + (size_t)M * 1024 * 4);
constexpr size_t WS_YG = al256(WS_YS5 + (size_t)M * 512 * 2);
constexpr size_t WS_HM = al256(WS_YG + (size_t)M * 512 * 2);
constexpr size_t WS_T5 = al256(WS_HM + (size_t)M * 1024 * 2);
constexpr size_t WS_MRG = al256(WS_T5 + (size_t)M * 1024 * 4);
constexpr size_t WS_GT = al256(WS_MRG + (size_t)M * 1024 * 2);
constexpr size_t WS_XB2 = al256(WS_GT + (size_t)M * 1024 * 2);
constexpr size_t WS_SSQ = al256(WS_XB2 + (size_t)M * D * 2);
constexpr size_t WS_NQI = al256(WS_SSQ + (size_t)17 * M * 16 * 4);
constexpr size_t WS_DCT = al256(WS_NQI + (size_t)MP * 4 * 4);
constexpr size_t WS_CTP = al256(WS_DCT + (size_t)512 * 65536 * 2);
constexpr size_t WS_DN = al256(WS_CTP + (size_t)512 * 65536 * 2);
constexpr size_t WS_NP = al256(WS_DN + (size_t)512 * 256 * 4);
constexpr size_t WS_DEC = al256(WS_NP + (size_t)512 * 256 * 4);
constexpr size_t WS_MNEW = al256(WS_DEC + 512 * 4);
constexpr size_t WS_NI = al256(WS_MNEW + 512 * 4);
constexpr size_t WS_S5K = al256(WS_NI + (size_t)MP * 1024 * 2);
constexpr size_t WS_S5E = al256(WS_S5K + (size_t)NL * 8192 * 384 * 2);
constexpr size_t WS_ES = al256(WS_S5E + (size_t)NL * 8192 * 256 * 2);
constexpr size_t WS_END = al256(WS_ES + (size_t)32768 * 128 * 4);
static_assert(WS_END < (size_t)2000 * 1024 * 1024, "d_ws map must fit 4 x the largest tensor");
static_assert(WS_GS5 == WS_OS + (size_t)M * 1024 * 2 && WS_GM == WS_GS5 + (size_t)M * 1024 * 2, "OS, GS5, GM consecutive");

DI float bf2f(bf16 b) { return __uint_as_float((u32)b << 16); }
DI float bflo(u32 w) { return __uint_as_float(w << 16); }
DI float bfhi(u32 w) { return __uint_as_float(w & 0xffff0000u); }
DI u32 f2bf(float f) { u32 u = __float_as_uint(f); return (u + 0x7fffu + ((u >> 16) & 1u)) >> 16; }
DI u32 pk2(float lo, float hi) { bf2_t v = {(__bf16)lo, (__bf16)hi}; return __builtin_bit_cast(u32, v); }
DI uint4 pk8(const float (&v)[8]) { uint4 o; o.x = pk2(v[0], v[1]); o.y = pk2(v[2], v[3]); o.z = pk2(v[4], v[5]); o.w = pk2(v[6], v[7]); return o; }
DI void unpk8(uint4 w, float (&v)[8]) { v[0] = bflo(w.x); v[1] = bfhi(w.x); v[2] = bflo(w.y); v[3] = bfhi(w.y); v[4] = bflo(w.z); v[5] = bfhi(w.z); v[6] = bflo(w.w); v[7] = bfhi(w.w); }
DI float sigm(float x) { return __builtin_amdgcn_rcpf(1.f + __expf(-x)); }
DI float wave_sum(float v) {
#pragma unroll
    for (int o = 1; o < 64; o <<= 1) v += __shfl_xor(v, o);
    return v;
}
DI float fdot2(u32 a, u32 b, float c) { return __builtin_amdgcn_fdot2_f32_bf16(__builtin_bit_cast(bf2_t, a), __builtin_bit_cast(bf2_t, b), c, false); }
DI float dot8(uint4 a, uint4 b, float c) { c = fdot2(a.x, b.x, c); c = fdot2(a.y, b.y, c); c = fdot2(a.z, b.z, c); c = fdot2(a.w, b.w, c); return c; }
DI float gelu_tanh(float x) { const float u = 0.7978845608028654f * (x + 0.044715f * x * x * x); const float e = __expf(2.f * u); const float th = 1.f - 2.f * __builtin_amdgcn_rcpf(e + 1.f); return 0.5f * x * (1.f + th); }

DI size_t up_off(int row, int col) { const int b = row >> 11, t = row & 2047, c = t >> 4, s = t & 15, g = col >> 4, j = col & 15; return ((size_t)(g * 1024 + b * 128 + c)) * 384 + s * 16 + j; }

struct Args { const float* in[N_IN]; float* out; unsigned char* ws; int lo, hi; };
static_assert(sizeof(Args) == (N_IN + 2) * 8 + 8, "Args has no padding");

#define CAS4 __attribute__((address_space(4)))
#define GAS __attribute__((address_space(1)))
DI const float* inptr(int i) { const CAS4 char* ka = (const CAS4 char*)__builtin_amdgcn_kernarg_segment_ptr(); asm volatile("" : "+s"(ka)); const GAS float* g = *(const GAS float* const CAS4*)(ka + 8 * i); return (const float*)g; }
DI void lds_sync() { asm volatile("s_waitcnt lgkmcnt(0)" ::: "memory"); __builtin_amdgcn_s_barrier(); asm volatile("" ::: "memory"); }
struct Ctx {
    float* out; unsigned char* ws;
    int tid, lane, wave, gtid, gthreads, gwave, gwaves, nblk, blk;
};
DI bf16* wsb(const Ctx& c, size_t off) { return (bf16*)(c.ws + off); }
DI float* wsf(const Ctx& c, size_t off) { return (float*)(c.ws + off); }
DI float* ssq_ptr(const Ctx& c, int idx) { return (float*)(c.ws + WS_SSQ) + (size_t)idx * M * 16; }
DI float rstd_of(const float* P, int row) {
    const float4* p = (const float4*)(P + (size_t)row * 16); const float4 a = p[0], b = p[1], c2 = p[2], d = p[3];
    const float s = (((a.x + a.y) + (a.z + a.w)) + ((b.x + b.y) + (b.z + b.w))) + (((c2.x + c2.y) + (c2.z + c2.w)) + ((d.x + d.y) + (d.z + d.w)));
    return rsqrtf(s * (1.f / D) + EPS);
}

#define XB_TMO      128
#define XB_XCNT(j)  (256  + 64 * (j))
#define XB_XSUB(j)  (1280 + 64 * (j))
#define XB_XGEN(j)  (2304 + 64 * (j))
#define XB_TOP      3328
#define XB_TOPGEN   3392
#define XCD_BAR_WORDS 3456
#define XB_SPIN_CAP (1u << 22)

__device__ __forceinline__ unsigned xb_ld(unsigned* p)              { return __hip_atomic_load(p, __ATOMIC_RELAXED, __HIP_MEMORY_SCOPE_AGENT); }
__device__ __forceinline__ unsigned xb_add(unsigned* p, unsigned v) { return __hip_atomic_fetch_add(p, v, __ATOMIC_RELAXED, __HIP_MEMORY_SCOPE_AGENT); }
__device__ __forceinline__ unsigned xb_xcc_id() { return (unsigned)__builtin_amdgcn_s_getreg((3 << 11) | 20) & 0xFu; }
#define XB_SPIN(cond, bar) do { unsigned _sp = 0; while (cond) { __builtin_amdgcn_s_sleep(1); \
    if ((++_sp & 255u) == 0u) { if (xb_ld(&(bar)[XB_TMO])) break; if (_sp > XB_SPIN_CAP) { atomicAdd(&(bar)[XB_TMO], 1u); break; } } } } while (0)

struct XcdBarrier {
    unsigned* bar; unsigned x;
    volatile LAS unsigned* st;
};

__device__ __forceinline__ XcdBarrier xcd_barrier_post(unsigned* bar, volatile LAS unsigned* st, bool is_t0  ) {
    XcdBarrier b; b.bar = bar; b.x = xb_xcc_id(); b.st = st;
    if (is_t0) (void)xb_add(&bar[XB_XCNT(b.x)], 1u);
    return b;
}
__device__ __forceinline__ void xcd_barrier_complete(unsigned* bar, unsigned x, unsigned& nloc, unsigned& nx) {
    const unsigned G = gridDim.x * gridDim.y * gridDim.z;
    unsigned sum, cnt, mine, sp = 0u;
    for (;;) {
        sum = 0u; cnt = 0u; mine = 0u;
#pragma unroll
        for (unsigned j = 0; j < 16; ++j) { const unsigned c = xb_ld(&bar[XB_XCNT(j)]); sum += c; cnt += (c > 0u) ? 1u : 0u; mine = (j == x) ? c : mine; }
        if (sum == G) break;
        __builtin_amdgcn_s_sleep(1);
        if ((++sp & 255u) == 0u) { if (xb_ld(&bar[XB_TMO])) break; if (sp > XB_SPIN_CAP) { atomicAdd(&bar[XB_TMO], 1u); break; } }
    }
    nloc = mine > 0u ? mine : 1u; nx = cnt > 0u ? cnt : 1u;
}

__device__ __forceinline__ void xcd_barrier(const XcdBarrier& b, bool is_t0  ) {
    asm volatile("s_waitcnt vmcnt(0)" ::: "memory");
    __syncthreads();
    if (is_t0) {
        unsigned* bar = b.bar;
        __builtin_amdgcn_s_waitcnt(0);
        unsigned nloc = b.st[0], nx = b.st[1];
        if (nloc == 0u) { xcd_barrier_complete(bar, b.x, nloc, nx); b.st[0] = nloc; b.st[1] = nx; }
        const unsigned old = xb_add(&bar[XB_XSUB(b.x)], 1u);
        const unsigned gen = old / nloc;
        if (old + 1u == (gen + 1u) * nloc) {
            __builtin_amdgcn_fence(__ATOMIC_RELEASE, "agent");
            asm volatile("s_waitcnt vmcnt(0)" ::: "memory");
            const unsigned og = xb_add(&bar[XB_TOP], 1u);
            const unsigned tg = og / nx;
            if (og + 1u == (tg + 1u) * nx) xb_add(&bar[XB_TOPGEN], 1u);
            else XB_SPIN(xb_ld(&bar[XB_TOPGEN]) == tg, bar);
            __builtin_amdgcn_fence(__ATOMIC_ACQUIRE, "agent");
            xb_add(&bar[XB_XGEN(b.x)], 1u);
            asm volatile("s_waitcnt vmcnt(0)" ::: "memory");
        } else {
            XB_SPIN(xb_ld(&bar[XB_XGEN(b.x)]) == gen, bar);
            __builtin_amdgcn_fence(__ATOMIC_ACQUIRE, "agent");
            asm volatile("s_waitcnt vmcnt(0)" ::: "memory");
        }
    }
    __syncthreads();
}

namespace pg8 {
#define PG8_LAS __attribute__((address_space(3)))
typedef unsigned short bf16_t;
typedef short bf16x8 __attribute__((ext_vector_type(8)));
typedef float f32x4 __attribute__((ext_vector_type(4)));
typedef unsigned u32x4 __attribute__((ext_vector_type(4)));
constexpr int BM = 256, BK = 64, HALF = 128, HTB = HALF * BK * 2  , STAGE_BYTES = 8 * HTB, NXCD = 8, WGM = 8;

__host__ __device__ __forceinline__ int lds_byte(int r, int c) { const int st = (r >> 4) * 2 + (c >> 5), rr = r & 15, cc = c & 31, ob = rr * 64 + cc * 2; return st * 1024 + (ob ^ (((ob >> 9) & 1) << 5)); }
__host__ __device__ __forceinline__ void stage_rc(int b, int& R, int& C) { const int st = b / 1024, sb = b % 1024, swz = sb ^ (((sb >> 9) & 1) << 5); R = (st >> 1) * 16 + swz / 64; C = (st & 1) * 32 + (swz % 64) / 2; }
__host__ __device__ __forceinline__ int perm32(int rho) { const int n = rho >> 4, i = rho & 15; return 8 * (i >> 2) + 4 * n + (i & 3); }

struct Unit { int pm, pn; };
struct Gemm { const bf16_t* A; const bf16_t* Bt; int M, N, K, lda, ldb; };

struct StaticOrder {
    int nM, nN, nwg, G, c;
    __host__ __device__ void init(int M, int N, int G_, int c_) { nM = M / BM; nN = N / BM; nwg = nM * nN; G = G_; c = c_; }
    __host__ __device__ bool next(int i, Unit& u) const {
        const long L = (long)i * G + c; if (L >= nwg) return false;
        int wgid = (int)L; { const int q = nwg / NXCD, r = nwg % NXCD, xcd = wgid % NXCD, off = wgid / NXCD; wgid = (xcd < r ? xcd * (q + 1) : r * (q + 1) + (xcd - r) * q) + off; }
        const int nig = WGM * nN, gid = wgid / nig, fm = gid * WGM, gsz = (nM - fm) < WGM ? (nM - fm) : WGM;
        u.pm = fm + ((wgid % nig) % gsz); u.pn = (wgid % nig) / gsz; return true;
    }
    __device__ __forceinline__ void a_ready(const Unit&) const {}
    __device__ __forceinline__ void done(const Unit&) const {}
};

template <class Epi, class Sched, bool ALIGN_EPI = false, bool SP2 = false>
__device__ __forceinline__ void gemm_phase(PG8_LAS unsigned char* lds, const Gemm g, const Sched& S, const Epi& E, int tid_in) {
    int tid_ = tid_in; asm volatile("" : "+v"(tid_));
    const int tid = tid_, wid = __builtin_amdgcn_readfirstlane(tid >> 6), lane = tid & 63, wr = wid >> 2, wc = wid & 3, fr = lane & 15, fq = lane >> 4;
    const int K = g.K, nt = K / BK;
    unsigned voffA[2], voffB[2];
#pragma unroll
    for (int i = 0; i < 2; ++i) { int R, C; stage_rc(tid * 16 + i * 8192, R, C); const int Rb = Epi::PERM ? ((R & ~31) + perm32(R & 31)) : R;
        voffA[i] = (unsigned)(R * g.lda + C) * 2u; voffB[i] = (unsigned)(Rb * g.ldb + C) * 2u; }
    const size_t kstep = (size_t)(BK * 2);
    const size_t hstepA = (size_t)HALF * g.lda * 2, hstepB = (size_t)HALF * g.ldb * 2;
    const size_t tstepA = 2 * hstepA, tstepB = 2 * hstepB;
    const unsigned ldsw = (unsigned)wid * 1024u;
    const int aoff = lds_byte(wr * 64 + fr, fq * 8), boff = lds_byte(wc * 32 + fr, fq * 8);
#define PG8_SA(b, h) (((b) * 2 + (h)) * HTB)
#define PG8_SB(b, h) ((4 + (b) * 2 + (h)) * HTB)
#define PG8_STAGE(bufoff, gbase, voff) do { _Pragma("unroll") for (int _i = 0; _i < 2; ++_i) \
        __builtin_amdgcn_global_load_lds((const unsigned*)((const char*)(gbase) + (voff)[_i]), (PG8_LAS unsigned*)(lds + (bufoff) + ldsw + _i * 8192), 16, 0, 0); } while (0)
#define PG8_LDA(dst, b, h) do { _Pragma("unroll") for (int m = 0; m < 4; ++m) _Pragma("unroll") for (int k = 0; k < 2; ++k) dst[m][k] = *(const PG8_LAS bf16x8*)(lds + PG8_SA(b, h) + aoff + m * 2048 + k * 1024); } while (0)
#define PG8_LDB(dst, b, h) do { _Pragma("unroll") for (int n = 0; n < 2; ++n) _Pragma("unroll") for (int k = 0; k < 2; ++k) dst[n][k] = *(const PG8_LAS bf16x8*)(lds + PG8_SB(b, h) + boff + n * 2048 + k * 1024); } while (0)
#define PG8_MMA(ai, bj, At, Bt) do { __builtin_amdgcn_s_setprio(1); _Pragma("unroll") for (int m = 0; m < 4; ++m) _Pragma("unroll") for (int n = 0; n < 2; ++n) _Pragma("unroll") for (int k = 0; k < 2; ++k) \
        acc[ai][bj][m][n] = __builtin_amdgcn_mfma_f32_16x16x32_bf16(Bt[n][k], At[m][k], acc[ai][bj][m][n], 0, 0, 0); __builtin_amdgcn_s_setprio(0); } while (0)
#define PG8_WAIT_V(n) asm volatile("s_waitcnt vmcnt(" #n ")" ::: "memory")
#define PG8_WAIT_L(n) asm volatile("s_waitcnt lgkmcnt(" #n ")" ::: "memory")
#define PG8_BAR __builtin_amdgcn_s_barrier()
#define PG8_SCHED __builtin_amdgcn_sched_barrier(0)
    Unit cur, nxt; int ui = 0;
    if (!S.next(0, cur)) return;
    f32x4 acc[2][2][4][2];
#pragma unroll
    for (int a = 0; a < 2; ++a)
#pragma unroll
        for (int b = 0; b < 2; ++b)
#pragma unroll
            for (int m = 0; m < 4; ++m)
#pragma unroll
                for (int n = 0; n < 2; ++n) acc[a][b][m][n] = (f32x4){0.f, 0.f, 0.f, 0.f};
    bf16x8 At[4][2], B0[2][2], B1[2][2];
    const char* cA = (const char*)g.A + (size_t)cur.pm * tstepA; const char* cB = (const char*)g.Bt + (size_t)cur.pn * tstepB;
    S.a_ready(cur);
    if constexpr (SP2) {
        PG8_STAGE(PG8_SB(0, 0), cB, voffB); PG8_STAGE(PG8_SB(0, 1), cB + hstepB, voffB); PG8_STAGE(PG8_SA(0, 0), cA, voffA); PG8_STAGE(PG8_SA(0, 1), cA + hstepA, voffA);
        if (wr == 1) PG8_BAR;
        PG8_WAIT_V(2); PG8_BAR;
        PG8_STAGE(PG8_SB(1, 0), cB + kstep, voffB); PG8_STAGE(PG8_SA(1, 0), cA + kstep, voffA); PG8_STAGE(PG8_SB(1, 1), cB + hstepB + kstep, voffB);
        PG8_WAIT_V(6); PG8_BAR;
    } else {
        PG8_STAGE(PG8_SB(0, 0), cB, voffB); PG8_STAGE(PG8_SA(0, 0), cA, voffA); PG8_STAGE(PG8_SB(0, 1), cB + hstepB, voffB); PG8_STAGE(PG8_SA(0, 1), cA + hstepA, voffA);
        if (wr == 1) PG8_BAR;
        PG8_WAIT_V(4); PG8_BAR;
        PG8_STAGE(PG8_SB(1, 0), cB + kstep, voffB); PG8_STAGE(PG8_SA(1, 0), cA + kstep, voffA); PG8_STAGE(PG8_SB(1, 1), cB + hstepB + kstep, voffB);
        PG8_WAIT_V(6); PG8_BAR;
    }
    for (;;) {
        const bool has_next = S.next(ui + 1, nxt);
        const char* nA = has_next ? (const char*)g.A + (size_t)nxt.pm * tstepA : cA; const char* nB = has_next ? (const char*)g.Bt + (size_t)nxt.pn * tstepB : cB;
#pragma unroll 1
        for (int t = 0; t < nt; t += 2) {
            const bool last = (t == nt - 2);
            const char* a1 = cA + (size_t)(t + 1) * kstep;
            const char* a2 = last ? nA : cA + (size_t)(t + 2) * kstep; const char* b2 = last ? nB : cB + (size_t)(t + 2) * kstep;
            const char* a3 = a2 + kstep; const char* b3 = b2 + kstep;
            if (last && has_next) S.a_ready(nxt);
            if constexpr (SP2) {
            PG8_LDB(B0, 0, 0); PG8_LDB(B1, 0, 1); PG8_SCHED; PG8_LDA(At, 0, 0); PG8_STAGE(PG8_SA(1, 1), a1 + hstepA, voffA);
            PG8_WAIT_V(8); PG8_WAIT_L(0); PG8_BAR; PG8_MMA(0, 0, At, B0); PG8_MMA(0, 1, At, B1); PG8_BAR; PG8_SCHED;
            PG8_LDA(At, 0, 1); PG8_STAGE(PG8_SB(0, 0), b2, voffB); PG8_STAGE(PG8_SB(0, 1), b2 + hstepB, voffB); PG8_STAGE(PG8_SA(0, 0), a2, voffA);
            PG8_WAIT_V(8); PG8_WAIT_L(0); PG8_BAR; PG8_MMA(1, 0, At, B0); PG8_MMA(1, 1, At, B1); PG8_BAR; PG8_SCHED;
            PG8_LDB(B0, 1, 0); PG8_LDB(B1, 1, 1); PG8_SCHED; PG8_LDA(At, 1, 0); PG8_STAGE(PG8_SA(0, 1), a2 + hstepA, voffA);
            PG8_WAIT_V(8); PG8_WAIT_L(0); PG8_BAR; PG8_MMA(0, 0, At, B0); PG8_MMA(0, 1, At, B1); PG8_BAR; PG8_SCHED;
            PG8_LDA(At, 1, 1); PG8_STAGE(PG8_SB(1, 0), b3, voffB); PG8_STAGE(PG8_SB(1, 1), b3 + hstepB, voffB); PG8_STAGE(PG8_SA(1, 0), a3, voffA);
            PG8_WAIT_V(8); PG8_WAIT_L(0); PG8_BAR; PG8_MMA(1, 0, At, B0); PG8_MMA(1, 1, At, B1); PG8_BAR; PG8_SCHED;
            } else {
            PG8_LDB(B0, 0, 0); PG8_SCHED; PG8_LDA(At, 0, 0); PG8_STAGE(PG8_SA(1, 1), a1 + hstepA, voffA);
            PG8_WAIT_L(8); PG8_BAR; PG8_WAIT_L(0); PG8_MMA(0, 0, At, B0); PG8_BAR; PG8_SCHED;
            PG8_LDB(B1, 0, 1); PG8_STAGE(PG8_SB(0, 0), b2, voffB);
            PG8_BAR; PG8_WAIT_L(0); PG8_MMA(0, 1, At, B1); PG8_BAR;
            PG8_LDA(At, 0, 1); PG8_STAGE(PG8_SA(0, 0), a2, voffA);
            PG8_BAR; PG8_WAIT_L(0); PG8_MMA(1, 0, At, B0); PG8_BAR; PG8_SCHED;
            PG8_STAGE(PG8_SB(0, 1), b2 + hstepB, voffB);
            PG8_WAIT_V(6); PG8_BAR; PG8_MMA(1, 1, At, B1); PG8_BAR;
            PG8_LDB(B0, 1, 0); PG8_SCHED; PG8_LDA(At, 1, 0); PG8_STAGE(PG8_SA(0, 1), a2 + hstepA, voffA);
            PG8_WAIT_L(8); PG8_BAR; PG8_WAIT_L(0); PG8_MMA(0, 0, At, B0); PG8_BAR; PG8_SCHED;
            PG8_LDB(B1, 1, 1); PG8_STAGE(PG8_SB(1, 0), b3, voffB);
            PG8_BAR; PG8_WAIT_L(0); PG8_MMA(0, 1, At, B1); PG8_BAR;
            PG8_LDA(At, 1, 1); PG8_STAGE(PG8_SA(1, 0), a3, voffA);
            PG8_BAR; PG8_WAIT_L(0); PG8_MMA(1, 0, At, B0); PG8_BAR; PG8_SCHED;
            PG8_STAGE(PG8_SB(1, 1), b3 + hstepB, voffB);
            PG8_WAIT_V(6); PG8_BAR; PG8_MMA(1, 1, At, B1); PG8_BAR;
            }
        }
        if constexpr (ALIGN_EPI) { if (wr == 0) PG8_BAR; }
        if constexpr (!Epi::AFTER_DRAIN) { E(acc, cur, wr, wc, fr, fq, ui); S.done(cur); }
        if (!has_next) break;
#pragma unroll
        for (int a = 0; a < 2; ++a)
#pragma unroll
            for (int b = 0; b < 2; ++b)
#pragma unroll
                for (int m = 0; m < 4; ++m)
#pragma unroll
                    for (int n = 0; n < 2; ++n) acc[a][b][m][n] = (f32x4){0.f, 0.f, 0.f, 0.f};
        cur = nxt; cA = nA; cB = nB; ++ui;
        if constexpr (ALIGN_EPI) { if (wr == 1) PG8_BAR; }
    }
    PG8_WAIT_V(0);
    if constexpr (!ALIGN_EPI) { if (wr == 0) PG8_BAR; }
    PG8_BAR;
    if constexpr (Epi::AFTER_DRAIN) { E.fused(acc, cur, wr, wc, fr, fq, lds, wid, lane); S.done(cur); }
#undef PG8_SA
#undef PG8_SB
#undef PG8_STAGE
#undef PG8_LDA
#undef PG8_LDB
#undef PG8_MMA
#undef PG8_WAIT_V
#undef PG8_WAIT_L
#undef PG8_BAR
#undef PG8_SCHED
}
}
struct PF0 {};
struct ESwiGLU {
    static constexpr int ID = 1; static constexpr bool NEEDS_RS = true; static constexpr bool PAIRED = true;
    const float* ssq_in; bf16* act;
    typedef PF0 PF; DI PF load(int, int) const { return PF0{}; }
    DI const float* ssq_src() const { return ssq_in; } DI float pre(int row) const { return rstd_of(ssq_in, row); }
    DI float operator()(int row, int col, const float (&a)[8], const float (&b)[8], float rs, const PF&) const {
        float o[8];
#pragma unroll
        for (int i = 0; i < 8; ++i) { const float g = a[i] * rs, u = b[i] * rs; o[i] = g * sigm(g) * u; }
        *(uint4*)(act + (size_t)row * FF + col) = pk8(o);
        return 0.f;
    }
};
struct EResid {
    static constexpr int ID = 2; static constexpr bool NEEDS_RS = false; static constexpr bool PAIRED = false;
    const bf16* XBin; bf16* XBout; float scale;
    struct PF { uint4 x; };
    DI PF load(int row, int col) const { PF p; p.x = *(const uint4*)(XBin + (size_t)row * D + col); return p; }
    DI const float* ssq_src() const { return nullptr; } DI float pre(int) const { return 0.f; }
    DI float operator()(int row, int col, const float (&a)[8], const float (&)[8], float, const PF& p) const {
        float o[8]; unpk8(p.x, o);
        float s = 0.f;
#pragma unroll
        for (int i = 0; i < 8; ++i) { o[i] += scale * a[i]; s += o[i] * o[i]; }
        *(uint4*)(XBout + (size_t)row * D + col) = pk8(o);
        return s;
    }
};
struct EWin {
    static constexpr int ID = 3; static constexpr bool NEEDS_RS = true; static constexpr bool PAIRED = false;
    const float* ssq_in; bf16 *UP, *US, *QKR, *V, *OS;
    typedef PF0 PF; DI PF load(int, int) const { return PF0{}; }
    DI const float* ssq_src() const { return ssq_in; } DI float pre(int row) const { return rstd_of(ssq_in, row); }
    DI float operator()(int row, int col, const float (&a)[8], const float (&)[8], float rs, const PF&) const {
        float o[8];
#pragma unroll
        for (int i = 0; i < 8; ++i) o[i] = a[i] * rs;
        if (col < 512) {
            if (row < MP) *(uint4*)(UP + up_off(row, col)) = pk8(o);
            else *(uint4*)(US + (size_t)(row - MP) * 512 + col) = pk8(o);
        } else if (col < 2560) { *(uint4*)(QKR + (size_t)row * 2048 + (col - 512)) = pk8(o); }
        else if (col < 3584) { *(uint4*)(V + (size_t)row * 1024 + (col - 2560)) = pk8(o); }
        else {
#pragma unroll
            for (int i = 0; i < 8; ++i) o[i] = sigm(o[i]);
            const int seg = (col - 3584) >> 10, cc = (col - 3584) & 1023;
            *(uint4*)(OS + (size_t)seg * ((size_t)M * 1024) + (size_t)row * 1024 + cc) = pk8(o);
        }
        return 0.f;
    }
};
struct EGlu {
    static constexpr int ID = 4; static constexpr bool NEEDS_RS = false; static constexpr bool PAIRED = false;
    const bf16* YS5; bf16* YG;
    struct PF { uint4 y; };
    DI PF load(int row, int col) const { PF p; p.y = *(const uint4*)(YS5 + (size_t)row * 512 + col); return p; }
    DI const float* ssq_src() const { return nullptr; } DI float pre(int) const { return 0.f; }
    DI float operator()(int row, int col, const float (&a)[8], const float (&)[8], float, const PF& p) const {
        float y[8]; unpk8(p.y, y);
#pragma unroll
        for (int i = 0; i < 8; ++i) y[i] = y[i] * sigm(a[i]);
        *(uint4*)(YG + (size_t)row * 512 + col) = pk8(y);
        return 0.f;
    }
};
struct ET5 {
    static constexpr int ID = 5; static constexpr bool NEEDS_RS = false; static constexpr bool PAIRED = false;
    const bf16* GS5; bf16* T5;
    struct PF { uint4 g; };
    DI PF load(int row, int col) const { PF p; p.g = *(const uint4*)(GS5 + (size_t)row * 1024 + col); return p; }
    DI const float* ssq_src() const { return nullptr; } DI float pre(int) const { return 0.f; }
    DI float operator()(int row, int col, const float (&a)[8], const float (&)[8], float, const PF& p) const {
        float g[8]; unpk8(p.g, g);
#pragma unroll
        for (int i = 0; i < 8; ++i) g[i] *= a[i];
        *(uint4*)(T5 + (size_t)row * 1024 + col) = pk8(g);
        return 0.f;
    }
};
struct EMerged {
    static constexpr int ID = 6; static constexpr bool NEEDS_RS = false; static constexpr bool PAIRED = false;
    const bf16* T5; const bf16* GM; bf16* MRG;
    struct PF { uint4 t, g; };
    DI PF load(int row, int col) const { PF p; p.t = *(const uint4*)(T5 + (size_t)row * 1024 + col); p.g = *(const uint4*)(GM + (size_t)row * 1024 + col); return p; }
    DI const float* ssq_src() const { return nullptr; } DI float pre(int) const { return 0.f; }
    DI float operator()(int row, int col, const float (&a)[8], const float (&)[8], float, const PF& p) const {
        float g[8], o[8]; unpk8(p.g, g); unpk8(p.t, o);
#pragma unroll
        for (int i = 0; i < 8; ++i) o[i] += g[i] * a[i];
        *(uint4*)(MRG + (size_t)row * 1024 + col) = pk8(o);
        return 0.f;
    }
};
struct EGate {
    static constexpr int ID = 7; static constexpr bool NEEDS_RS = true; static constexpr bool PAIRED = false;
    const float* ssq_in; bf16* GT;
    typedef PF0 PF; DI PF load(int, int) const { return PF0{}; }
    DI const float* ssq_src() const { return ssq_in; } DI float pre(int row) const { return rstd_of(ssq_in, row); }
    DI float operator()(int row, int col, const float (&a)[8], const float (&)[8], float rs, const PF&) const {
        float o[8];
#pragma unroll
        for (int i = 0; i < 8; ++i) o[i] = sigm(a[i] * rs);
        *(uint4*)(GT + (size_t)row * 1024 + col) = pk8(o);
        return 0.f;
    }
};
struct EPle {
    static constexpr int ID = 8; static constexpr bool NEEDS_RS = false; static constexpr bool PAIRED = false;
    const bf16* XBin; bf16* XBout; const bf16* GT; float scale;
    struct PF { uint4 x, g; };
    DI PF load(int row, int col) const { PF p; p.x = *(const uint4*)(XBin + (size_t)row * D + col); p.g = *(const uint4*)(GT + (size_t)row * 1024 + col); return p; }
    DI const float* ssq_src() const { return nullptr; } DI float pre(int) const { return 0.f; }
    DI float operator()(int row, int col, const float (&a)[8], const float (&)[8], float, const PF& p) const {
        float g[8], o[8]; unpk8(p.g, g); unpk8(p.x, o);
        float s = 0.f;
#pragma unroll
        for (int i = 0; i < 8; ++i) { o[i] += scale * g[i] * a[i]; s += o[i] * o[i]; }
        *(uint4*)(XBout + (size_t)row * D + col) = pk8(o);
        return s;
    }
};

template <class F>
DI void gemm_ref(const Ctx& c, const bf16* A, int lda, const bf16* Bt, int ldb, int Mrows, int Ncols, int K, const F& f, float* ssq_out) {
    const int ng = Ncols >> 3;
    const long items = (long)Mrows * ng;
    for (long it = c.gtid; it < items; it += c.gthreads) {
        const int row = (int)(it % Mrows), c0 = (int)(it / Mrows) * 8;
        float a[8], b[8];
#pragma unroll
        for (int j = 0; j < 8; ++j) { a[j] = 0.f; b[j] = 0.f; }
        const bf16* ar = A + (size_t)row * lda;
        const int br0 = F::PAIRED ? ((c0 >> 7) * 256 + (c0 & 127)) : c0;
        const bf16* br = Bt + (size_t)br0 * ldb;
        for (int k0 = 0; k0 < K; k0 += 8) {
            const uint4 av = *(const uint4*)(ar + k0);
#pragma unroll
            for (int j = 0; j < 8; ++j) {
                a[j] = dot8(av, *(const uint4*)(br + (size_t)j * ldb + k0), a[j]);
                if (F::PAIRED) b[j] = dot8(av, *(const uint4*)(br + (size_t)(128 + j) * ldb + k0), b[j]);
            }
        }
        (void)f(row, c0, a, b, f.pre(row), f.load(row, c0)); (void)ssq_out;
    }
}

DI void tr_mat(const Ctx& c, bf16* dst, int N, int K, const float* srcA, const float* srcB, int Nsrc, const float* gain, int mode, int cut, int skip) {
    const long total = (long)N * (K >> 3);
    for (long idx = c.gtid; idx < total; idx += c.gthreads) {
        const int n = (int)(idx % N), kg = (int)(idx / N);
        const float* s; int sc;
        if (mode == 1) { const int tile = n >> 8, l = n & 255; s = l < 128 ? srcA : srcB; sc = tile * 128 + (l & 127); }
        else { s = srcA; sc = n + (n >= cut ? skip : 0); }
        float v[8];
#pragma unroll
        for (int i = 0; i < 8; ++i) { const int k = kg * 8 + i; float w = s[(size_t)k * Nsrc + sc]; if (gain) w *= gain[k]; v[i] = w; }
        *(uint4*)(dst + (size_t)n * (K + PADK) + kg * 8) = pk8(v);
    }
}
DI void tr_tile(LAS float* scr, const float* W, int Nsrc, int scol0, const float* gain, bf16* dst, int K, int n0, int k0, int lane) {
    float wv[32];
#pragma unroll
    for (int i = 0; i < 32; ++i) wv[i] = W[(size_t)(k0 + 2 * i + (lane >> 5)) * Nsrc + scol0 + (lane & 31)];
    if (gain) {
#pragma unroll
        for (int i = 0; i < 32; ++i) wv[i] *= gain[k0 + 2 * i + (lane >> 5)];
    }
#pragma unroll
    for (int i = 0; i < 32; ++i) scr[(2 * i + (lane >> 5)) * 33 + (lane & 31)] = wv[i];
    asm volatile("s_waitcnt lgkmcnt(0)" ::: "memory");
    const int ch = lane & 7;
#pragma unroll
    for (int j = 0; j < 4; ++j) {
        const int n = (lane >> 3) + 8 * j; const LAS float* sp = scr + (8 * ch) * 33 + n;
        float v[8];
#pragma unroll
        for (int i = 0; i < 8; ++i) v[i] = sp[i * 33];
        *(uint4*)(dst + (size_t)(n0 + n) * (K + PADK) + k0 + 8 * ch) = pk8(v);
    }
    asm volatile("s_waitcnt lgkmcnt(0)" ::: "memory");
}
DI void stage_prologue(const Args& a, const Ctx& c, unsigned char* lds_) {
    LAS float* scr = (LAS float*)lds_ + c.wave * (64 * 33);
    constexpr int T_W1GU = 16 * 128, T_W1D = 32 * 32, T_WIN = 16 * (INN / 32), T_WGLU = 8 * 16, T_WS5UP = 8 * 32, T_SQ = 16 * 32, T_WPLE = 4 * 32;
    constexpr int T_LAYER = 2 * T_W1GU + 2 * T_W1D + T_WIN + T_WGLU + T_WS5UP + 3 * T_SQ + T_WPLE;
    for (int it = c.gwave; it < NL * T_LAYER; it += c.gwaves) {
        const int l = it / T_LAYER; int r = it % T_LAYER;
        unsigned char* lw = c.ws + WS_W + (size_t)l * LW_STRIDE;
        if (r < 2 * T_W1GU) {
            const int which = r / T_W1GU; r %= T_W1GU; const int kb = r / 128, nb = r % 128, n0 = nb * 32, tile = n0 >> 8, lrow = n0 & 255;
            const float* src = inptr(which ? (lrow < 128 ? I_W2G : I_W2U) : (lrow < 128 ? I_W1G : I_W1U)) + (size_t)l * D * FF;
            tr_tile(scr, src, FF, tile * 128 + (lrow & 127), inptr(which ? I_GFFN2 : I_GFFN1) + l * D, (bf16*)(lw + (which ? LW_W2GU : LW_W1GU)), 1024, n0, kb * 64, c.lane); continue; }
        r -= 2 * T_W1GU;
        if (r < 2 * T_W1D) { const int which = r / T_W1D; r %= T_W1D; const int kb = r / 32, nb = r % 32;
            tr_tile(scr, inptr(which ? I_W2D : I_W1D) + (size_t)l * FF * D, D, nb * 32, nullptr, (bf16*)(lw + (which ? LW_W2D : LW_W1D)), 2048, nb * 32, kb * 64, c.lane); continue; }
        r -= 2 * T_W1D;
        if (r < T_WIN) { const int kb = r / (INN / 32), nb = r % (INN / 32), n0 = nb * 32;
            tr_tile(scr, inptr(I_WIN) + (size_t)l * D * INC, INC, n0 + (n0 >= 4608 ? 8 : 0), inptr(I_GMIX) + l * D, (bf16*)(lw + LW_WIN), 1024, n0, kb * 64, c.lane); continue; }
        r -= T_WIN;
        if (r < T_WGLU) { const int kb = r / 16, nb = r % 16; tr_tile(scr, inptr(I_WGLU) + (size_t)l * 512 * 512, 512, nb * 32, nullptr, (bf16*)(lw + LW_WGLU), 512, nb * 32, kb * 64, c.lane); continue; }
        r -= T_WGLU;
        if (r < T_WS5UP) { const int kb = r / 32, nb = r % 32; tr_tile(scr, inptr(I_WS5UP) + (size_t)l * 512 * 1024, 1024, nb * 32, nullptr, (bf16*)(lw + LW_WS5UP), 512, nb * 32, kb * 64, c.lane); continue; }
        r -= T_WS5UP;
        if (r < 3 * T_SQ) { const int which = r / T_SQ; r %= T_SQ; const int kb = r / 32, nb = r % 32;
            const float* src = inptr(which == 0 ? I_WMUP : (which == 1 ? I_WOUT : I_WPG)) + (size_t)l * 1024 * 1024;
            const float* gain = which == 2 ? inptr(I_GPLE) + l * D : nullptr;
            tr_tile(scr, src, 1024, nb * 32, gain, (bf16*)(lw + (which == 0 ? LW_WMUP : (which == 1 ? LW_WOUT : LW_WPG))), 1024, nb * 32, kb * 64, c.lane); continue; }
        r -= 3 * T_SQ;
        { const int kb = r / 32, nb = r % 32; tr_tile(scr, inptr(I_WPLE) + (size_t)l * 256 * 1024, 1024, nb * 32, nullptr, (bf16*)(lw + LW_WPLE), 256, nb * 32, kb * 64, c.lane); }
    }
    for (int l = 0; l < NL; ++l) {
        float* wg = (float*)(c.ws + WS_W + (size_t)l * LW_STRIDE + LW_WG);
        for (int idx = c.gtid; idx < 8 * 1024; idx += c.gthreads) { const int j = idx >> 10, k = idx & 1023; wg[idx] = inptr(I_WIN)[(size_t)l * D * INC + (size_t)k * INC + 4608 + j] * inptr(I_GMIX)[l * D + k]; }
    }
    bf16* XB = wsb(c, WS_XB); float* ssq0 = ssq_ptr(c, 0);
    for (int row = c.gwave; row < M; row += c.gwaves) {
        const float* src = row < MP ? inptr(I_XP) + (size_t)row * D : inptr(I_XS) + (size_t)(row - MP) * D;
        float s = 0.f;
#pragma unroll
        for (int j = 0; j < 4; ++j) {
            const int col = (c.lane + 64 * j) * 4;
            const float4 v = *(const float4*)(src + col);
            uint2 w; w.x = pk2(v.x, v.y); w.y = pk2(v.z, v.w); *(uint2*)(XB + (size_t)row * D + col) = w;
            s += v.x * v.x + v.y * v.y + v.z * v.z + v.w * v.w;
        }
        s = wave_sum(s);
        if (c.lane < 16) ssq0[(size_t)row * 16 + c.lane] = c.lane == 0 ? s : 0.f;
    }
    bf16* PB = wsb(c, WS_PB);
    const long tp = (long)NL * M * (DPLE / 8);
    for (long idx0 = c.gtid; idx0 < tp; idx0 += 4L * c.gthreads) {
        float4 pa[4], pb[4];
#pragma unroll
        for (int j = 0; j < 4; ++j) {
            const long idx = idx0 + (long)j * c.gthreads;
            if (idx < tp) {
                const int cg = (int)(idx % (DPLE / 8)); const long rl = idx / (DPLE / 8); const int row = (int)(rl % M), l = (int)(rl / M);
                const float* src = row < MP ? inptr(I_PP) + ((size_t)l * MP + row) * DPLE + cg * 8 : inptr(I_PS) + ((size_t)l * MS + (row - MP)) * DPLE + cg * 8;
                pa[j] = *(const float4*)src; pb[j] = *(const float4*)(src + 4);
            }
        }
#pragma unroll
        for (int j = 0; j < 4; ++j) {
            const long idx = idx0 + (long)j * c.gthreads;
            if (idx < tp) {
                const int cg = (int)(idx % (DPLE / 8)); const long rl = idx / (DPLE / 8); const int row = (int)(rl % M), l = (int)(rl / M);
                float v[8] = {pa[j].x, pa[j].y, pa[j].z, pa[j].w, pb[j].x, pb[j].y, pb[j].z, pb[j].w};
                *(uint4*)(PB + ((size_t)l * M + row) * DPLE + cg * 8) = pk8(v);
            }
        }
    }
}

DI void conv_row(const float (&w)[4][8], const float (&bias)[8], const float (&x0)[8], const float (&x1)[8], const float (&x2)[8], const float (&x3)[8], int c0, size_t row, bf16* Q, bf16* Kb) {
    float o[8];
#pragma unroll
    for (int i = 0; i < 8; ++i) { const float v = bias[i] + w[0][i] * x0[i] + w[1][i] * x1[i] + w[2][i] * x2[i] + w[3][i] * x3[i]; o[i] = v * sigm(v) * (c0 < 1024 ? 0.0625f : 1.f); }
    if (c0 < 1024) *(uint4*)(Q + row * 1024 + c0) = pk8(o); else *(uint4*)(Kb + row * 1024 + (c0 - 1024)) = pk8(o);
}
DI void stage_conv(const Args& a, const Ctx& c, int l) {
    const bf16* QKR = wsb(c, WS_QKR); bf16* Q = wsb(c, WS_Q); bf16* Kb = wsb(c, WS_K);
    const float* cw = inptr(I_CONVW) + (size_t)l * 4 * 2048; const float* cb = inptr(I_CONVB) + (size_t)l * 2048;
    const float* st = inptr(I_CONV) + (size_t)l * NBS * 3 * 2048;
    constexpr int NPI = NBP * 256 * 64, NSI = NBS * 256;
    for (int it = c.gtid; it < NPI + NSI; it += c.gthreads) {
        const bool smp = it >= NPI; const int j = smp ? it - NPI : it, cg = j & 255, c0 = cg * 8;
        float w[4][8], bias[8];
#pragma unroll
        for (int q = 0; q < 4; ++q) { const float4 w0 = *(const float4*)(cw + q * 2048 + c0), w1 = *(const float4*)(cw + q * 2048 + c0 + 4); w[q][0] = w0.x; w[q][1] = w0.y; w[q][2] = w0.z; w[q][3] = w0.w; w[q][4] = w1.x; w[q][5] = w1.y; w[q][6] = w1.z; w[q][7] = w1.w; }
        { const float4 b0 = *(const float4*)(cb + c0), b1 = *(const float4*)(cb + c0 + 4); bias[0] = b0.x; bias[1] = b0.y; bias[2] = b0.z; bias[3] = b0.w; bias[4] = b1.x; bias[5] = b1.y; bias[6] = b1.z; bias[7] = b1.w; }
        float x0[8], x1[8], x2[8];
        if (!smp) {
            const int seg = (j >> 8) & 63, b = j >> 14, t0 = seg * 32; const size_t rb = (size_t)b * SEQ + t0;
            if (t0 == 0) {
#pragma unroll
                for (int i = 0; i < 8; ++i) { x0[i] = 0.f; x1[i] = 0.f; x2[i] = 0.f; }
            } else { unpk8(*(const uint4*)(QKR + (rb - 3) * 2048 + c0), x0); unpk8(*(const uint4*)(QKR + (rb - 2) * 2048 + c0), x1); unpk8(*(const uint4*)(QKR + (rb - 1) * 2048 + c0), x2); }
#pragma unroll 1
            for (int t8 = 0; t8 < 32; t8 += 8) {
                uint4 xr[8];
#pragma unroll
                for (int i = 0; i < 8; ++i) xr[i] = *(const uint4*)(QKR + (rb + t8 + i) * 2048 + c0);
#pragma unroll
                for (int i = 0; i < 8; ++i) {
                    float x3[8]; unpk8(xr[i], x3);
                    conv_row(w, bias, x0, x1, x2, x3, c0, rb + t8 + i, Q, Kb);
#pragma unroll
                    for (int e = 0; e < 8; ++e) { x0[e] = x1[e]; x1[e] = x2[e]; x2[e] = x3[e]; }
                }
            }
            if (seg == 63) {
                float* o = c.out + O_CONV_P + (((size_t)l * NBP + b) * 3) * 2048 + c0;
                *(float4*)o = make_float4(x0[0], x0[1], x0[2], x0[3]); *(float4*)(o + 4) = make_float4(x0[4], x0[5], x0[6], x0[7]);
                *(float4*)(o + 2048) = make_float4(x1[0], x1[1], x1[2], x1[3]); *(float4*)(o + 2048 + 4) = make_float4(x1[4], x1[5], x1[6], x1[7]);
                *(float4*)(o + 4096) = make_float4(x2[0], x2[1], x2[2], x2[3]); *(float4*)(o + 4096 + 4) = make_float4(x2[4], x2[5], x2[6], x2[7]);
            }
        } else {
            const int bs = j >> 8; const size_t rb = (size_t)MP + (size_t)bs * SS;
            const float* sp = st + (size_t)bs * 3 * 2048 + c0;
            { const float4 p0 = *(const float4*)sp, p1 = *(const float4*)(sp + 4); x0[0] = p0.x; x0[1] = p0.y; x0[2] = p0.z; x0[3] = p0.w; x0[4] = p1.x; x0[5] = p1.y; x0[6] = p1.z; x0[7] = p1.w; }
            { const float4 p0 = *(const float4*)(sp + 2048), p1 = *(const float4*)(sp + 2048 + 4); x1[0] = p0.x; x1[1] = p0.y; x1[2] = p0.z; x1[3] = p0.w; x1[4] = p1.x; x1[5] = p1.y; x1[6] = p1.z; x1[7] = p1.w; }
            { const float4 p0 = *(const float4*)(sp + 4096), p1 = *(const float4*)(sp + 4096 + 4); x2[0] = p0.x; x2[1] = p0.y; x2[2] = p0.z; x2[3] = p0.w; x2[4] = p1.x; x2[5] = p1.y; x2[6] = p1.z; x2[7] = p1.w; }
            uint4 xr[4];
#pragma unroll
            for (int i = 0; i < 4; ++i) xr[i] = *(const uint4*)(QKR + (rb + i) * 2048 + c0);
#pragma unroll
            for (int i = 0; i < 4; ++i) {
                float x3[8]; unpk8(xr[i], x3);
                conv_row(w, bias, x0, x1, x2, x3, c0, rb + i, Q, Kb);
#pragma unroll
                for (int e = 0; e < 8; ++e) { x0[e] = x1[e]; x1[e] = x2[e]; x2[e] = x3[e]; }
            }
            float* o = c.out + O_CONV_S + (((size_t)l * NBS + bs) * 3) * 2048 + c0;
            *(float4*)o = make_float4(x0[0], x0[1], x0[2], x0[3]); *(float4*)(o + 4) = make_float4(x0[4], x0[5], x0[6], x0[7]);
            *(float4*)(o + 2048) = make_float4(x1[0], x1[1], x1[2], x1[3]); *(float4*)(o + 2048 + 4) = make_float4(x1[4], x1[5], x1[6], x1[7]);
            *(float4*)(o + 4096) = make_float4(x2[0], x2[1], x2[2], x2[3]); *(float4*)(o + 4096 + 4) = make_float4(x2[4], x2[5], x2[6], x2[7]);
        }
    }
}

DI void stage_gates(const Args& a, const Ctx& c, int l, const float* ssq_in, const bf16* XB) {
    const float* wg = (const float*)(c.ws + WS_W + (size_t)l * LW_STRIDE + LW_WG);
    float* LI = wsf(c, WS_LI); float* LF = wsf(c, WS_LF);
    float w[8][16];
#pragma unroll
    for (int j = 0; j < 8; ++j)
#pragma unroll
        for (int q = 0; q < 4; ++q) { const float4 wv = *(const float4*)(wg + j * 1024 + c.lane * 16 + 4 * q); w[j][4 * q] = wv.x; w[j][4 * q + 1] = wv.y; w[j][4 * q + 2] = wv.z; w[j][4 * q + 3] = wv.w; }
    const float bi = c.lane < 4 ? inptr(I_BIG)[l * 4 + c.lane] : 0.f, bfg = c.lane < 4 ? inptr(I_BFG)[l * 4 + c.lane] : 0.f;
    int row = c.gwave;
    uint4 n0 = make_uint4(0, 0, 0, 0), n1 = n0;
    if (row < M) { n0 = *(const uint4*)(XB + (size_t)row * D + c.lane * 16); n1 = *(const uint4*)(XB + (size_t)row * D + c.lane * 16 + 8); }
    for (; row < M; row += c.gwaves) {
        float x[16];
        { float t0[8], t1[8]; unpk8(n0, t0); unpk8(n1, t1);
#pragma unroll
          for (int i = 0; i < 8; ++i) { x[i] = t0[i]; x[8 + i] = t1[i]; } }
        const int nr = row + c.gwaves;
        if (nr < M) { n0 = *(const uint4*)(XB + (size_t)nr * D + c.lane * 16); n1 = *(const uint4*)(XB + (size_t)nr * D + c.lane * 16 + 8); }
        float acc[8];
#pragma unroll
        for (int j = 0; j < 8; ++j) {
            float s = 0.f;
#pragma unroll
            for (int q = 0; q < 16; ++q) s += w[j][q] * x[q];
            acc[j] = wave_sum(s);
        }
        const float rstd = rstd_of(ssq_in, row);
        if (c.lane < 4) {
            float ig = acc[0]; ig = c.lane == 1 ? acc[1] : ig; ig = c.lane == 2 ? acc[2] : ig; ig = c.lane == 3 ? acc[3] : ig;
            float fg = acc[4]; fg = c.lane == 1 ? acc[5] : fg; fg = c.lane == 2 ? acc[6] : fg; fg = c.lane == 3 ? acc[7] : fg;
            LI[(size_t)row * 4 + c.lane] = ig * rstd + bi;
            const float z = fg * rstd + bfg;
            LF[(size_t)row * 4 + c.lane] = (z >= 0.f) ? -__logf(1.f + __expf(-z)) : (z - __logf(1.f + __expf(z)));
        }
    }
}

DI void stage_s5_ref(const Args& a, const Ctx& c, int l, unsigned char* lds) {
    float* hst = (float*)lds + c.wave * 128;
    const bf16* UP = wsb(c, WS_UP); const bf16* US = wsb(c, WS_US); bf16* YS5 = wsb(c, WS_YS5);
    const int nitems = (NBP + NBS) * NG;
    for (int it = (FAST_S5 ? NBP * NG : 0) + c.gwave; it < nitems; it += c.gwaves) {
        const int seq = it / NG, g = it % NG, n = c.lane;
        const float lre = inptr(I_LRE)[((size_t)l * NG + g) * NST + n], lim = inptr(I_LIM)[((size_t)l * NG + g) * NST + n];
        const float dt = expf(inptr(I_LDT)[l * NG + g]);
        const float mag = expf(lre * dt), ar = mag * cosf(lim * dt), ai = mag * sinf(lim * dt);
        const float den = lre * lre + lim * lim, pr = ar - 1.f;
        const float wre = (pr * lre + ai * lim) / den, wim = (ai * lre - pr * lim) / den;
        float bbr[16], bbi[16];
        { const float* bre = inptr(I_BRE) + (((size_t)l * NG + g) * NST + n) * 16; const float* bim = inptr(I_BIM) + (((size_t)l * NG + g) * NST + n) * 16;
#pragma unroll
          for (int j = 0; j < 16; ++j) { const float r = bre[j], i = bim[j]; bbr[j] = wre * r - wim * i; bbi[j] = wre * i + wim * r; } }
        const int hh = c.lane & 15, part = c.lane >> 4;
        float cre[16], cim[16];
        { const float* pr_ = inptr(I_CRE) + (((size_t)l * NG + g) * 16 + hh) * NST + part * 16; const float* pi_ = inptr(I_CIM) + (((size_t)l * NG + g) * 16 + hh) * NST + part * 16;
#pragma unroll
          for (int i = 0; i < 16; ++i) { cre[i] = pr_[i]; cim[i] = pi_[i]; } }
        const float dsk = inptr(I_S5D)[l * S5W + g * 16 + hh];
        float hr = 0.f, hi = 0.f; int S, row0;
        if (seq < NBP) { S = SEQ; row0 = seq * SEQ; }
        else { const int bs = seq - NBP; S = SS; row0 = MP + bs * SS; hr = inptr(I_S5RE)[(((size_t)l * NBS + bs) * NG + g) * NST + n]; hi = inptr(I_S5IM)[(((size_t)l * NBS + bs) * NG + g) * NST + n]; }
        for (int t = 0; t < S; ++t) {
            const int row = row0 + t;
            const bf16* up = row < MP ? UP + up_off(row, g * 16) : US + (size_t)(row - MP) * 512 + g * 16;
            float u[16];
            { float t0[8], t1[8]; unpk8(*(const uint4*)up, t0); unpk8(*(const uint4*)(up + 8), t1);
#pragma unroll
              for (int i = 0; i < 8; ++i) { u[i] = t0[i]; u[8 + i] = t1[i]; } }
            float bur = 0.f, bui = 0.f;
#pragma unroll
            for (int j = 0; j < 16; ++j) { bur += bbr[j] * u[j]; bui += bbi[j] * u[j]; }
            const float nr = ar * hr - ai * hi + bur, ni = ar * hi + ai * hr + bui;
            hr = nr; hi = ni;
            hst[2 * n] = hr; hst[2 * n + 1] = hi;
            asm volatile("s_waitcnt lgkmcnt(0)" ::: "memory");
            float y = 0.f;
#pragma unroll
            for (int i = 0; i < 16; ++i) { const float2 hv = *(const float2*)(hst + 2 * (part * 16 + i)); y += cre[i] * hv.x - cim[i] * hv.y; }
            asm volatile("s_waitcnt lgkmcnt(0)" ::: "memory");
            y += __shfl_xor(y, 16); y += __shfl_xor(y, 32);
            y += dsk * bf2f(up[hh]);
            if (c.lane < 16) YS5[(size_t)row * 512 + g * 16 + hh] = (bf16)f2bf(gelu_tanh(y));
        }
        float* ore = c.out + (seq < NBP ? O_S5RE_P + (((size_t)l * NBP + seq) * NG + g) * NST : O_S5RE_S + (((size_t)l * NBS + (seq - NBP)) * NG + g) * NST);
        float* oim = c.out + (seq < NBP ? O_S5IM_P + (((size_t)l * NBP + seq) * NG + g) * NST : O_S5IM_S + (((size_t)l * NBS + (seq - NBP)) * NG + g) * NST);
        ore[n] = hr; oim[n] = hi;
    }
}

DI void stage_s5_sample(const Args& a, const Ctx& c, int l, unsigned char* lds_) {
    LAS float* hst = (LAS float*)lds_ + c.wave * 128;
    const bf16* US = wsb(c, WS_US); bf16* YS5 = wsb(c, WS_YS5);
    for (int it = c.gwave; it < NG * (NBS / 2); it += c.gwaves) {
        const int g = it & 31, bsp = it >> 5, n = c.lane;
        const float lre = inptr(I_LRE)[((size_t)l * NG + g) * NST + n], lim = inptr(I_LIM)[((size_t)l * NG + g) * NST + n];
        const float dt = expf(inptr(I_LDT)[l * NG + g]);
        const float mag = expf(lre * dt), ar = mag * cosf(lim * dt), ai = mag * sinf(lim * dt);
        const float den = lre * lre + lim * lim, pr = ar - 1.f;
        const float wre = (pr * lre + ai * lim) / den, wim = (ai * lre - pr * lim) / den;
        float bbr[16], bbi[16];
        { const float4* bre = (const float4*)(inptr(I_BRE) + (((size_t)l * NG + g) * NST + n) * 16); const float4* bim = (const float4*)(inptr(I_BIM) + (((size_t)l * NG + g) * NST + n) * 16);
#pragma unroll
          for (int j = 0; j < 4; ++j) { const float4 r = bre[j], i = bim[j];
              bbr[4 * j] = wre * r.x - wim * i.x; bbi[4 * j] = wre * i.x + wim * r.x; bbr[4 * j + 1] = wre * r.y - wim * i.y; bbi[4 * j + 1] = wre * i.y + wim * r.y;
              bbr[4 * j + 2] = wre * r.z - wim * i.z; bbi[4 * j + 2] = wre * i.z + wim * r.z; bbr[4 * j + 3] = wre * r.w - wim * i.w; bbi[4 * j + 3] = wre * i.w + wim * r.w; } }
        const int hh = c.lane & 15, part = c.lane >> 4;
        float cre[16], cim[16];
        { const float4* pr_ = (const float4*)(inptr(I_CRE) + (((size_t)l * NG + g) * 16 + hh) * NST + part * 16); const float4* pi_ = (const float4*)(inptr(I_CIM) + (((size_t)l * NG + g) * 16 + hh) * NST + part * 16);
#pragma unroll
          for (int i = 0; i < 4; ++i) { const float4 r = pr_[i], m = pi_[i]; cre[4 * i] = r.x; cre[4 * i + 1] = r.y; cre[4 * i + 2] = r.z; cre[4 * i + 3] = r.w; cim[4 * i] = m.x; cim[4 * i + 1] = m.y; cim[4 * i + 2] = m.z; cim[4 * i + 3] = m.w; } }
        const float dsk = inptr(I_S5D)[l * S5W + g * 16 + hh];
#pragma unroll 1
        for (int s2 = 0; s2 < 2; ++s2) {
            const int bs = 2 * bsp + s2;
            float hr = inptr(I_S5RE)[(((size_t)l * NBS + bs) * NG + g) * NST + n], hi = inptr(I_S5IM)[(((size_t)l * NBS + bs) * NG + g) * NST + n];
#pragma unroll
            for (int t = 0; t < SS; ++t) {
                const int row = MP + bs * SS + t;
                const bf16* up = US + (size_t)(row - MP) * 512 + g * 16;
                float u[16];
                { float t0[8], t1[8]; unpk8(*(const uint4*)up, t0); unpk8(*(const uint4*)(up + 8), t1);
#pragma unroll
                  for (int i = 0; i < 8; ++i) { u[i] = t0[i]; u[8 + i] = t1[i]; } }
                float bur = 0.f, bui = 0.f;
#pragma unroll
                for (int j = 0; j < 16; ++j) { bur += bbr[j] * u[j]; bui += bbi[j] * u[j]; }
                const float nr = ar * hr - ai * hi + bur, ni = ar * hi + ai * hr + bui;
                hr = nr; hi = ni;
                hst[2 * n] = hr; hst[2 * n + 1] = hi;
                asm volatile("s_waitcnt lgkmcnt(0)" ::: "memory");
                float y = 0.f;
#pragma unroll
                for (int i = 0; i < 16; ++i) { const float hvx = hst[2 * (part * 16 + i)], hvy = hst[2 * (part * 16 + i) + 1]; y += cre[i] * hvx - cim[i] * hvy; }
                asm volatile("s_waitcnt lgkmcnt(0)" ::: "memory");
                y += __shfl_xor(y, 16); y += __shfl_xor(y, 32);
                y += dsk * bf2f(up[hh]);
                if (c.lane < 16) YS5[(size_t)row * 512 + g * 16 + hh] = (bf16)f2bf(gelu_tanh(y));
            }
            c.out[O_S5RE_S + (((size_t)l * NBS + bs) * NG + g) * NST + n] = hr;
            c.out[O_S5IM_S + (((size_t)l * NBS + bs) * NG + g) * NST + n] = hi;
        }
    }
}

DI void stage_mlstm_ref(const Args& a, const Ctx& c, int l, unsigned char* lds) {
    float* Cs = (float*)lds;
    float* ns = Cs + 256 * 64;
    float* red = ns + 256;
    float* nqr = red + 512;
    const bf16* Q = wsb(c, WS_Q); const bf16* Kb = wsb(c, WS_K); const bf16* V = wsb(c, WS_V);
    const float* LI = wsf(c, WS_LI); const float* LF = wsf(c, WS_LF); float* Hh = wsf(c, WS_H);
    const int v = c.tid & 63, kg = c.tid >> 6;
    const int nitems = (NBP + NBS) * NH * 4;
    for (int it = c.blk; it < nitems; it += c.nblk) {
        const int seq = it >> 4, h = (it >> 2) & 3, vb = it & 3;
        int S, row0; float m = 0.f;
        __syncthreads();
        if (seq < NBP) {
            S = SEQ; row0 = seq * SEQ;
#pragma unroll 4
            for (int kk = 0; kk < 32; ++kk) Cs[(kg * 32 + kk) * 64 + v] = 0.f;
            if (c.tid < 256) ns[c.tid] = 0.f;
        } else {
            const int bs = seq - NBP; S = SS; row0 = MP + bs * SS;
            const float* c0 = inptr(I_MC) + (((size_t)l * NBS + bs) * NH + h) * DH * DH;
#pragma unroll 4
            for (int kk = 0; kk < 32; ++kk) Cs[(kg * 32 + kk) * 64 + v] = c0[(size_t)(kg * 32 + kk) * DH + vb * 64 + v];
            if (c.tid < 256) ns[c.tid] = inptr(I_MN)[(((size_t)l * NBS + bs) * NH + h) * DH + c.tid];
            m = inptr(I_MM)[((size_t)l * NBS + bs) * NH + h];
        }
        __syncthreads();
        for (int t = 0; t < S; ++t) {
            const int row = row0 + t;
            const float li = LI[(size_t)row * 4 + h], lf = LF[(size_t)row * 4 + h];
            const float mn = fmaxf(lf + m, li), fd = __expf(lf + m - mn), iw = __expf(li - mn);
            m = mn;
            const bf16* qp = Q + (size_t)row * 1024 + h * 256; const bf16* kp = Kb + (size_t)row * 1024 + h * 256;
            const float vv = bf2f(V[(size_t)row * 1024 + h * 256 + vb * 64 + v]) * iw;
            float part = 0.f;
#pragma unroll
            for (int q8 = 0; q8 < 4; ++q8) {
                float qf[8], kf[8];
                unpk8(*(const uint4*)(qp + kg * 32 + q8 * 8), qf); unpk8(*(const uint4*)(kp + kg * 32 + q8 * 8), kf);
#pragma unroll
                for (int i = 0; i < 8; ++i) { float* cp = Cs + (kg * 32 + q8 * 8 + i) * 64 + v; const float cn = fd * (*cp) + kf[i] * vv; *cp = cn; part += qf[i] * cn; }
            }
            red[kg * 64 + v] = part;
            if (c.tid < 256) {
                const float nn = fd * ns[c.tid] + iw * bf2f(kp[c.tid]); ns[c.tid] = nn;
                const float pq = wave_sum(bf2f(qp[c.tid]) * nn);
                if (c.lane == 0) nqr[c.wave] = pq;
            }
            __syncthreads();
            if (c.tid < 64) {
                float num = 0.f;
#pragma unroll
                for (int g8 = 0; g8 < 8; ++g8) num += red[g8 * 64 + c.tid];
                const float nq = (nqr[0] + nqr[1]) + (nqr[2] + nqr[3]);
                Hh[(size_t)row * 1024 + h * 256 + vb * 64 + c.tid] = num / fmaxf(fabsf(nq), __expf(-m));
            }
            __syncthreads();
        }
        float* oc = c.out + (seq < NBP ? O_C_P + (((size_t)l * NBP + seq) * NH + h) * DH * DH : O_C_S + (((size_t)l * NBS + (seq - NBP)) * NH + h) * DH * DH);
#pragma unroll 4
        for (int kk = 0; kk < 32; ++kk) oc[(size_t)(kg * 32 + kk) * DH + vb * 64 + v] = Cs[(kg * 32 + kk) * 64 + v];
        if (vb == 0) {
            float* on = c.out + (seq < NBP ? O_N_P + (((size_t)l * NBP + seq) * NH + h) * DH : O_N_S + (((size_t)l * NBS + (seq - NBP)) * NH + h) * DH);
            if (c.tid < 256) on[c.tid] = ns[c.tid];
            if (c.tid == 0) { float* om = c.out + (seq < NBP ? O_M_P + ((size_t)l * NBP + seq) * NH + h : O_M_S + ((size_t)l * NBS + (seq - NBP)) * NH + h); *om = m; }
        }
    }
    __syncthreads();
}

DI void stage_headnorm(const Args& a, const Ctx& c, int l, int row_lo) {
    const float* Hh = wsf(c, WS_H); const bf16* OS = wsb(c, WS_OS); bf16* HM = wsb(c, WS_HM);
    const float* gm = inptr(I_GMH) + (size_t)l * MW;
    for (int it = row_lo * NH + c.gwave; it < M * NH; it += c.gwaves) {
        const int row = it >> 2, h = it & 3; const size_t off = (size_t)row * 1024 + h * 256 + c.lane * 4;
        const float4 x = *(const float4*)(Hh + off);
        const float ss = wave_sum(x.x * x.x + x.y * x.y + x.z * x.z + x.w * x.w);
        const float rs = rsqrtf(ss * (1.f / DH) + EPS);
        const float4 g = *(const float4*)(gm + h * 256 + c.lane * 4);
        const uint2 ow = *(const uint2*)(OS + off);
        uint2 w; w.x = pk2(x.x * rs * g.x * bflo(ow.x), x.y * rs * g.y * bfhi(ow.x)); w.y = pk2(x.z * rs * g.z * bflo(ow.y), x.w * rs * g.w * bfhi(ow.y));
        *(uint2*)(HM + off) = w;
    }
}

DI void stage_final(const Args& a, const Ctx& c, const bf16* XB) {
    const float* ssq = ssq_ptr(c, 16); const float* gf = inptr(I_GFIN);
    for (int row = c.gwave; row < M; row += c.gwaves) {
        const float rstd = rstd_of(ssq, row);
#pragma unroll
        for (int j = 0; j < 2; ++j) {
            const int col = (c.lane + 64 * j) * 8;
            float x[8]; unpk8(*(const uint4*)(XB + (size_t)row * D + col), x);
            const float4 g0 = *(const float4*)(gf + col), g1 = *(const float4*)(gf + col + 4);
            float* o = c.out + O_Y + (size_t)row * D + col;
            *(float4*)o = make_float4(x[0] * rstd * g0.x, x[1] * rstd * g0.y, x[2] * rstd * g0.z, x[3] * rstd * g0.w);
            *(float4*)(o + 4) = make_float4(x[4] * rstd * g1.x, x[5] * rstd * g1.y, x[6] * rstd * g1.z, x[7] * rstd * g1.w);
        }
    }
}

DI void stage_ssq(const Ctx& c, float* ssq_out, const bf16* XB) {
    for (int row = c.gwave; row < M; row += c.gwaves) {
        float s = 0.f;
#pragma unroll
        for (int j = 0; j < 2; ++j) { float x[8]; unpk8(*(const uint4*)(XB + (size_t)row * D + (c.lane + 64 * j) * 8), x);
#pragma unroll
            for (int i = 0; i < 8; ++i) s += x[i] * x[i]; }
        s = wave_sum(s);
        if (c.lane < 16) ssq_out[(size_t)row * 16 + c.lane] = c.lane == 0 ? s : 0.f;
    }
}

template <class F> struct EpiA {
    static constexpr bool PERM = true, AFTER_DRAIN = false;
    F f; float* ssq_part;
    LAS float* rc;
    DI void operator()(const pg8::f32x4 (&acc)[2][2][4][2], const pg8::Unit& u, int wr, int wc, int fr, int fq, int ui) const {
        float rsv[8];
        if (F::NEEDS_RS) {
            bool hit = false;
            if (ui != 0) { const int tg = ((const LAS int*)rc)[256]; hit = (tg & 0xffff) == u.pm && (tg >> 16) <= ui; }
            if (hit) {
#pragma unroll
                for (int i = 0; i < 8; ++i) rsv[i] = rc[(i >> 2) * 128 + wr * 64 + (i & 3) * 16 + fr];
            } else {
                const float* P = f.ssq_src(); pg8::f32x4 q[8];
#pragma unroll
                for (int i = 0; i < 8; ++i) q[i] = *(const pg8::f32x4*)(P + (size_t)(u.pm * 256 + (i >> 2) * 128 + wr * 64 + (i & 3) * 16 + fr) * 16 + 4 * fq);
#pragma unroll
                for (int i = 0; i < 8; ++i) { float t = (q[i][0] + q[i][1]) + (q[i][2] + q[i][3]); t += __shfl_xor(t, 16); t += __shfl_xor(t, 32); rsv[i] = rsqrtf(t * (1.f / D) + EPS); }
                if (wc == 0 && fq == 0) {
#pragma unroll
                    for (int i = 0; i < 8; ++i) rc[(i >> 2) * 128 + wr * 64 + (i & 3) * 16 + fr] = rsv[i];
                    if (wr == 0 && fr == 0) ((LAS int*)rc)[256] = u.pm | ((ui + 1) << 16);
                }
            }
        } else {
#pragma unroll
            for (int i = 0; i < 8; ++i) rsv[i] = 0.f;
        }
        constexpr int NC = F::PAIRED ? 8 : 16;
        constexpr int PD = sizeof(typename F::PF) <= 4 ? 1 : (sizeof(typename F::PF) <= 16 ? 8 : 4);
        const int colb = F::PAIRED ? (u.pn * 128 + wc * 32 + 8 * fq) : (u.pn * 256 + wc * 32 + 8 * fq);
        typename F::PF ring[PD];
#pragma unroll
        for (int q = 0; q < PD && q < NC; ++q) {
            const int g8n = F::PAIRED ? q : (q >> 1), bjn = F::PAIRED ? 0 : (q & 1);
            int rown = u.pm * 256 + (g8n >> 2) * 128 + wr * 64 + (g8n & 3) * 16 + fr; asm volatile("" : "+v"(rown)); ring[q] = f.load(rown, colb + bjn * 128);
        }
        float srow = 0.f;
#pragma unroll
        for (int q = 0; q < NC; ++q) {
            const int g8 = F::PAIRED ? q : (q >> 1), bj = F::PAIRED ? 0 : (q & 1), ai = g8 >> 2, m = g8 & 3;
            int row = u.pm * 256 + ai * 128 + wr * 64 + m * 16 + fr; asm volatile("" : "+v"(row));
            const typename F::PF pf = ring[q % PD];
            if (q + PD < NC) { const int g8n = F::PAIRED ? (q + PD) : ((q + PD) >> 1), bjn = F::PAIRED ? 0 : ((q + PD) & 1);
                               int rown = u.pm * 256 + (g8n >> 2) * 128 + wr * 64 + (g8n & 3) * 16 + fr; asm volatile("" : "+v"(rown)); ring[q % PD] = f.load(rown, colb + bjn * 128); }
            const float rs = rsv[g8];
            float s;
            if (F::PAIRED) {
                const float a[8] = {acc[ai][0][m][0][0], acc[ai][0][m][0][1], acc[ai][0][m][0][2], acc[ai][0][m][0][3], acc[ai][0][m][1][0], acc[ai][0][m][1][1], acc[ai][0][m][1][2], acc[ai][0][m][1][3]};
                const float b[8] = {acc[ai][1][m][0][0], acc[ai][1][m][0][1], acc[ai][1][m][0][2], acc[ai][1][m][0][3], acc[ai][1][m][1][0], acc[ai][1][m][1][1], acc[ai][1][m][1][2], acc[ai][1][m][1][3]};
                s = f(row, colb, a, b, rs, pf);
            } else {
                const float a[8] = {acc[ai][bj][m][0][0], acc[ai][bj][m][0][1], acc[ai][bj][m][0][2], acc[ai][bj][m][0][3], acc[ai][bj][m][1][0], acc[ai][bj][m][1][1], acc[ai][bj][m][1][2], acc[ai][bj][m][1][3]};
                s = f(row, colb + bj * 128, a, a, rs, pf);
            }
            srow = (F::PAIRED || bj == 0) ? s : srow + s;
            if (ssq_part && (F::PAIRED || bj == 1)) { float t = srow; t += __shfl_xor(t, 16); t += __shfl_xor(t, 32); if (fq == 0) ssq_part[(size_t)row * 16 + u.pn * 4 + wc] = t; }
            asm volatile("" ::: "memory");
        }
    }
};
template <class F>
DI void gemm_fast(const Ctx& c, unsigned char* lds, const bf16* A, int lda, const bf16* Bt, int ldb, int Mrows, int Nbt, int K, const F& f, float* ssq_part) {
    pg8::Gemm g{A, Bt, Mrows, Nbt, K, lda, ldb};
    pg8::StaticOrder S; S.init(Mrows, Nbt, c.nblk, c.blk);
    EpiA<F> E{f, ssq_part, (LAS float*)((LAS unsigned char*)lds + pg8::STAGE_BYTES)};
    pg8::gemm_phase<EpiA<F>, pg8::StaticOrder, GEMM_ALIGN, true>((PG8_LAS unsigned char*)lds, g, S, E, c.tid);
}

template <class F, int WR, int TR, int WC, int KS>
DI void gemm_thin(const Ctx& c, unsigned char* lds_, const bf16* A, int lda, const bf16* Bt, int ldb, int Ncols, int K, const F& f, float* ssq_part) {
    static_assert(WR * WC * KS == 8, "eight waves");
    constexpr int NB = F::PAIRED ? 4 : 2, UR = WR * TR * 16, UC = WC * 32, UB = F::PAIRED ? 2 * UC : UC, RT = UR + UB, NRB = MS / UR, NI = RT * 32 / NTHR, TP = 528;
    static_assert(RT * 32 % NTHR == 0 && RT * TP + 8192 + 1024 <= MISC_OFF, "thin GEMM LDS map");
    LAS unsigned char* lds = (LAS unsigned char*)lds_;
    LAS unsigned char* sA = lds; LAS unsigned char* sB = lds + UR * TP;
    LAS pg8::f32x4* red = (LAS pg8::f32x4*)(lds + RT * TP);
    LAS float* ssqr = (LAS float*)(lds + RT * TP + 8192);
    const int tid = c.tid, lane = c.lane, l15 = lane & 15, q4 = lane >> 4, w = c.wave, wc = w % WC, wr = (w / WC) % WR, ks = w / (WC * WR), wg = w % (WC * WR);
    const int ncb = Ncols / UC, nch = K >> 8;
    const int upx = (NRB * ncb) >> 3, xcd = c.blk & 7, bpx = c.nblk >> 3;
    for (int ui = c.blk >> 3; ui < upx; ui += bpx) {
        const int u = xcd * upx + ui;
        const int rb = u % NRB, cb = u / NRB, r0u = rb * UR, c0u = cb * UC;
        const bf16* src[NI];
#pragma unroll
        for (int i = 0; i < NI; ++i) {
            const int it = tid + NTHR * i, row = it >> 5, seg = it & 31;
            if (row < UR) src[i] = A + (size_t)(r0u + row) * lda + seg * 8;
            else { const int j = row - UR; int brow;
                   if (F::PAIRED) brow = (c0u >> 7) * 256 + (c0u & 127) + (j < UC ? j : 128 + (j - UC)); else brow = c0u + j;
                   src[i] = Bt + (size_t)brow * ldb + seg * 8; }
        }
        uint4 pre[NI];
#pragma unroll
        for (int i = 0; i < NI; ++i) pre[i] = *(const uint4*)(src[i]);
        pg8::f32x4 acc[TR][NB];
#pragma unroll
        for (int tr = 0; tr < TR; ++tr)
#pragma unroll
            for (int n = 0; n < NB; ++n) acc[tr][n] = (pg8::f32x4){0.f, 0.f, 0.f, 0.f};
        float prv[TR]; typename F::PF pfv[TR];
#pragma unroll
        for (int tr = 0; tr < TR; ++tr) { const int row = MP + r0u + wr * TR * 16 + tr * 16 + l15, col = c0u + wc * 32 + 8 * q4; prv[tr] = f.pre(row); pfv[tr] = f.load(row, col); }
        for (int kc = 0; kc < nch; ++kc) {
            lds_sync();
#pragma unroll
            for (int i = 0; i < NI; ++i) { const int it = tid + NTHR * i; *(LAS u32x4t*)(lds + (it >> 5) * TP + (it & 31) * 16) = (u32x4t){pre[i].x, pre[i].y, pre[i].z, pre[i].w}; }
            lds_sync();
            if (kc + 1 < nch) {
#pragma unroll
                for (int i = 0; i < NI; ++i) pre[i] = *(const uint4*)(src[i] + (kc + 1) * 256);
            }
#pragma unroll
            for (int kk = 0; kk < 8 / KS; ++kk) {
                const int kof = ((ks * (8 / KS) + kk) * 32 + 8 * q4) * 2;
                pg8::bf16x8 av[TR], bv[NB];
#pragma unroll
                for (int tr = 0; tr < TR; ++tr) av[tr] = *(const LAS pg8::bf16x8*)(sA + (wr * TR * 16 + tr * 16 + l15) * TP + kof);
#pragma unroll
                for (int n = 0; n < NB; ++n) bv[n] = *(const LAS pg8::bf16x8*)(sB + (wc * 32 + 8 * (l15 >> 2) + 4 * (n & 1) + (l15 & 3) + (n >> 1) * UC) * TP + kof);
#pragma unroll
                for (int tr = 0; tr < TR; ++tr)
#pragma unroll
                    for (int n = 0; n < NB; ++n) acc[tr][n] = __builtin_amdgcn_mfma_f32_16x16x32_bf16(bv[n], av[tr], acc[tr][n], 0, 0, 0);
            }
        }
        const int r0 = r0u + wr * TR * 16, c0 = c0u + wc * 32;
        if (KS > 1) {
            lds_sync();
            if (ks > 0) {
#pragma unroll
                for (int tr = 0; tr < TR; ++tr)
#pragma unroll
                    for (int n = 0; n < NB; ++n) red[(((ks - 1) * (WR * WC) + wg) * (TR * NB) + tr * NB + n) * 64 + lane] = acc[tr][n];
            }
            lds_sync();
            if (ks == 0) {
#pragma unroll
                for (int kk = 1; kk < KS; ++kk)
#pragma unroll
                    for (int tr = 0; tr < TR; ++tr)
#pragma unroll
                        for (int n = 0; n < NB; ++n) acc[tr][n] += red[(((kk - 1) * (WR * WC) + wg) * (TR * NB) + tr * NB + n) * 64 + lane];
            }
        }
        float ssv[TR];
#pragma unroll
        for (int tr = 0; tr < TR; ++tr) {
            ssv[tr] = 0.f;
            if (ks == 0) {
                const int row = MP + r0 + tr * 16 + l15, col = c0 + 8 * q4;
                const float a8[8] = {acc[tr][0][0], acc[tr][0][1], acc[tr][0][2], acc[tr][0][3], acc[tr][1][0], acc[tr][1][1], acc[tr][1][2], acc[tr][1][3]};
                if (F::PAIRED) { const float b8[8] = {acc[tr][NB - 2][0], acc[tr][NB - 2][1], acc[tr][NB - 2][2], acc[tr][NB - 2][3], acc[tr][NB - 1][0], acc[tr][NB - 1][1], acc[tr][NB - 1][2], acc[tr][NB - 1][3]}; ssv[tr] = f(row, col, a8, b8, prv[tr], pfv[tr]); }
                else ssv[tr] = f(row, col, a8, a8, prv[tr], pfv[tr]);
            }
        }
        if (ssq_part) {
            lds_sync();
#pragma unroll
            for (int tr = 0; tr < TR; ++tr) { float s = ssv[tr]; s += __shfl_xor(s, 16); s += __shfl_xor(s, 32); if (ks == 0 && q4 == 0) ssqr[wc * UR + wr * TR * 16 + tr * 16 + l15] = s; }
            lds_sync();
            if (c.tid < UR) ssq_part[(size_t)(MP + rb * UR + c.tid) * 16 + cb] = ssqr[c.tid] + ssqr[UR + c.tid];
        }
    }
}
typedef short s16x4 __attribute__((ext_vector_type(4)));
using pg8::bf16x8; using pg8::f32x4;
constexpr int PT = 528, PHB = 272;
constexpr int L_Q = 0, L_P = 0, L_VH = 35840, L_K = 71680, L_F = 139264;
constexpr int F_AL = 0, F_PM = 128, F_BT = 256, F_QN = 384, F_NQP = 512, F_SUM = 1024  , F_NP = 1056, F_SSP = 1312, F_END = 1824;
static_assert(L_P + 128 * PHB <= L_VH && L_VH + 128 * PHB <= L_K && L_K + 128 * PT <= L_F && L_F + F_END * 4 <= MISC_OFF, "mLSTM LDS map");
constexpr size_t UNIT_E = 65536;

#define MFMA16(a, b, c) __builtin_amdgcn_mfma_f32_16x16x32_bf16((a), (b), (c), 0, 0, 0)
#define TR_2F(o, a, P4) asm volatile("ds_read_b64_tr_b16 %0, %4\n\tds_read_b64_tr_b16 %1, %4 offset:" #P4 "\n\tds_read_b64_tr_b16 %2, %4 offset:32\n\tds_read_b64_tr_b16 %3, %4 offset:32+" #P4 "\n\ts_waitcnt lgkmcnt(0)" \
    : "=&v"(o[0]), "=&v"(o[1]), "=&v"(o[2]), "=&v"(o[3]) : "v"(a) : "memory")
#define TR_4F(o, a, P4) asm volatile("ds_read_b64_tr_b16 %0, %8\n\tds_read_b64_tr_b16 %1, %8 offset:" #P4 "\n\tds_read_b64_tr_b16 %2, %8 offset:32\n\tds_read_b64_tr_b16 %3, %8 offset:32+" #P4 "\n\t" \
    "ds_read_b64_tr_b16 %4, %8 offset:64\n\tds_read_b64_tr_b16 %5, %8 offset:64+" #P4 "\n\tds_read_b64_tr_b16 %6, %8 offset:96\n\tds_read_b64_tr_b16 %7, %8 offset:96+" #P4 "\n\ts_waitcnt lgkmcnt(0)" \
    : "=&v"(o[0]), "=&v"(o[1]), "=&v"(o[2]), "=&v"(o[3]), "=&v"(o[4]), "=&v"(o[5]), "=&v"(o[6]), "=&v"(o[7]) : "v"(a) : "memory")
typedef unsigned u32x4n __attribute__((ext_vector_type(4)));
typedef unsigned u32x2n __attribute__((ext_vector_type(2)));
DI uint4 lds_ld16(const LAS unsigned char* p) { const u32x4n v = *(const LAS u32x4n*)p; return make_uint4(v[0], v[1], v[2], v[3]); }
DI void lds_st16(LAS unsigned char* p, uint4 v) { *(LAS u32x4n*)p = (u32x4n){v.x, v.y, v.z, v.w}; }
DI void lds_st8(LAS unsigned char* p, uint2 v) { *(LAS u32x2n*)p = (u32x2n){v.x, v.y}; }
DI f32x4 lds_ldf4(const LAS float* p) { return *(const LAS f32x4*)p; }
DI void lds_stf4(LAS float* p, float4 v) { *(LAS f32x4*)p = (f32x4){v.x, v.y, v.z, v.w}; }
DI bf16x8 cat8(s16x4 lo, s16x4 hi) { return __builtin_shufflevector(lo, hi, 0, 1, 2, 3, 4, 5, 6, 7); }

DI void load_tile(LAS unsigned char* lds, int lbase, int lpitch, const bf16* g, int gpitch, int rows, int lgc, int tid) {
    const int total = rows << lgc;
    for (int idx = tid; idx < total; idx += NTHR) {
        const int r = idx >> lgc, chn = idx & ((1 << lgc) - 1);
        const uint4 v = *(const uint4*)(g + (size_t)r * gpitch + chn * 8);
        lds_st16(lds + lbase + r * lpitch + chn * 16, v);
    }
}
template <int NI> DI void tile_fetch(uint4 (&r)[NI], const bf16* g, int gpitch, int lgc, int tid) {
#pragma unroll
    for (int i = 0; i < NI; ++i) { const int idx = tid + NTHR * i, rr = idx >> lgc, chn = idx & ((1 << lgc) - 1); r[i] = *(const uint4*)(g + (size_t)rr * gpitch + chn * 8); }
}
template <int NI> DI void tile_store(LAS unsigned char* lds, int lbase, int lpitch, const uint4 (&r)[NI], int lgc, int tid) {
#pragma unroll
    for (int i = 0; i < NI; ++i) { const int idx = tid + NTHR * i, rr = idx >> lgc, chn = idx & ((1 << lgc) - 1); lds_st16(lds + lbase + rr * lpitch + chn * 16, r[i]); }
}
DI void gate_part1(const float* LI, const float* LF, int seq_row0, int h, int ch, LAS float* F, int lane, int wave) {
#pragma unroll
    for (int rep = 0; rep < 2; ++rep) {
        const int cc = wave + 8 * rep;
        if (cc <= ch) {
            const size_t r0 = (size_t)(seq_row0 + cc * 128 + 2 * lane);
            const float lf0 = LF[r0 * 4 + h], lf1 = LF[(r0 + 1) * 4 + h], li0 = LI[r0 * 4 + h], li1 = LI[(r0 + 1) * 4 + h];
            const float ps = lf0 + lf1; float incl = ps;
#pragma unroll
            for (int o = 1; o < 64; o <<= 1) { const float t = __shfl_up(incl, o); if (lane >= o) incl += t; }
            const float b0 = (incl - ps) + lf0, b1 = incl;
            const float a0 = li0 - b0, a1 = li1 - b1;
            float cm = fmaxf(a0, a1);
#pragma unroll
            for (int o = 1; o < 64; o <<= 1) { const float t = __shfl_up(cm, o); if (lane >= o) cm = fmaxf(cm, t); }
            if (lane == 63) { F[F_SUM + 2 * cc] = incl; F[F_SUM + 2 * cc + 1] = cm; }
            if (cc == ch) {
                float prev = __shfl_up(cm, 1); if (lane == 0) prev = -3.0e38f;
                F[F_AL + 2 * lane] = a0; F[F_AL + 2 * lane + 1] = a1;
                F[F_PM + 2 * lane] = fmaxf(prev, a0); F[F_PM + 2 * lane + 1] = cm;
                F[F_BT + 2 * lane] = b0; F[F_BT + 2 * lane + 1] = b1;
            }
        }
    }
}
DI float gate_mprev(const LAS float* F, int ch) {
    float m = 0.f;
    for (int cc = 0; cc < ch; ++cc) m = F[F_SUM + 2 * cc] + fmaxf(m, F[F_SUM + 2 * cc + 1]);
    return m;
}

template <int PM>
DI void mlstm_A_unit(const Ctx& c, unsigned char* lds_, int u) {
    LAS unsigned char* lds = (LAS unsigned char*)lds_;
    LAS float* F = (LAS float*)(lds + L_F);
    const unsigned ldsb = (unsigned)(size_t)lds_;
    const int b = u >> 6, h = (u >> 4) & 3, ch = u & 15, row0 = b * SEQ + ch * 128;
    const int tid = c.tid, lane = c.lane, wr = c.wave >> 2, wc = c.wave & 3, l15 = lane & 15, q4 = lane >> 4;
    const bf16* Qg = wsb(c, WS_Q) + (size_t)row0 * 1024 + h * 256; const bf16* Kg = wsb(c, WS_K) + (size_t)row0 * 1024 + h * 256; const bf16* Vg = wsb(c, WS_V) + (size_t)row0 * 1024 + h * 256;
    { uint4 tq[8], tk[8];
      tile_fetch<8>(tq, Qg, 1024, 5, tid); tile_fetch<8>(tk, Kg, 1024, 5, tid);
      tile_store<8>(lds, L_Q, PT, tq, 5, tid); tile_store<8>(lds, L_K, PT, tk, 5, tid); }
    uint4 vpre[4]; tile_fetch<4>(vpre, Vg, 1024, 4, tid);
    gate_part1(wsf(c, WS_LI), wsf(c, WS_LF), b * SEQ, h, ch, F, lane, c.wave);
    lds_sync();
    const float mprev = gate_mprev(F, ch), pml = fmaxf(mprev, F[F_SUM + 2 * ch + 1]), blast = F[F_SUM + 2 * ch];
    f32x4 acc[2][4];
#pragma unroll
    for (int si = 0; si < 2; ++si)
#pragma unroll
        for (int ti = 0; ti < 4; ++ti) acc[si][ti] = (f32x4){0.f, 0.f, 0.f, 0.f};
#pragma unroll 4
    for (int ks = 0; ks < 8; ++ks) {
        bf16x8 a[2], bq[4];
#pragma unroll
        for (int si = 0; si < 2; ++si) a[si] = *(const LAS bf16x8*)(lds + L_K + (32 * wc + 16 * si + l15) * PT + (32 * ks + 8 * q4) * 2);
#pragma unroll
        for (int ti = 0; ti < 4; ++ti) bq[ti] = *(const LAS bf16x8*)(lds + L_Q + (64 * wr + 16 * ti + l15) * PT + (32 * ks + 8 * q4) * 2);
#pragma unroll
        for (int si = 0; si < 2; ++si)
#pragma unroll
            for (int ti = 0; ti < 4; ++ti) acc[si][ti] = MFMA16(a[si], bq[ti], acc[si][ti]);
    }
    uint2 pp[2][4];
#pragma unroll
    for (int ti = 0; ti < 4; ++ti) {
        const int t = 64 * wr + 16 * ti + l15; const float pmt = fmaxf(mprev, F[F_PM + t]); float nqs = 0.f;
#pragma unroll
        for (int si = 0; si < 2; ++si) {
            const int s0 = 32 * wc + 16 * si + 4 * q4;
            const f32x4 al4 = lds_ldf4(F + F_AL + s0); const float4 al = make_float4(al4[0], al4[1], al4[2], al4[3]);
            const float p0 = (s0 + 0 <= t) ? acc[si][ti][0] * __expf(al.x - pmt) : 0.f;
            const float p1 = (s0 + 1 <= t) ? acc[si][ti][1] * __expf(al.y - pmt) : 0.f;
            const float p2 = (s0 + 2 <= t) ? acc[si][ti][2] * __expf(al.z - pmt) : 0.f;
            const float p3 = (s0 + 3 <= t) ? acc[si][ti][3] * __expf(al.w - pmt) : 0.f;
            nqs += (p0 + p1) + (p2 + p3);
            pp[si][ti].x = pk2(p0, p1); pp[si][ti].y = pk2(p2, p3);
        }
        nqs += __shfl_xor(nqs, 16); nqs += __shfl_xor(nqs, 32);
        if (q4 == 0) F[F_NQP + t * 4 + wc] = nqs;
    }
    lds_sync();
#pragma unroll
    for (int ti = 0; ti < 4; ++ti)
#pragma unroll
        for (int si = 0; si < 2; ++si) lds_st8(lds + L_P + (64 * wr + 16 * ti + l15) * PHB + (32 * wc + 16 * si + 4 * q4) * 2, pp[si][ti]);
    {
        const int s = tid >> 2, seg = tid & 3; const float wk = __expf(F[F_AL + s] - pml);
#pragma unroll
        for (int j = 0; j < 8; ++j) {
            LAS unsigned char* p = lds + L_K + s * PT + (seg * 64 + j * 8) * 2;
            float x[8]; unpk8(lds_ld16(p), x);
#pragma unroll
            for (int i = 0; i < 8; ++i) x[i] *= wk;
            lds_st16(p, pk8(x));
        }
    }
    tile_store<4>(lds, L_VH, PHB, vpre, 4, tid);
    tile_fetch<4>(vpre, Vg + 128, 1024, 4, tid);
    lds_sync();
    if (PM & 2) {
    if (tid < 128) wsf(c, WS_NQI)[(size_t)(row0 + tid) * 4 + h] = (F[F_NQP + tid * 4 + 0] + F[F_NQP + tid * 4 + 1]) + (F[F_NQP + tid * 4 + 2] + F[F_NQP + tid * 4 + 3]);
    if (tid < 256) {
        float s = 0.f;
#pragma unroll 8
        for (int r = 0; r < 128; ++r) s += bf2f(*(const LAS bf16*)(lds + L_K + r * PT + tid * 2));
        wsf(c, WS_DN)[(size_t)u * 256 + tid] = s;
    }
    if (tid == 0) { wsf(c, WS_DEC)[u] = __expf(mprev - pml); wsf(c, WS_MNEW)[u] = blast + pml; }
    }
    bf16* NI = wsb(c, WS_NI); bf16* DCT = wsb(c, WS_DCT) + (size_t)u * UNIT_E;
    for (int half = 0; half < 2; ++half) {
        if (half) { lds_sync(); tile_store<4>(lds, L_VH, PHB, vpre, 4, tid); lds_sync(); }
        if (PM & 4) {
            f32x4 a2[2][4];
#pragma unroll
            for (int vi = 0; vi < 2; ++vi)
#pragma unroll
                for (int ti = 0; ti < 4; ++ti) a2[vi][ti] = (f32x4){0.f, 0.f, 0.f, 0.f};
#pragma unroll
            for (int ks = 0; ks < 4; ++ks) {
                s16x4 o[4]; const unsigned va = ldsb + L_VH + (32 * ks + 8 * q4 + (l15 >> 2)) * PHB + (32 * wc + 4 * (lane & 3)) * 2;
                TR_2F(o, va, 1088);
                const bf16x8 av0 = cat8(o[0], o[1]), av1 = cat8(o[2], o[3]);
                bf16x8 bp[4];
#pragma unroll
                for (int ti = 0; ti < 4; ++ti) bp[ti] = *(const LAS bf16x8*)(lds + L_P + (64 * wr + 16 * ti + l15) * PHB + (32 * ks + 8 * q4) * 2);
#pragma unroll
                for (int ti = 0; ti < 4; ++ti) { a2[0][ti] = MFMA16(av0, bp[ti], a2[0][ti]); a2[1][ti] = MFMA16(av1, bp[ti], a2[1][ti]); }
            }
#pragma unroll
            for (int ti = 0; ti < 4; ++ti)
#pragma unroll
                for (int vi = 0; vi < 2; ++vi)
                    { uint2 w2; w2.x = pk2(a2[vi][ti][0], a2[vi][ti][1]); w2.y = pk2(a2[vi][ti][2], a2[vi][ti][3]); if (PM & 8) *(uint2*)(NI + (size_t)(row0 + 64 * wr + 16 * ti + l15) * 1024 + h * 256 + 128 * half + 32 * wc + 16 * vi + 4 * q4) = w2; else if (w2.x == 0x12345678u) NI[0] = (bf16)w2.y; }
        }
        if (PM & 16) {
            f32x4 a3[4][4];
#pragma unroll
            for (int ki = 0; ki < 4; ++ki)
#pragma unroll
                for (int vi = 0; vi < 4; ++vi) a3[ki][vi] = (f32x4){0.f, 0.f, 0.f, 0.f};
#pragma unroll
            for (int ks = 0; ks < 4; ++ks) {
                s16x4 ok[8], ov[8];
                const unsigned ka = ldsb + L_K + (32 * ks + 8 * q4 + (l15 >> 2)) * PT + (64 * wc + 4 * (lane & 3)) * 2;
                const unsigned va = ldsb + L_VH + (32 * ks + 8 * q4 + (l15 >> 2)) * PHB + (64 * wr + 4 * (lane & 3)) * 2;
                TR_4F(ok, ka, 2112); TR_4F(ov, va, 1088);
#pragma unroll
                for (int ki = 0; ki < 4; ++ki)
#pragma unroll
                    for (int vi = 0; vi < 4; ++vi) a3[ki][vi] = MFMA16(cat8(ok[2 * ki], ok[2 * ki + 1]), cat8(ov[2 * vi], ov[2 * vi + 1]), a3[ki][vi]);
            }
#pragma unroll
            for (int vi = 0; vi < 4; ++vi)
#pragma unroll
                for (int ki = 0; ki < 4; ++ki) {
                    uint2 w; w.x = pk2(a3[ki][vi][0], a3[ki][vi][1]); w.y = pk2(a3[ki][vi][2], a3[ki][vi][3]);
                    if (PM & 32) *(uint2*)(DCT + (size_t)(128 * half + 64 * wr + 16 * vi + l15) * 256 + 64 * wc + 16 * ki + 4 * q4) = w; else if (w.x == 0x12345678u) DCT[0] = (bf16)w.y;
                }
        }
    }
    lds_sync();
}

DI void mlstm_B(const Ctx& c, int l, unsigned char* lds_) {
    const bf16* __restrict__ DCT = wsb(c, WS_DCT); bf16* __restrict__ CTP = wsb(c, WS_CTP); const float* __restrict__ DEC = wsf(c, WS_DEC);
    LAS float* T = (LAS float*)lds_;
    for (int it = c.blk; it < 32 * 8; it += c.nblk) {
        const int bh = it >> 3, vb = it & 7, v = c.tid >> 4, k0 = (c.tid & 15) * 16;
        const size_t e = (size_t)(vb * 32 + v) * 256 + k0;
        float C[16];
#pragma unroll
        for (int i = 0; i < 16; ++i) C[i] = 0.f;
#pragma unroll 1
        for (int c4 = 0; c4 < 16; c4 += 4) {
        uint4 dd[4][2]; float dc[4];
#pragma unroll
        for (int j = 0; j < 4; ++j) { const size_t u = (size_t)bh * 16 + c4 + j; dd[j][0] = *(const uint4*)(DCT + u * UNIT_E + e); dd[j][1] = *(const uint4*)(DCT + u * UNIT_E + e + 8); dc[j] = DEC[u]; }
#pragma unroll
        for (int j = 0; j < 4; ++j) {
            const size_t u = (size_t)bh * 16 + c4 + j;
            { float lo[8], hi[8];
#pragma unroll
              for (int i = 0; i < 8; ++i) { lo[i] = C[i]; hi[i] = C[8 + i]; }
              *(uint4*)(CTP + u * UNIT_E + e) = pk8(lo); *(uint4*)(CTP + u * UNIT_E + e + 8) = pk8(hi); }
            const float dec = dc[j]; float d0[8], d1[8]; unpk8(dd[j][0], d0); unpk8(dd[j][1], d1);
#pragma unroll
            for (int i = 0; i < 8; ++i) { C[i] = dec * C[i] + d0[i]; C[8 + i] = dec * C[8 + i] + d1[i]; }
        }
        }
        lds_sync();
#pragma unroll
        for (int i = 0; i < 16; ++i) T[v * 257 + k0 + i] = C[i];
        lds_sync();
        float* oc = c.out + O_C_P + ((size_t)l * NBP * NH + bh) * UNIT_E + vb * 32;
        {
            const int k = c.tid >> 1, vh = (c.tid & 1) * 16;
#pragma unroll
            for (int q = 0; q < 4; ++q) *(float4*)(oc + (size_t)k * 256 + vh + 4 * q) = make_float4(T[(vh + 4 * q) * 257 + k], T[(vh + 4 * q + 1) * 257 + k], T[(vh + 4 * q + 2) * 257 + k], T[(vh + 4 * q + 3) * 257 + k]);
        }
    }
    const float* DN = wsf(c, WS_DN); float* NPv = wsf(c, WS_NP);
    for (int it = c.gtid; it < 32 * 256; it += c.gthreads) {
        const int bh = it >> 8, k = it & 255; float n = 0.f;
        for (int ch = 0; ch < 16; ++ch) { const size_t u = (size_t)bh * 16 + ch; NPv[u * 256 + k] = n; n = DEC[u] * n + DN[u * 256 + k]; }
        c.out[O_N_P + ((size_t)l * NBP * NH + bh) * DH + k] = n;
        if (k == 0) c.out[O_M_P + (size_t)l * NBP * NH + bh] = wsf(c, WS_MNEW)[(size_t)bh * 16 + 15];
    }
    lds_sync();
}

DI void mlstm_C_unit(const Ctx& c, unsigned char* lds_, int u, const float* gmh) {
    LAS unsigned char* lds = (LAS unsigned char*)lds_;
    LAS float* F = (LAS float*)(lds + L_F);
    const int b = u >> 6, h = (u >> 4) & 3, ch = u & 15, row0 = b * SEQ + ch * 128;
    const int tid = c.tid, lane = c.lane, wr = c.wave >> 2, wc = c.wave & 3, l15 = lane & 15, q4 = lane >> 4;
    const bf16* Qg = wsb(c, WS_Q) + (size_t)row0 * 1024 + h * 256; const bf16* CT = wsb(c, WS_CTP) + (size_t)u * UNIT_E;
    { uint4 tq[8], tk[8];
      tile_fetch<8>(tq, Qg, 1024, 5, tid); tile_fetch<8>(tk, CT, 256, 5, tid);
      tile_store<8>(lds, L_Q, PT, tq, 5, tid); tile_store<8>(lds, L_K, PT, tk, 5, tid); }
    if (tid < 256) F[F_NP + tid] = wsf(c, WS_NP)[(size_t)u * 256 + tid];
    gate_part1(wsf(c, WS_LI), wsf(c, WS_LF), b * SEQ, h, ch, F, lane, c.wave);
    lds_sync();
    const float mprev = gate_mprev(F, ch);
    uint4 cpre[8]; tile_fetch<8>(cpre, CT + 128 * 256, 256, 5, tid);
    {
        const int t = tid >> 2, kq = tid & 3; float s = 0.f;
#pragma unroll
        for (int j = 0; j < 8; ++j) {
            float x[8]; unpk8(lds_ld16(lds + L_Q + t * PT + (kq * 64 + j * 8) * 2), x);
#pragma unroll
            for (int i = 0; i < 8; ++i) s += x[i] * F[F_NP + kq * 64 + j * 8 + i];
        }
        s += __shfl_xor(s, 1); s += __shfl_xor(s, 2);
        if (kq == 0) F[F_QN + t] = s;
    }
    uint2 nip[2][2][4];
    { const bf16* NIp = wsb(c, WS_NI);
#pragma unroll
      for (int ti = 0; ti < 4; ++ti)
#pragma unroll
          for (int hf = 0; hf < 2; ++hf)
#pragma unroll
              for (int vi = 0; vi < 2; ++vi) nip[hf][vi][ti] = *(const uint2*)(NIp + (size_t)(row0 + 64 * wr + 16 * ti + l15) * 1024 + h * 256 + 128 * hf + 32 * wc + 16 * vi + 4 * q4); }
    f32x4 acc[2][2][4];
#pragma unroll
    for (int hf = 0; hf < 2; ++hf)
#pragma unroll
        for (int vi = 0; vi < 2; ++vi)
#pragma unroll
            for (int ti = 0; ti < 4; ++ti) acc[hf][vi][ti] = (f32x4){0.f, 0.f, 0.f, 0.f};
#pragma unroll
    for (int hf = 0; hf < 2; ++hf) {
        if (hf) { lds_sync(); tile_store<8>(lds, L_K, PT, cpre, 5, tid); lds_sync(); }
#pragma unroll 4
        for (int ks = 0; ks < 8; ++ks) {
            bf16x8 a[2], bq[4];
#pragma unroll
            for (int vi = 0; vi < 2; ++vi) a[vi] = *(const LAS bf16x8*)(lds + L_K + (32 * wc + 16 * vi + l15) * PT + (32 * ks + 8 * q4) * 2);
#pragma unroll
            for (int ti = 0; ti < 4; ++ti) bq[ti] = *(const LAS bf16x8*)(lds + L_Q + (64 * wr + 16 * ti + l15) * PT + (32 * ks + 8 * q4) * 2);
#pragma unroll
            for (int vi = 0; vi < 2; ++vi)
#pragma unroll
                for (int ti = 0; ti < 4; ++ti) acc[hf][vi][ti] = MFMA16(a[vi], bq[ti], acc[hf][vi][ti]);
        }
    }
    const float* NQI = wsf(c, WS_NQI);
#pragma unroll
    for (int ti = 0; ti < 4; ++ti) {
        const int t = 64 * wr + 16 * ti + l15; const size_t row = (size_t)(row0 + t);
        const float pmt = fmaxf(mprev, F[F_PM + t]), at = __expf(mprev - pmt);
        const float nq = NQI[row * 4 + h] + at * F[F_QN + t];
        const float inv = 1.f / fmaxf(fabsf(nq), __expf(-(F[F_BT + t] + pmt)));
        float ss = 0.f;
#pragma unroll
        for (int hf = 0; hf < 2; ++hf)
#pragma unroll
            for (int vi = 0; vi < 2; ++vi) {
                const uint2 nw = nip[hf][vi][ti]; const f32x4 ni = (f32x4){bflo(nw.x), bfhi(nw.x), bflo(nw.y), bfhi(nw.y)};
                const f32x4 hv = (ni + acc[hf][vi][ti] * at) * inv;
                acc[hf][vi][ti] = hv; ss += (hv[0] * hv[0] + hv[1] * hv[1]) + (hv[2] * hv[2] + hv[3] * hv[3]);
            }
        ss += __shfl_xor(ss, 16); ss += __shfl_xor(ss, 32);
        if (q4 == 0) F[F_SSP + t * 4 + wc] = ss;
    }
    lds_sync();
    const bf16* OS = wsb(c, WS_OS); bf16* HM = wsb(c, WS_HM);
#pragma unroll
    for (int ti = 0; ti < 4; ++ti) {
        const int t = 64 * wr + 16 * ti + l15; const size_t row = (size_t)(row0 + t);
        const float rs = rsqrtf(((F[F_SSP + t * 4 + 0] + F[F_SSP + t * 4 + 1]) + (F[F_SSP + t * 4 + 2] + F[F_SSP + t * 4 + 3])) * (1.f / DH) + EPS);
#pragma unroll
        for (int hf = 0; hf < 2; ++hf)
#pragma unroll
            for (int vi = 0; vi < 2; ++vi) {
                const int col = h * 256 + 128 * hf + 32 * wc + 16 * vi + 4 * q4;
                const float4 g = *(const float4*)(gmh + col); const uint2 ow = *(const uint2*)(OS + row * 1024 + col);
                const f32x4 hv = acc[hf][vi][ti];
                uint2 w; w.x = pk2(hv[0] * rs * g.x * bflo(ow.x), hv[1] * rs * g.y * bfhi(ow.x)); w.y = pk2(hv[2] * rs * g.z * bflo(ow.y), hv[3] * rs * g.w * bfhi(ow.y));
                *(uint2*)(HM + row * 1024 + col) = w;
            }
    }
    lds_sync();
}

template <bool first, bool has>
DI void mlstm_sample_item(const Ctx& c, unsigned char* lds_, int l, int it, float4 (&Cr)[32], int nxt) {
    LAS float* F = (LAS float*)lds_;
    LAS float* red = F;
    LAS float* qs = F + 2048;
    LAS float* ksm = F + 3072;
    LAS float* nqr = F + 4096;
    const int bs = it >> 2, h = it & 3, row0 = MP + bs * SS, tid = c.tid, kg = c.wave, v0 = c.lane * 4;
    const bf16* Q = wsb(c, WS_Q); const bf16* Kb = wsb(c, WS_K); const bf16* V = wsb(c, WS_V);
    const float* LI = wsf(c, WS_LI); const float* LF = wsf(c, WS_LF); float* Hh = wsf(c, WS_H);
    lds_sync();
    {
        static_assert(NTHR == 512, "two pieces per thread");
        const int i0 = tid, i1 = tid + NTHR;
        const bf16 q0 = Q[(size_t)(row0 + (i0 >> 8)) * 1024 + h * 256 + (i0 & 255)], k0 = Kb[(size_t)(row0 + (i0 >> 8)) * 1024 + h * 256 + (i0 & 255)];
        const bf16 q1 = Q[(size_t)(row0 + (i1 >> 8)) * 1024 + h * 256 + (i1 & 255)], k1 = Kb[(size_t)(row0 + (i1 >> 8)) * 1024 + h * 256 + (i1 & 255)];
        qs[i0] = bf2f(q0); ksm[i0] = bf2f(k0); qs[i1] = bf2f(q1); ksm[i1] = bf2f(k1);
    }
    const float* cn = inptr(I_MC) + ((size_t)l * NBS * NH + nxt) * UNIT_E;
    if (first) {
        const float* c0 = inptr(I_MC) + ((size_t)l * NBS * NH + it) * UNIT_E;
#pragma unroll
        for (int i = 0; i < 32; ++i) { const f32x4 t4 = __builtin_nontemporal_load((const f32x4*)(c0 + (size_t)(kg * 32 + i) * 256 + v0)); Cr[i] = make_float4(t4[0], t4[1], t4[2], t4[3]); }
    }
    float* oc = c.out + O_C_S + (((size_t)l * NBS + bs) * NH + h) * UNIT_E;
    float nval = 0.f; if (tid < 256) nval = inptr(I_MN)[(((size_t)l * NBS + bs) * NH + h) * DH + tid];
    float m = inptr(I_MM)[((size_t)l * NBS + bs) * NH + h];
    lds_sync();
#pragma unroll
    for (int t = 0; t < 4; ++t) {
        const size_t row = (size_t)(row0 + t);
        const float li = LI[row * 4 + h], lf = LF[row * 4 + h];
        const float mn = fmaxf(lf + m, li), fd = __expf(lf + m - mn), iw = __expf(li - mn); m = mn;
        const uint2 vw = *(const uint2*)(V + row * 1024 + h * 256 + v0);
        const float4 vv = make_float4(bflo(vw.x) * iw, bfhi(vw.x) * iw, bflo(vw.y) * iw, bfhi(vw.y) * iw);
        float4 part = make_float4(0.f, 0.f, 0.f, 0.f);
#pragma unroll
        for (int g = 0; g < 8; ++g) {
#pragma unroll
            for (int i = 4 * g; i < 4 * g + 4; ++i) {
                const float kk = ksm[t * 256 + kg * 32 + i], qq = qs[t * 256 + kg * 32 + i];
                Cr[i].x = fd * Cr[i].x + kk * vv.x; Cr[i].y = fd * Cr[i].y + kk * vv.y; Cr[i].z = fd * Cr[i].z + kk * vv.z; Cr[i].w = fd * Cr[i].w + kk * vv.w;
                part.x += qq * Cr[i].x; part.y += qq * Cr[i].y; part.z += qq * Cr[i].z; part.w += qq * Cr[i].w;
            }
            if (t == 3) {
#pragma unroll
                for (int i = 4 * g; i < 4 * g + 4; ++i) { const f32x4 t4 = {Cr[i].x, Cr[i].y, Cr[i].z, Cr[i].w}; __builtin_nontemporal_store(t4, (f32x4*)(oc + (size_t)(kg * 32 + i) * 256 + v0)); }
                asm volatile("" : "+v"(part.x), "+v"(part.y), "+v"(part.z), "+v"(part.w) :: "memory");
                if (has) {
#pragma unroll
                    for (int i = 4 * g; i < 4 * g + 4; ++i) { const f32x4 n4 = __builtin_nontemporal_load((const f32x4*)(cn + (size_t)(kg * 32 + i) * 256 + v0)); Cr[i] = make_float4(n4[0], n4[1], n4[2], n4[3]); }
                }
            }
        }
        lds_stf4(red + kg * 256 + v0, part);
        if (tid < 256) { nval = fd * nval + iw * ksm[t * 256 + tid]; const float pq = wave_sum(qs[t * 256 + tid] * nval); if (c.lane == 0) nqr[c.wave] = pq; }
        lds_sync();
        if (tid < 256) {
            float num = 0.f;
#pragma unroll
            for (int g8 = 0; g8 < 8; ++g8) num += red[g8 * 256 + tid];
            const float nq = (nqr[0] + nqr[1]) + (nqr[2] + nqr[3]);
            Hh[row * 1024 + h * 256 + tid] = num / fmaxf(fabsf(nq), __expf(-m));
        }
        lds_sync();
    }
    if (tid < 256) c.out[O_N_S + (((size_t)l * NBS + bs) * NH + h) * DH + tid] = nval;
    if (tid == 0) c.out[O_M_S + ((size_t)l * NBS + bs) * NH + h] = m;
}

DI void stage_mlstm_A(const Ctx& c, int l, unsigned char* lds) {
    for (int u = c.blk; u < NBP * NH * 16; u += c.nblk) mlstm_A_unit<63>(c, lds, u);
#ifdef PROBE_PARTS
    for (int u = c.blk; u < NBP * NH * 16; u += c.nblk) mlstm_A_unit<PROBE_PARTS>(c, lds, u);
#endif
    if (c.blk < NBS * NH) {
        float4 Cr[32];
        const int it1 = c.blk + c.nblk; const bool has1 = it1 < NBS * NH;
        if (has1) { mlstm_sample_item<true, true>(c, lds, l, c.blk, Cr, it1); mlstm_sample_item<false, false>(c, lds, l, it1, Cr, it1); }
        else mlstm_sample_item<true, false>(c, lds, l, c.blk, Cr, c.blk);
    }
    lds_sync();
}
DI void stage_mlstm_C(const Ctx& c, int l, unsigned char* lds) {
    const float* gmh = inptr(I_GMH) + (size_t)l * MW;
    for (int u = c.blk; u < NBP * NH * 16; u += c.nblk) mlstm_C_unit(c, lds, u, gmh);
}
struct DiagOrder {
    int G, c;
    DI bool next(int i, pg8::Unit& u) const { const int L = i * G + c; if (L >= 128) return false; u.pm = L; u.pn = L >> 2; return true; }
    DI void a_ready(const pg8::Unit&) const {}
    DI void done(const pg8::Unit&) const {}
};
struct EEs5 {
    static constexpr int ID = 9; static constexpr bool NEEDS_RS = false; static constexpr bool PAIRED = false;
    float* ES;
    typedef PF0 PF; DI PF load(int, int) const { return PF0{}; }
    DI const float* ssq_src() const { return nullptr; } DI float pre(int) const { return 0.f; }
    DI float operator()(int row, int col, const float (&a)[8], const float (&)[8], float, const PF&) const {
        const int cl = col & 255;
        if (cl < 128) { float* p = ES + (size_t)row * 128 + cl; *(float4*)p = make_float4(a[0], a[1], a[2], a[3]); *(float4*)(p + 4) = make_float4(a[4], a[5], a[6], a[7]); }
        return 0.f;
    }
};
struct EYs5 {
    static constexpr int ID = 10; static constexpr bool NEEDS_RS = false; static constexpr bool PAIRED = false;
    bf16* YS5;
    typedef PF0 PF; DI PF load(int, int) const { return PF0{}; }
    DI const float* ssq_src() const { return nullptr; } DI float pre(int) const { return 0.f; }
    DI float operator()(int row, int col, const float (&a)[8], const float (&)[8], float, const PF&) const {
        const int cl = col & 255, t = cl >> 4, hh0 = cl & 15, g = row >> 10, b = (row >> 7) & 7, ch = row & 127;
        float o[8];
#pragma unroll
        for (int i = 0; i < 8; ++i) o[i] = gelu_tanh(a[i]);
        *(uint4*)(YS5 + (size_t)(b * SEQ + ch * 16 + t) * 512 + g * 16 + hh0) = pk8(o);
        return 0.f;
    }
};
template <class F>
DI void gemm_diag(const Ctx& c, unsigned char* lds, const bf16* A, int lda, const bf16* Bt, int ldb, int K, const F& f) {
    pg8::Gemm g{A, Bt, 32768, 8192, K, lda, ldb};
    DiagOrder S{c.nblk, c.blk};
    EpiA<F> E{f, nullptr};
    pg8::gemm_phase<EpiA<F>, DiagOrder, true, true>((PG8_LAS unsigned char*)lds, g, S, E, c.tid);
}

DI void s5_build_item(const Ctx& c, unsigned char* lds_, int item) {
    LAS float* PWr = (LAS float*)lds_;
    LAS float* PWi = PWr + 17 * 64;
    LAS float* BBr = PWi + 17 * 64;
    LAS float* BBi = BBr + 1024;
    LAS float* CCr = BBi + 1024;
    LAS float* CCi = CCr + 1024;
    LAS float* KT = CCi + 1024;
    const int half = item & 1, l = item >> 6, g = (item >> 1) & 31, tid = c.tid;
    __syncthreads();
    if (tid < 64) {
        const int n = tid;
        const float lre = inptr(I_LRE)[((size_t)l * NG + g) * NST + n], lim = inptr(I_LIM)[((size_t)l * NG + g) * NST + n];
        const float dt = expf(inptr(I_LDT)[l * NG + g]);
        for (int tau = 0; tau <= 16; ++tau) { const float mag = expf((float)tau * lre * dt), th = (float)tau * (lim * dt); PWr[tau * 64 + n] = mag * cosf(th); PWi[tau * 64 + n] = mag * sinf(th); }
        const float mag = expf(lre * dt), ar = mag * cosf(lim * dt), ai = mag * sinf(lim * dt);
        const float den = lre * lre + lim * lim, pr = ar - 1.f;
        const float wre = (pr * lre + ai * lim) / den, wim = (ai * lre - pr * lim) / den;
        const float* bre = inptr(I_BRE) + (((size_t)l * NG + g) * NST + n) * 16; const float* bim = inptr(I_BIM) + (((size_t)l * NG + g) * NST + n) * 16;
        for (int j = 0; j < 16; ++j) { const float r = bre[j], i = bim[j]; BBr[n * 16 + j] = wre * r - wim * i; BBi[n * 16 + j] = wre * i + wim * r; }
    }
    for (int idx = tid; idx < 1024; idx += NTHR) { CCr[idx] = inptr(I_CRE)[((size_t)l * NG + g) * 1024 + idx]; CCi[idx] = inptr(I_CIM)[((size_t)l * NG + g) * 1024 + idx]; }
    __syncthreads();
    if (half == 0) for (int idx = tid; idx < 4096; idx += NTHR) {
        const int tau = idx >> 8, hh = (idx >> 4) & 15, j = idx & 15; float s = 0.f;
        for (int n = 0; n < 64; ++n) {
            const float cr = CCr[hh * 64 + n], ci = CCi[hh * 64 + n], pr = PWr[tau * 64 + n], pi = PWi[tau * 64 + n];
            const float xr = cr * pr - ci * pi, xi = cr * pi + ci * pr;
            s += xr * BBr[n * 16 + j] - xi * BBi[n * 16 + j];
        }
        KT[idx] = s;
    }
    __syncthreads();
    bf16* Km = wsb(c, WS_S5K) + ((size_t)l * 8192 + (size_t)g * 256) * 384;
    bf16* Em = wsb(c, WS_S5E) + ((size_t)l * 8192 + (size_t)g * 256) * 256;
    const float* dsk = inptr(I_S5D) + (size_t)l * S5W + g * 16;
    for (int idx = tid + (half ? 256 * 32 : 0); idx < (half ? 256 * 48 : 256 * 32); idx += NTHR) {
        const int r = idx & 255, chn = idx >> 8, t = r >> 4, hh = r & 15, kk0 = chn * 8; float v[8];
        if (kk0 < 256) {
            const int s = kk0 >> 4, j0 = kk0 & 15;
#pragma unroll
            for (int i = 0; i < 8; ++i) { float x = 0.f; if (s <= t) { x = KT[((t - s) * 16 + hh) * 16 + j0 + i]; if (s == t && j0 + i == hh) x += dsk[hh]; } v[i] = x; }
        } else {
            const int n0 = (kk0 - 256) & 63; const bool im = (kk0 - 256) >= 64;
#pragma unroll
            for (int i = 0; i < 8; ++i) { const int n = n0 + i; const float cr = CCr[hh * 64 + n], ci = CCi[hh * 64 + n], pr = PWr[(t + 1) * 64 + n], pi = PWi[(t + 1) * 64 + n]; v[i] = im ? -(cr * pi + ci * pr) : (cr * pr - ci * pi); }
        }
        *(uint4*)(Km + (size_t)r * 384 + kk0) = pk8(v);
    }
    if (half == 1) for (int idx = tid; idx < 256 * 32; idx += NTHR) {
        const int r = idx >> 5, chn = idx & 31, kk0 = chn * 8, s = kk0 >> 4, j0 = kk0 & 15; float v[8];
#pragma unroll
        for (int i = 0; i < 8; ++i) {
            float x = 0.f;
            if (r < 128) { const int n = r & 63; const float pr = PWr[(15 - s) * 64 + n], pi = PWi[(15 - s) * 64 + n], br = BBr[n * 16 + j0 + i], bi = BBi[n * 16 + j0 + i]; x = (r < 64) ? (pr * br - pi * bi) : (pr * bi + pi * br); }
            v[i] = x;
        }
        *(uint4*)(Em + (size_t)r * 256 + kk0) = pk8(v);
    }
}
DI void stage_s5_build(const Ctx& c, unsigned char* lds) { for (int it = c.blk; it < NL * NG * 2; it += c.nblk) s5_build_item(c, lds, it); __syncthreads(); }

DI void stage_s5_carry(const Ctx& c, int l, unsigned char* lds_) {
    const float* __restrict__ ES = wsf(c, WS_ES); bf16* __restrict__ UP = wsb(c, WS_UP);
    LAS float* segr = (LAS float*)lds_; LAS float* segi = segr + 512;
    for (int it = c.blk; it < NBP * NG; it += c.nblk) {
        const int b = it >> 5, g = it & 31, n = c.lane, w = c.wave;
        const float lre = inptr(I_LRE)[((size_t)l * NG + g) * NST + n], lim = inptr(I_LIM)[((size_t)l * NG + g) * NST + n];
        const float dt = expf(inptr(I_LDT)[l * NG + g]);
        const float m16 = expf(16.f * lre * dt), t16 = 16.f * (lim * dt), ar = m16 * cosf(t16), ai = m16 * sinf(t16);
        const float m256 = expf(256.f * lre * dt), t256 = 256.f * (lim * dt), Ar = m256 * cosf(t256), Ai = m256 * sinf(t256);
        const size_t rbase = (size_t)g * 1024 + (size_t)b * 128 + (size_t)w * 16;
        float er[16], ei[16];
#pragma unroll
        for (int j = 0; j < 16; ++j) { er[j] = ES[(rbase + j) * 128 + n]; ei[j] = ES[(rbase + j) * 128 + 64 + n]; }
        float pr[16], pi[16]; float hr = 0.f, hi = 0.f;
#pragma unroll
        for (int j = 0; j < 16; ++j) { pr[j] = hr; pi[j] = hi; const float nr = ar * hr - ai * hi + er[j], ni = ar * hi + ai * hr + ei[j]; hr = nr; hi = ni; }
        lds_sync();
        segr[w * 64 + n] = hr; segi[w * 64 + n] = hi;
        lds_sync();
        float sr = 0.f, si = 0.f;
        for (int ww = 0; ww < w; ++ww) { const float nr = Ar * sr - Ai * si + segr[ww * 64 + n], ni = Ar * si + Ai * sr + segi[ww * 64 + n]; sr = nr; si = ni; }
        float qr = 1.f, qi = 0.f;
#pragma unroll
        for (int j = 0; j < 16; ++j) {
            const float xr = pr[j] + (qr * sr - qi * si), xi = pi[j] + (qr * si + qi * sr);
            UP[(rbase + j) * 384 + 256 + n] = (bf16)f2bf(xr); UP[(rbase + j) * 384 + 320 + n] = (bf16)f2bf(xi);
            const float tr = qr * ar - qi * ai, ti = qr * ai + qi * ar; qr = tr; qi = ti;
        }
        if (w == 7) {
            c.out[O_S5RE_P + (((size_t)l * NBP + b) * NG + g) * NST + n] = hr + (qr * sr - qi * si);
            c.out[O_S5IM_P + (((size_t)l * NBP + b) * NG + g) * NST + n] = hi + (qr * si + qi * sr);
        }
    }
    lds_sync();
}
#ifndef MULTI_LAUNCH
#define MULTI_LAUNCH 0
#endif
#if FAST_GEMM
#ifndef ONLY_EPI
#define ONLY_EPI 0
#endif
#ifndef THIN_SAMPLE
#define THIN_SAMPLE 1
#endif
#define RUN_GEMM(A_, lda_, Bt_, ldb_, M_, Nc_, K_, e_, ssq_) do { if constexpr (ONLY_EPI == 0 || decltype(e_)::ID == ONLY_EPI) { \
    if (!(((PROBE_MASK >> 27) & 1) && rep_ == 1)) gemm_fast(c, lds, A_, lda_, Bt_, (ldb_) + PADK, ((THIN_SAMPLE && (Nc_) != INN && (Nc_) != 512) ? MP : (M_)), (e_.PAIRED ? 2 * (Nc_) : (Nc_)), K_, e_, ssq_); \
    if (THIN_SAMPLE && (Nc_) != INN && (Nc_) != 512 && !(((PROBE_MASK >> 26) & 1) && rep_ == 1)) for (int r_ = 0; r_ < ((((PROBE_MASK >> 20) & 1) && (decltype(e_)::ID == 1 || decltype(e_)::ID == 3 || decltype(e_)::ID == 4)) ? 3 : 1); ++r_) { \
        if (e_.PAIRED) gemm_thin<decltype(e_), 4, 1, 2, 1>(c, lds, (A_) + (size_t)MP * (lda_), lda_, Bt_, (ldb_) + PADK, Nc_, K_, e_, ssq_); \
        else if ((Nc_) == INN) gemm_thin<decltype(e_), 4, 2, 2, 1>(c, lds, (A_) + (size_t)MP * (lda_), lda_, Bt_, (ldb_) + PADK, Nc_, K_, e_, ssq_); \
        else gemm_thin<decltype(e_), 2, 1, 2, 2>(c, lds, (A_) + (size_t)MP * (lda_), lda_, Bt_, (ldb_) + PADK, Nc_, K_, e_, ssq_); } } } while (0)
#define SSQ_PHASE(p_)
constexpr int PH_PER_LAYER = 11 + (FAST_MLSTM ? 1 : 0);
#else
#define RUN_GEMM(A_, lda_, Bt_, ldb_, M_, Nc_, K_, e_, ssq_) gemm_ref(c, A_, lda_, Bt_, (ldb_) + PADK, M_, Nc_, K_, e_, ssq_)
#define SSQ_PHASE(p_) PH_BEGIN(0) stage_ssq(c, p_, XB); PH_END
constexpr int PH_PER_LAYER = 15 + (FAST_MLSTM ? 1 : 0);
#endif
constexpr int PH_TOTAL = 1 + NL * PH_PER_LAYER + 1;

__global__ void __launch_bounds__(NTHR, 2) fwd(Args args) {
    extern __shared__ __attribute__((aligned(16))) unsigned char lds[];
#define MKCTX Ctx c; { int ln_; asm volatile("v_mbcnt_lo_u32_b32 %0, -1, 0\n\tv_mbcnt_hi_u32_b32 %0, -1, %0" : "=v"(ln_)); int ws_ = wave_s; asm volatile("" : "+s"(ws_)); \
    { int z_ = 0; asm volatile("" : "+s"(z_)); c.out = args.out + z_; c.ws = args.ws + z_; }     \
    c.tid = ws_ * 64 + ln_; c.lane = ln_; c.wave = ws_; \
    { int b_ = blockIdx.x; asm volatile("" : "+s"(b_)); c.blk = b_; } c.nblk = gridDim.x; c.gtid = c.blk * NTHR + c.tid; c.gthreads = c.nblk * NTHR; c.gwave = c.blk + c.nblk * c.wave; c.gwaves = c.nblk * NWV; }
    volatile LAS unsigned* MISC = (volatile LAS unsigned*)((LAS unsigned char*)lds + MISC_OFF);
    const int wave_s = __builtin_amdgcn_readfirstlane(threadIdx.x >> 6);
    if (threadIdx.x < 32) MISC[threadIdx.x] = 0u;
    __syncthreads();
    if (!MULTI_LAUNCH) (void)xcd_barrier_post((unsigned*)(args.ws + WS_BAR), MISC + 8, threadIdx.x == 0);
    const int lo = args.lo, hi = args.hi;
    int gp = 0;
#ifndef PROBE_MASK
#define PROBE_MASK 0
#endif
#define PH_BEGIN(id_) if (lo <= gp && gp < hi) { for (int rep_ = 0; rep_ < (((PROBE_MASK >> (id_)) & 1) ? 2 : 1); ++rep_) { { MKCTX LAYER_PTRS
#define PH_FRESH } { MKCTX LAYER_PTRS
#define PH_END   } if (gp + 1 < hi) { MKCTX XcdBarrier b_; b_.bar = (unsigned*)(c.ws + WS_BAR); b_.x = xb_xcc_id(); b_.st = (volatile LAS unsigned*)((LAS unsigned char*)lds + MISC_OFF) + 8; xcd_barrier(b_, c.tid == 0); } } } ++gp;

#define LAYER_PTRS
    PH_BEGIN(1) stage_prologue(args, c, lds);
#if FAST_S5
    PH_FRESH stage_s5_build(c, lds);
#endif
    PH_END
#undef LAYER_PTRS
#define LAYER_PTRS unsigned char* lw = c.ws + WS_W + (size_t)l * LW_STRIDE; bf16* XB = (bf16*)(c.ws + ((l & 1) ? WS_XB2 : WS_XB)); bf16* XBn = (bf16*)(c.ws + ((l & 1) ? WS_XB : WS_XB2)); float* X = (float*)(c.ws + WS_X); (void)lw; (void)XB; (void)XBn; (void)X;

    for (int l = 0; l < NL; ++l) {
        PH_BEGIN(2) { ESwiGLU e{ssq_ptr(c, 4 * l + 0), wsb(c, WS_ACT)}; RUN_GEMM(XB, D, (const bf16*)(lw + LW_W1GU), D, M, FF, D, e, nullptr); } PH_END
        PH_BEGIN(3) { EResid e{XB, XB, rep_ ? 0.f : 0.5f}; RUN_GEMM(wsb(c, WS_ACT), FF, (const bf16*)(lw + LW_W1D), FF, M, D, FF, e, ssq_ptr(c, 4 * l + 1)); } PH_END
        SSQ_PHASE(ssq_ptr(c, 4 * l + 1))
        PH_BEGIN(4) { EWin e{ssq_ptr(c, 4 * l + 1), wsb(c, WS_UP), wsb(c, WS_US), wsb(c, WS_QKR), wsb(c, WS_V), wsb(c, WS_OS)};
                   RUN_GEMM(XB, D, (const bf16*)(lw + LW_WIN), D, M, INN, D, e, nullptr); } PH_END
        PH_BEGIN(5)
#if FAST_S5
                 { EEs5 e{wsf(c, WS_ES)}; gemm_diag(c, lds, wsb(c, WS_UP), 384, wsb(c, WS_S5E) + (size_t)l * 8192 * 256, 256, 256, e); }
        PH_FRESH
#endif
                 stage_conv(args, c, l); stage_gates(args, c, l, ssq_ptr(c, 4 * l + 1), XB); PH_END
#if FAST_MLSTM
        PH_BEGIN(6) stage_mlstm_A(c, l, lds);
#if FAST_S5
        PH_FRESH for (int r_ = 0; r_ < (((PROBE_MASK >> 23) & 1) ? 2 : 1); ++r_) stage_s5_carry(c, l, lds);
#endif
        PH_FRESH stage_s5_sample(args, c, l, lds); PH_END
        PH_BEGIN(7)
#if FAST_S5
                 { EYs5 e{wsb(c, WS_YS5)}; gemm_diag(c, lds, wsb(c, WS_UP), 384, wsb(c, WS_S5K) + (size_t)l * 8192 * 384, 384, 384, e); }
        PH_FRESH
#endif
                 mlstm_B(c, l, lds); PH_END
        PH_BEGIN(8) stage_mlstm_C(c, l, lds); stage_headnorm(args, c, l, MP);
#else
        PH_BEGIN(9) stage_mlstm_ref(args, c, l, lds); stage_s5_ref(args, c, l, lds); PH_END
        PH_BEGIN(10) stage_headnorm(args, c, l, 0);
#endif
                 { EGlu e{wsb(c, WS_YS5), wsb(c, WS_YG)}; RUN_GEMM(wsb(c, WS_YS5), 512, (const bf16*)(lw + LW_WGLU), 512, M, 512, 512, e, nullptr); } PH_END
        PH_BEGIN(11) { ET5 e{wsb(c, WS_GS5), wsb(c, WS_T5)}; RUN_GEMM(wsb(c, WS_YG), 512, (const bf16*)(lw + LW_WS5UP), 512, M, D, 512, e, nullptr); }
                 { EMerged e{wsb(c, WS_T5), wsb(c, WS_GM), wsb(c, WS_MRG)}; RUN_GEMM(wsb(c, WS_HM), 1024, (const bf16*)(lw + LW_WMUP), 1024, M, D, 1024, e, nullptr); } PH_END
        PH_BEGIN(12) { EResid e{XB, XB, rep_ ? 0.f : 1.0f}; RUN_GEMM(wsb(c, WS_MRG), 1024, (const bf16*)(lw + LW_WOUT), 1024, M, D, 1024, e, ssq_ptr(c, 4 * l + 2)); } PH_END
        SSQ_PHASE(ssq_ptr(c, 4 * l + 2))
        PH_BEGIN(13) { ESwiGLU e{ssq_ptr(c, 4 * l + 2), wsb(c, WS_ACT)}; RUN_GEMM(XB, D, (const bf16*)(lw + LW_W2GU), D, M, FF, D, e, nullptr); } PH_END
        PH_BEGIN(14) { EResid e{XB, XB, rep_ ? 0.f : 0.5f}; RUN_GEMM(wsb(c, WS_ACT), FF, (const bf16*)(lw + LW_W2D), FF, M, D, FF, e, ssq_ptr(c, 4 * l + 3)); } PH_END
        SSQ_PHASE(ssq_ptr(c, 4 * l + 3))
        PH_BEGIN(15) { EGate e{ssq_ptr(c, 4 * l + 3), wsb(c, WS_GT)}; RUN_GEMM(XB, D, (const bf16*)(lw + LW_WPG), D, M, D, D, e, nullptr); }
                 { EPle e{XB, XBn, wsb(c, WS_GT), rep_ ? 0.f : 1.f}; RUN_GEMM(wsb(c, WS_PB) + (size_t)l * M * DPLE, DPLE, (const bf16*)(lw + LW_WPLE), DPLE, M, D, DPLE, e, ssq_ptr(c, 4 * l + 4)); } PH_END
        SSQ_PHASE(ssq_ptr(c, 4 * l + 4))
    }
#undef LAYER_PTRS
#define LAYER_PTRS
    PH_BEGIN(16) stage_final(args, c, wsb(c, (NL & 1) ? WS_XB2 : WS_XB)); PH_END
#undef LAYER_PTRS
#undef PH_BEGIN
#undef PH_END
}

extern "C" void kernel_launch(void* const* d_in, const int* in_sizes, int n_in, void* d_out, int out_size, void* d_ws, size_t ws_size, hipStream_t stream) {
    static int grid = 0;
    if (grid == 0) {
        if (n_in != N_IN || (size_t)out_size != O_END || ws_size < WS_END) { fprintf(stderr, "kernel_launch: unexpected shapes (n_in %d, out %d, ws %zu)\n", n_in, out_size, ws_size); grid = -1; return; }
        int dev = 0, cus = 0, per_cu = 0;
        if (hipGetDevice(&dev) != hipSuccess || hipDeviceGetAttribute(&cus, hipDeviceAttributeMultiprocessorCount, dev) != hipSuccess) { grid = -1; return; }
        if (hipFuncSetAttribute((const void*)fwd, hipFuncAttributeMaxDynamicSharedMemorySize, LDS_BYTES) != hipSuccess) { fprintf(stderr, "kernel_launch: hipFuncSetAttribute failed\n"); grid = -1; return; }
        if (hipOccupancyMaxActiveBlocksPerMultiprocessor(&per_cu, (const void*)fwd, NTHR, LDS_BYTES) != hipSuccess || per_cu < 1) { fprintf(stderr, "kernel_launch: occupancy query says %d\n", per_cu); per_cu = 1; }
        (void)hipGetLastError();
        if (2 * cus < NBS * NH) { fprintf(stderr, "kernel_launch: %d CUs, the sample-state stream is written for >= %d workgroups\n", cus, NBS * NH / 2); grid = -1; return; }
        grid = cus;
    }
    if (grid < 0) return;
    (void)hipMemsetAsync((char*)d_ws + WS_ZERO, 0, ZERO_BYTES, stream);
    Args a{};
    for (int i = 0; i < N_IN; ++i) a.in[i] = (const float*)d_in[i];
    a.out = (float*)d_out; a.ws = (unsigned char*)d_ws;
#if MULTI_LAUNCH
    for (int p = 0; p < PH_TOTAL; ++p) { a.lo = p; a.hi = p + 1; hipLaunchKernelGGL(fwd, dim3(grid), dim3(NTHR), LDS_BYTES, stream, a); }
#else
    a.lo = 0; a.hi = PH_TOTAL;
    hipLaunchKernelGGL(fwd, dim3(grid), dim3(NTHR), LDS_BYTES, stream, a);
#endif
    const hipError_t le = hipPeekAtLastError();
    if (le != hipSuccess) fprintf(stderr, "kernel_launch: launch failed: %s\n", hipGetErrorName(le));
}
```

```cpp
#include <hip/hip_runtime.h>
#include <cstdio>
#include <cstdint>

#define DI __device__ __forceinline__
#ifndef PROBE_MASK
#define PROBE_MASK 0
#endif
#ifndef FAST_GEMM
#define FAST_GEMM 1
#endif
#ifndef GEMM_ALIGN
#define GEMM_ALIGN true
#endif
#ifndef FAST_MLSTM
#define FAST_MLSTM 1
#endif
#ifndef FAST_S5
#define FAST_S5 1
#endif
typedef unsigned short bf16;
typedef unsigned int u32;
typedef __bf16 bf2_t __attribute__((ext_vector_type(2)));
typedef unsigned u32x4t __attribute__((ext_vector_type(4)));
#define LAS __attribute__((address_space(3)))

constexpr int D = 1024, FF = 2048, NL = 4;
constexpr int NBP = 8, SEQ = 2048, NBS = 128, SS = 4;
constexpr int MP = NBP * SEQ, MS = NBS * SS, M = MP + MS;
constexpr int NG = 32, NST = 64, S5W = 512;
constexpr int NH = 4, DH = 256, MW = 1024;
constexpr int INC = 6664, INN = 6656;
constexpr int DPLE = 256;
constexpr float EPS = 1e-6f;
constexpr int NTHR = 512, NWV = 8;
constexpr int PADK = 0;
constexpr int LDS_BYTES = 147456;
constexpr int MISC_OFF = LDS_BYTES - 256;

enum { I_XP = 0, I_XS, I_S5RE, I_S5IM, I_MC, I_MN, I_MM, I_CONV, I_PP, I_PS, I_GFFN1, I_W1G, I_W1U, I_W1D, I_GMIX, I_WIN, I_LRE, I_LIM, I_LDT,
       I_BRE, I_BIM, I_CRE, I_CIM, I_S5D, I_WGLU, I_WS5UP, I_CONVW, I_CONVB, I_BIG, I_BFG, I_GMH, I_WMUP, I_WOUT, I_GFFN2, I_W2G, I_W2U, I_W2D,
       I_GPLE, I_WPLE, I_WPG, I_GFIN, N_IN };

constexpr size_t O_Y = 0;
constexpr size_t O_S5RE_P = O_Y + (size_t)M * D;
constexpr size_t O_S5IM_P = O_S5RE_P + (size_t)NL * NBP * NG * NST;
constexpr size_t O_C_P = O_S5IM_P + (size_t)NL * NBP * NG * NST;
constexpr size_t O_N_P = O_C_P + (size_t)NL * NBP * NH * DH * DH;
constexpr size_t O_M_P = O_N_P + (size_t)NL * NBP * NH * DH;
constexpr size_t O_CONV_P = O_M_P + (size_t)NL * NBP * NH;
constexpr size_t O_S5RE_S = O_CONV_P + (size_t)NL * NBP * 3 * 2048;
constexpr size_t O_S5IM_S = O_S5RE_S + (size_t)NL * NBS * NG * NST;
constexpr size_t O_C_S = O_S5IM_S + (size_t)NL * NBS * NG * NST;
constexpr size_t O_N_S = O_C_S + (size_t)NL * NBS * NH * DH * DH;
constexpr size_t O_M_S = O_N_S + (size_t)NL * NBS * NH * DH;
constexpr size_t O_CONV_S = O_M_S + (size_t)NL * NBS * NH;
constexpr size_t O_END = O_CONV_S + (size_t)NL * NBS * 3 * 2048;
static_assert(O_END == 166037632ull, "output map");

constexpr size_t al256(size_t x) { return (x + 255) & ~(size_t)255; }
constexpr size_t WS_ZERO = 0, ZERO_BYTES = 32768;
constexpr size_t WS_BAR = 16384;
constexpr size_t LW_W1GU = 0;
constexpr size_t LW_W1D = LW_W1GU + (size_t)4096 * (1024 + PADK) * 2;
constexpr size_t LW_WIN = LW_W1D + (size_t)1024 * (2048 + PADK) * 2;
constexpr size_t LW_WG = LW_WIN + (size_t)INN * (1024 + PADK) * 2;
constexpr size_t LW_WGLU = LW_WG + (size_t)8 * 1024 * 4;
constexpr size_t LW_WS5UP = LW_WGLU + (size_t)512 * (512 + PADK) * 2;
constexpr size_t LW_WMUP = LW_WS5UP + (size_t)1024 * (512 + PADK) * 2;
constexpr size_t LW_WOUT = LW_WMUP + (size_t)1024 * (1024 + PADK) * 2;
constexpr size_t LW_W2GU = LW_WOUT + (size_t)1024 * (1024 + PADK) * 2;
constexpr size_t LW_W2D = LW_W2GU + (size_t)4096 * (1024 + PADK) * 2;
constexpr size_t LW_WPG = LW_W2D + (size_t)1024 * (2048 + PADK) * 2;
constexpr size_t LW_WPLE = LW_WPG + (size_t)1024 * (1024 + PADK) * 2;
constexpr size_t LW_END = LW_WPLE + (size_t)1024 * (256 + PADK) * 2;
constexpr size_t LW_STRIDE = al256(LW_END);
constexpr size_t WS_W = 1u << 20;
constexpr size_t WS_PB = al256(WS_W + NL * LW_STRIDE);
constexpr size_t WS_X = al256(WS_PB + (size_t)NL * M * DPLE * 2);
constexpr size_t WS_XB = al256(WS_X + (size_t)M * D * 4);
constexpr size_t WS_ACT = al256(WS_XB + (size_t)M * D * 2);
constexpr size_t WS_UP = al256(WS_ACT + (size_t)M * FF * 2);
constexpr size_t WS_US = al256(WS_UP + (size_t)NG * 1024 * 384 * 2);
constexpr size_t WS_QKR = al256(WS_US + (size_t)MS * 512 * 2);
constexpr size_t WS_V = al256(WS_QKR + (size_t)M * 2048 * 2);
constexpr size_t WS_OS = al256(WS_V + (size_t)M * 1024 * 2);
constexpr size_t WS_GS5 = al256(WS_OS + (size_t)M * 1024 * 2);
constexpr size_t WS_GM = al256(WS_GS5 + (size_t)M * 1024 * 2);
constexpr size_t WS_LI = al256(WS_GM + (size_t)M * 1024 * 2);
constexpr size_t WS_LF = al256(WS_LI + (size_t)M * 4 * 4);
constexpr size_t WS_Q = al256(WS_LF + (size_t)M * 4 * 4);
constexpr size_t WS_K = al256(WS_Q + (size_t)M * 1024 * 2);
constexpr size_t WS_H = al256(WS_K + (size_t)M * 1024 * 2);
constexpr size_t WS_YS5 = al256(WS_H + (size_t)M * 1024 * 4);
constexpr size_t WS_YG = al256(WS_YS5 + (size_t)M * 512 * 2);
constexpr size_t WS_HM = al256(WS_YG + (size_t)M * 512 * 2);
constexpr size_t WS_T5 = al256(WS_HM + (size_t)M * 1024 * 2);
constexpr size_t WS_MRG = al256(WS_T5 + (size_t)M * 1024 * 4);
constexpr size_t WS_GT = al256(WS_MRG + (size_t)M * 1024 * 2);
constexpr size_t WS_XB2 = al256(WS_GT + (size_t)M * 1024 * 2);
constexpr size_t WS_SSQ = al256(WS_XB2 + (size_t)M * D * 2);
constexpr size_t WS_NQI = al256(WS_SSQ + (size_t)17 * M * 16 * 4);
constexpr size_t WS_DCT = al256(WS_NQI + (size_t)MP * 4 * 4);
constexpr size_t WS_CTP = al256(WS_DCT + (size_t)512 * 65536 * 2);
constexpr size_t WS_DN = al256(WS_CTP + (size_t)512 * 65536 * 2);
constexpr size_t WS_NP = al256(WS_DN + (size_t)512 * 256 * 4);
constexpr size_t WS_DEC = al256(WS_NP + (size_t)512 * 256 * 4);
constexpr size_t WS_MNEW = al256(WS_DEC + 512 * 4);
constexpr size_t WS_NI = al256(WS_MNEW + 512 * 4);
constexpr size_t WS_S5K = al256(WS_NI + (size_t)MP * 1024 * 2);
constexpr size_t WS_S5E = al256(WS_S5K + (size_t)NL * 8192 * 384 * 2);
constexpr size_t WS_ES = al256(WS_S5E + (size_t)NL * 8192 * 256 * 2);
constexpr size_t WS_END = al256(WS_ES + (size_t)32768 * 128 * 4);
static_assert(WS_END < (size_t)2000 * 1024 * 1024, "d_ws map must fit 4 x the largest tensor");
static_assert(WS_GS5 == WS_OS + (size_t)M * 1024 * 2 && WS_GM == WS_GS5 + (size_t)M * 1024 * 2, "OS, GS5, GM consecutive");

DI float bf2f(bf16 b) { return __uint_as_float((u32)b << 16); }
DI float bflo(u32 w) { return __uint_as_float(w << 16); }
DI float bfhi(u32 w) { return __uint_as_float(w & 0xffff0000u); }
DI u32 f2bf(float f) { u32 u = __float_as_uint(f); return (u + 0x7fffu + ((u >> 16) & 1u)) >> 16; }
DI u32 pk2(float lo, float hi) { bf2_t v = {(__bf16)lo, (__bf16)hi}; return __builtin_bit_cast(u32, v); }
DI uint4 pk8(const float (&v)[8]) { uint4 o; o.x = pk2(v[0], v[1]); o.y = pk2(v[2], v[3]); o.z = pk2(v[4], v[5]); o.w = pk2(v[6], v[7]); return o; }
DI void unpk8(uint4 w, float (&v)[8]) { v[0] = bflo(w.x); v[1] = bfhi(w.x); v[2] = bflo(w.y); v[3] = bfhi(w.y); v[4] = bflo(w.z); v[5] = bfhi(w.z); v[6] = bflo(w.w); v[7] = bfhi(w.w); }
DI float sigm(float x) { return __builtin_amdgcn_rcpf(1.f + __expf(-x)); }
DI float wave_sum(float v) {
#pragma unroll
    for (int o = 1; o < 64; o <<= 1) v += __shfl_xor(v, o);
    return v;
}
DI float fdot2(u32 a, u32 b, float c) { return __builtin_amdgcn_fdot2_f32_bf16(__builtin_bit_cast(bf2_t, a), __builtin_bit_cast(bf2_t, b), c, false); }
DI float dot8(uint4 a, uint4 b, float c) { c = fdot2(a.x, b.x, c); c = fdot2(a.y, b.y, c); c = fdot2(a.z, b.z, c); c = fdot2(a.w, b.w, c); return c; }
DI float gelu_tanh(float x) { const float u = 0.7978845608028654f * (x + 0.044715f * x * x * x); const float e = __expf(2.f * u); const float th = 1.f - 2.f * __builtin_amdgcn_rcpf(e + 1.f); return 0.5f * x * (1.f + th); }

DI size_t up_off(int row, int col) { const int b = row >> 11, t = row & 2047, c = t >> 4, s = t & 15, g = col >> 4, j = col & 15; return ((size_t)(g * 1024 + b * 128 + c)) * 384 + s * 16 + j; }

struct Args { const float* in[N_IN]; float* out; unsigned char* ws; int lo, hi; };
static_assert(sizeof(Args) == (N_IN + 2) * 8 + 8, "Args has no padding");

#define CAS4 __attribute__((address_space(4)))
#define GAS __attribute__((address_space(1)))
DI const float* inptr(int i) { const CAS4 char* ka = (const CAS4 char*)__builtin_amdgcn_kernarg_segment_ptr(); asm volatile("" : "+s"(ka)); const GAS float* g = *(const GAS float* const CAS4*)(ka + 8 * i); return (const float*)g; }
DI void lds_sync() { asm volatile("s_waitcnt lgkmcnt(0)" ::: "memory"); __builtin_amdgcn_s_barrier(); asm volatile("" ::: "memory"); }
struct Ctx {
    float* out; unsigned char* ws;
    int tid, lane, wave, gtid, gthreads, gwave, gwaves, nblk, blk;
};
DI bf16* wsb(const Ctx& c, size_t off) { return (bf16*)(c.ws + off); }
DI float* wsf(const Ctx& c, size_t off) { return (float*)(c.ws + off); }
DI float* ssq_ptr(const Ctx& c, int idx) { return (float*)(c.ws + WS_SSQ) + (size_t)idx * M * 16; }
DI float rstd_of(const float* P, int row) {
    const float4* p = (const float4*)(P + (size_t)row * 16); const float4 a = p[0], b = p[1], c2 = p[2], d = p[3];
    const float s = (((a.x + a.y) + (a.z + a.w)) + ((b.x + b.y) + (b.z + b.w))) + (((c2.x + c2.y) + (c2.z + c2.w)) + ((d.x + d.y) + (d.z + d.w)));
    return rsqrtf(s * (1.f / D) + EPS);
}

#define XB_TMO      128
#define XB_XCNT(j)  (256  + 64 * (j))
#define XB_XSUB(j)  (1280 + 64 * (j))
#define XB_XGEN(j)  (2304 + 64 * (j))
#define XB_TOP      3328
#define XB_TOPGEN   3392
#define XCD_BAR_WORDS 3456
#define XB_SPIN_CAP (1u << 22)

__device__ __forceinline__ unsigned xb_ld(unsigned* p)              { return __hip_atomic_load(p, __ATOMIC_RELAXED, __HIP_MEMORY_SCOPE_AGENT); }
__device__ __forceinline__ unsigned xb_add(unsigned* p, unsigned v) { return __hip_atomic_fetch_add(p, v, __ATOMIC_RELAXED, __HIP_MEMORY_SCOPE_AGENT); }
__device__ __forceinline__ unsigned xb_xcc_id() { return (unsigned)__builtin_amdgcn_s_getreg((3 << 11) | 20) & 0xFu; }
#define XB_SPIN(cond, bar) do { unsigned _sp = 0; while (cond) { __builtin_amdgcn_s_sleep(1); \
    if ((++_sp & 255u) == 0u) { if (xb_ld(&(bar)[XB_TMO])) break; if (_sp > XB_SPIN_CAP) { atomicAdd(&(bar)[XB_TMO], 1u); break; } } } } while (0)

struct XcdBarrier {
    unsigned* bar; unsigned x;
    volatile LAS unsigned* st;
};

__device__ __forceinline__ XcdBarrier xcd_barrier_post(unsigned* bar, volatile LAS unsigned* st, bool is_t0  ) {
    XcdBarrier b; b.bar = bar; b.x = xb_xcc_id(); b.st = st;
    if (is_t0) (void)xb_add(&bar[XB_XCNT(b.x)], 1u);
    return b;
}
__device__ __forceinline__ void xcd_barrier_complete(unsigned* bar, unsigned x, unsigned& nloc, unsigned& nx) {
    const unsigned G = gridDim.x * gridDim.y * gridDim.z;
    unsigned sum, cnt, mine, sp = 0u;
    for (;;) {
        sum = 0u; cnt = 0u; mine = 0u;
#pragma unroll
        for (unsigned j = 0; j < 16; ++j) { const unsigned c = xb_ld(&bar[XB_XCNT(j)]); sum += c; cnt += (c > 0u) ? 1u : 0u; mine = (j == x) ? c : mine; }
        if (sum == G) break;
        __builtin_amdgcn_s_sleep(1);
        if ((++sp & 255u) == 0u) { if (xb_ld(&bar[XB_TMO])) break; if (sp > XB_SPIN_CAP) { atomicAdd(&bar[XB_TMO], 1u); break; } }
    }
    nloc = mine > 0u ? mine : 1u; nx = cnt > 0u ? cnt : 1u;
}

__device__ __forceinline__ void xcd_barrier(const XcdBarrier& b, bool is_t0  ) {
    asm volatile("s_waitcnt vmcnt(0)" ::: "memory");
    __syncthreads();
    if (is_t0) {
        unsigned* bar = b.bar;
        __builtin_amdgcn_s_waitcnt(0);
        unsigned nloc = b.st[0], nx = b.st[1];
        if (nloc == 0u) { xcd_barrier_complete(bar, b.x, nloc, nx); b.st[0] = nloc; b.st[1] = nx; }
        const unsigned old = xb_add(&bar[XB_XSUB(b.x)], 1u);
        const unsigned gen = old / nloc;
        if (old + 1u == (gen + 1u) * nloc) {
            __builtin_amdgcn_fence(__ATOMIC_RELEASE, "agent");
            asm volatile("s_waitcnt vmcnt(0)" ::: "memory");
            const unsigned og = xb_add(&bar[XB_TOP], 1u);
            const unsigned tg = og / nx;
            if (og + 1u == (tg + 1u) * nx) xb_add(&bar[XB_TOPGEN], 1u);
            else XB_SPIN(xb_ld(&bar[XB_TOPGEN]) == tg, bar);
            __builtin_amdgcn_fence(__ATOMIC_ACQUIRE, "agent");
            xb_add(&bar[XB_XGEN(b.x)], 1u);
            asm volatile("s_waitcnt vmcnt(0)" ::: "memory");
        } else {
            XB_SPIN(xb_ld(&bar[XB_XGEN(b.x)]) == gen, bar);
            __builtin_amdgcn_fence(__ATOMIC_ACQUIRE, "agent");
            asm volatile("s_waitcnt vmcnt(0)" ::: "memory");
        }
    }
    __syncthreads();
}

namespace pg8 {
#define PG8_LAS __attribute__((address_space(3)))
typedef unsigned short bf16_t;
typedef short bf16x8 __attribute__((ext_vector_type(8)));
typedef float f32x4 __attribute__((ext_vector_type(4)));
typedef unsigned u32x4 __attribute__((ext_vector_type(4)));
constexpr int BM = 256, BK = 64, HALF = 128, HTB = HALF * BK * 2  , STAGE_BYTES = 8 * HTB, NXCD = 8, WGM = 8;

__host__ __device__ __forceinline__ int lds_byte(int r, int c) { const int st = (r >> 4) * 2 + (c >> 5), rr = r & 15, cc = c & 31, ob = rr * 64 + cc * 2; return st * 1024 + (ob ^ (((ob >> 9) & 1) << 5)); }
__host__ __device__ __forceinline__ void stage_rc(int b, int& R, int& C) { const int st = b / 1024, sb = b % 1024, swz = sb ^ (((sb >> 9) & 1) << 5); R = (st >> 1) * 16 + swz / 64; C = (st & 1) * 32 + (swz % 64) / 2; }
__host__ __device__ __forceinline__ int perm32(int rho) { const int n = rho >> 4, i = rho & 15; return 8 * (i >> 2) + 4 * n + (i & 3); }

struct Unit { int pm, pn; };
struct Gemm { const bf16_t* A; const bf16_t* Bt; int M, N, K, lda, ldb; };

struct StaticOrder {
    int nM, nN, nwg, G, c;
    __host__ __device__ void init(int M, int N, int G_, int c_) { nM = M / BM; nN = N / BM; nwg = nM * nN; G = G_; c = c_; }
    __host__ __device__ bool next(int i, Unit& u) const {
        const long L = (long)i * G + c; if (L >= nwg) return false;
        int wgid = (int)L; { const int q = nwg / NXCD, r = nwg % NXCD, xcd = wgid % NXCD, off = wgid / NXCD; wgid = (xcd < r ? xcd * (q + 1) : r * (q + 1) + (xcd - r) * q) + off; }
        const int nig = WGM * nN, gid = wgid / nig, fm = gid * WGM, gsz = (nM - fm) < WGM ? (nM - fm) : WGM;
        u.pm = fm + ((wgid % nig) % gsz); u.pn = (wgid % nig) / gsz; return true;
    }
    __device__ __forceinline__ void a_ready(const Unit&) const {}
    __device__ __forceinline__ void done(const Unit&) const {}
};

template <class Epi, class Sched, bool ALIGN_EPI = false, bool SP2 = false>
__device__ __forceinline__ void gemm_phase(PG8_LAS unsigned char* lds, const Gemm g, const Sched& S, const Epi& E, int tid_in) {
    int tid_ = tid_in; asm volatile("" : "+v"(tid_));
    const int tid = tid_, wid = __builtin_amdgcn_readfirstlane(tid >> 6), lane = tid & 63, wr = wid >> 2, wc = wid & 3, fr = lane & 15, fq = lane >> 4;
    const int K = g.K, nt = K / BK;
    unsigned voffA[2], voffB[2];
#pragma unroll
    for (int i = 0; i < 2; ++i) { int R, C; stage_rc(tid * 16 + i * 8192, R, C); const int Rb = Epi::PERM ? ((R & ~31) + perm32(R & 31)) : R;
        voffA[i] = (unsigned)(R * g.lda + C) * 2u; voffB[i] = (unsigned)(Rb * g.ldb + C) * 2u; }
    const size_t kstep = (size_t)(BK * 2);
    const size_t hstepA = (size_t)HALF * g.lda * 2, hstepB = (size_t)HALF * g.ldb * 2;
    const size_t tstepA = 2 * hstepA, tstepB = 2 * hstepB;
    const unsigned ldsw = (unsigned)wid * 1024u;
    const int aoff = lds_byte(wr * 64 + fr, fq * 8), boff = lds_byte(wc * 32 + fr, fq * 8);
#define PG8_SA(b, h) (((b) * 2 + (h)) * HTB)
#define PG8_SB(b, h) ((4 + (b) * 2 + (h)) * HTB)
#define PG8_STAGE(bufoff, gbase, voff) do { _Pragma("unroll") for (int _i = 0; _i < 2; ++_i) \
        __builtin_amdgcn_global_load_lds((const unsigned*)((const char*)(gbase) + (voff)[_i]), (PG8_LAS unsigned*)(lds + (bufoff) + ldsw + _i * 8192), 16, 0, 0); } while (0)
#define PG8_LDA(dst, b, h) do { _Pragma("unroll") for (int m = 0; m < 4; ++m) _Pragma("unroll") for (int k = 0; k < 2; ++k) dst[m][k] = *(const PG8_LAS bf16x8*)(lds + PG8_SA(b, h) + aoff + m * 2048 + k * 1024); } while (0)
#define PG8_LDB(dst, b, h) do { _Pragma("unroll") for (int n = 0; n < 2; ++n) _Pragma("unroll") for (int k = 0; k < 2; ++k) dst[n][k] = *(const PG8_LAS bf16x8*)(lds + PG8_SB(b, h) + boff + n * 2048 + k * 1024); } while (0)
#define PG8_MMA(ai, bj, At, Bt) do { __builtin_amdgcn_s_setprio(1); _Pragma("unroll") for (int m = 0; m < 4; ++m) _Pragma("unroll") for (int n = 0; n < 2; ++n) _Pragma("unroll") for (int k = 0; k < 2; ++k) \
        acc[ai][bj][m][n] = __builtin_amdgcn_mfma_f32_16x16x32_bf16(Bt[n][k], At[m][k], acc[ai][bj][m][n], 0, 0, 0); __builtin_amdgcn_s_setprio(0); } while (0)
#define PG8_WAIT_V(n) asm volatile("s_waitcnt vmcnt(" #n ")" ::: "memory")
#define PG8_WAIT_L(n) asm volatile("s_waitcnt lgkmcnt(" #n ")" ::: "memory")
#define PG8_BAR __builtin_amdgcn_s_barrier()
#define PG8_SCHED __builtin_amdgcn_sched_barrier(0)
    Unit cur, nxt; int ui = 0;
    if (!S.next(0, cur)) return;
    f32x4 acc[2][2][4][2];
#pragma unroll
    for (int a = 0; a < 2; ++a)
#pragma unroll
        for (int b = 0; b < 2; ++b)
#pragma unroll
            for (int m = 0; m < 4; ++m)
#pragma unroll
                for (int n = 0; n < 2; ++n) acc[a][b][m][n] = (f32x4){0.f, 0.f, 0.f, 0.f};
    bf16x8 At[4][2], B0[2][2], B1[2][2];
    const char* cA = (const char*)g.A + (size_t)cur.pm * tstepA; const char* cB = (const char*)g.Bt + (size_t)cur.pn * tstepB;
    S.a_ready(cur);
    if constexpr (SP2) {
        PG8_STAGE(PG8_SB(0, 0), cB, voffB); PG8_STAGE(PG8_SB(0, 1), cB + hstepB, voffB); PG8_STAGE(PG8_SA(0, 0), cA, voffA); PG8_STAGE(PG8_SA(0, 1), cA + hstepA, voffA);
        if (wr == 1) PG8_BAR;
        PG8_WAIT_V(2); PG8_BAR;
        PG8_STAGE(PG8_SB(1, 0), cB + kstep, voffB); PG8_STAGE(PG8_SA(1, 0), cA + kstep, voffA); PG8_STAGE(PG8_SB(1, 1), cB + hstepB + kstep, voffB);
        PG8_WAIT_V(6); PG8_BAR;
    } else {
        PG8_STAGE(PG8_SB(0, 0), cB, voffB); PG8_STAGE(PG8_SA(0, 0), cA, voffA); PG8_STAGE(PG8_SB(0, 1), cB + hstepB, voffB); PG8_STAGE(PG8_SA(0, 1), cA + hstepA, voffA);
        if (wr == 1) PG8_BAR;
        PG8_WAIT_V(4); PG8_BAR;
        PG8_STAGE(PG8_SB(1, 0), cB + kstep, voffB); PG8_STAGE(PG8_SA(1, 0), cA + kstep, voffA); PG8_STAGE(PG8_SB(1, 1), cB + hstepB + kstep, voffB);
        PG8_WAIT_V(6); PG8_BAR;
    }
    for (;;) {
        const bool has_next = S.next(ui + 1, nxt);
        const char* nA = has_next ? (const char*)g.A + (size_t)nxt.pm * tstepA : cA; const char* nB = has_next ? (const char*)g.Bt + (size_t)nxt.pn * tstepB : cB;
#pragma unroll 1
        for (int t = 0; t < nt; t += 2) {
            const bool last = (t == nt - 2);
            const char* a1 = cA + (size_t)(t + 1) * kstep;
            const char* a2 = last ? nA : cA + (size_t)(t + 2) * kstep; const char* b2 = last ? nB : cB + (size_t)(t + 2) * kstep;
            const char* a3 = a2 + kstep; const char* b3 = b2 + kstep;
            if (last && has_next) S.a_ready(nxt);
            if constexpr (SP2) {
            PG8_LDB(B0, 0, 0); PG8_LDB(B1, 0, 1); PG8_SCHED; PG8_LDA(At, 0, 0); PG8_STAGE(PG8_SA(1, 1), a1 + hstepA, voffA);
            PG8_WAIT_V(8); PG8_WAIT_L(0); PG8_BAR; PG8_MMA(0, 0, At, B0); PG8_MMA(0, 1, At, B1); PG8_BAR; PG8_SCHED;
            PG8_LDA(At, 0, 1); PG8_STAGE(PG8_SB(0, 0), b2, voffB); PG8_STAGE(PG8_SB(0, 1), b2 + hstepB, voffB); PG8_STAGE(PG8_SA(0, 0), a2, voffA);
            PG8_WAIT_V(8); PG8_WAIT_L(0); PG8_BAR; PG8_MMA(1, 0, At, B0); PG8_MMA(1, 1, At, B1); PG8_BAR; PG8_SCHED;
            PG8_LDB(B0, 1, 0); PG8_LDB(B1, 1, 1); PG8_SCHED; PG8_LDA(At, 1, 0); PG8_STAGE(PG8_SA(0, 1), a2 + hstepA, voffA);
            PG8_WAIT_V(8); PG8_WAIT_L(0); PG8_BAR; PG8_MMA(0, 0, At, B0); PG8_MMA(0, 1, At, B1); PG8_BAR; PG8_SCHED;
            PG8_LDA(At, 1, 1); PG8_STAGE(PG8_SB(1, 0), b3, voffB); PG8_STAGE(PG8_SB(1, 1), b3 + hstepB, voffB); PG8_STAGE(PG8_SA(1, 0), a3, voffA);
            PG8_WAIT_V(8); PG8_WAIT_L(0); PG8_BAR; PG8_MMA(1, 0, At, B0); PG8_MMA(1, 1, At, B1); PG8_BAR; PG8_SCHED;
            } else {
            PG8_LDB(B0, 0, 0); PG8_SCHED; PG8_LDA(At, 0, 0); PG8_STAGE(PG8_SA(1, 1), a1 + hstepA, voffA);
            PG8_WAIT_L(8); PG8_BAR; PG8_WAIT_L(0); PG8_MMA(0, 0, At, B0); PG8_BAR; PG8_SCHED;
            PG8_LDB(B1, 0, 1); PG8_STAGE(PG8_SB(0, 0), b2, voffB);
            PG8_BAR; PG8_WAIT_L(0); PG8_MMA(0, 1, At, B1); PG8_BAR;
            PG8_LDA(At, 0, 1); PG8_STAGE(PG8_SA(0, 0), a2, voffA);
            PG8_BAR; PG8_WAIT_L(0); PG8_MMA(1, 0, At, B0); PG8_BAR; PG8_SCHED;
            PG8_STAGE(PG8_SB(0, 1), b2 + hstepB, voffB);
            PG8_WAIT_V(6); PG8_BAR; PG8_MMA(1, 1, At, B1); PG8_BAR;
            PG8_LDB(B0, 1, 0); PG8_SCHED; PG8_LDA(At, 1, 0); PG8_STAGE(PG8_SA(0, 1), a2 + hstepA, voffA);
            PG8_WAIT_L(8); PG8_BAR; PG8_WAIT_L(0); PG8_MMA(0, 0, At, B0); PG8_BAR; PG8_SCHED;
            PG8_LDB(B1, 1, 1); PG8_STAGE(PG8_SB(1, 0), b3, voffB);
            PG8_BAR; PG8_WAIT_L(0); PG8_MMA(0, 1, At, B1); PG8_BAR;
            PG8_LDA(At, 1, 1); PG8_STAGE(PG8_SA(1, 0), a3, voffA);
            PG8_BAR; PG8_WAIT_L(0); PG8_MMA(1, 0, At, B0); PG8_BAR; PG8_SCHED;
            PG8_STAGE(PG8_SB(1, 1), b3 + hstepB, voffB);
            PG8_WAIT_V(6); PG8_BAR; PG8_MMA(1, 1, At, B1); PG8_BAR;
            }
        }
        if constexpr (ALIGN_EPI) { if (wr == 0) PG8_BAR; }
        if constexpr (!Epi::AFTER_DRAIN) { E(acc, cur, wr, wc, fr, fq, ui); S.done(cur); }
        if (!has_next) break;
#pragma unroll
        for (int a = 0; a < 2; ++a)
#pragma unroll
            for (int b = 0; b < 2; ++b)
#pragma unroll
                for (int m = 0; m < 4; ++m)
#pragma unroll
                    for (int n = 0; n < 2; ++n) acc[a][b][m][n] = (f32x4){0.f, 0.f, 0.f, 0.f};
        cur = nxt; cA = nA; cB = nB; ++ui;
        if constexpr (ALIGN_EPI) { if (wr == 1) PG8_BAR; }
    }
    PG8_WAIT_V(0);
    if constexpr (!ALIGN_EPI) { if (wr == 0) PG8_BAR; }
    PG8_BAR;
    if constexpr (Epi::AFTER_DRAIN) { E.fused(acc, cur, wr, wc, fr, fq, lds, wid, lane); S.done(cur); }
#undef PG8_SA
#undef PG8_SB
#undef PG8_STAGE
#undef PG8_LDA
#undef PG8_LDB
#undef PG8_MMA
#undef PG8_WAIT_V
#undef PG8_WAIT_L
#undef PG8_BAR
#undef PG8_SCHED
}
}
struct PF0 {};
struct ESwiGLU {
    static constexpr int ID = 1; static constexpr bool NEEDS_RS = true; static constexpr bool PAIRED = true;
    const float* ssq_in; bf16* act;
    typedef PF0 PF; DI PF load(int, int) const { return PF0{}; }
    DI const float* ssq_src() const { return ssq_in; } DI float pre(int row) const { return rstd_of(ssq_in, row); }
    DI float operator()(int row, int col, const float (&a)[8], const float (&b)[8], float rs, const PF&) const {
        float o[8];
#pragma unroll
        for (int i = 0; i < 8; ++i) { const float g = a[i] * rs, u = b[i] * rs; o[i] = g * sigm(g) * u; }
        *(uint4*)(act + (size_t)row * FF + col) = pk8(o);
        return 0.f;
    }
};
struct EResid {
    static constexpr int ID = 2; static constexpr bool NEEDS_RS = false; static constexpr bool PAIRED = false;
    const bf16* XBin; bf16* XBout; float scale;
    struct PF { uint4 x; };
    DI PF load(int row, int col) const { PF p; p.x = *(const uint4*)(XBin + (size_t)row * D + col); return p; }
    DI const float* ssq_src() const { return nullptr; } DI float pre(int) const { return 0.f; }
    DI float operator()(int row, int col, const float (&a)[8], const float (&)[8], float, const PF& p) const {
        float o[8]; unpk8(p.x, o);
        float s = 0.f;
#pragma unroll
        for (int i = 0; i < 8; ++i) { o[i] += scale * a[i]; s += o[i] * o[i]; }
        *(uint4*)(XBout + (size_t)row * D + col) = pk8(o);
        return s;
    }
};
struct EWin {
    static constexpr int ID = 3; static constexpr bool NEEDS_RS = true; static constexpr bool PAIRED = false;
    const float* ssq_in; bf16 *UP, *US, *QKR, *V, *OS;
    typedef PF0 PF; DI PF load(int, int) const { return PF0{}; }
    DI const float* ssq_src() const { return ssq_in; } DI float pre(int row) const { return rstd_of(ssq_in, row); }
    DI float operator()(int row, int col, const float (&a)[8], const float (&)[8], float rs, const PF&) const {
        float o[8];
#pragma unroll
        for (int i = 0; i < 8; ++i) o[i] = a[i] * rs;
        if (col < 512) {
            if (row < MP) *(uint4*)(UP + up_off(row, col)) = pk8(o);
            else *(uint4*)(US + (size_t)(row - MP) * 512 + col) = pk8(o);
        } else if (col < 2560) { *(uint4*)(QKR + (size_t)row * 2048 + (col - 512)) = pk8(o); }
        else if (col < 3584) { *(uint4*)(V + (size_t)row * 1024 + (col - 2560)) = pk8(o); }
        else {
#pragma unroll
            for (int i = 0; i < 8; ++i) o[i] = sigm(o[i]);
            const int seg = (col - 3584) >> 10, cc = (col - 3584) & 1023;
            *(uint4*)(OS + (size_t)seg * ((size_t)M * 1024) + (size_t)row * 1024 + cc) = pk8(o);
        }
        return 0.f;
    }
};
struct EGlu {
    static constexpr int ID = 4; static constexpr bool NEEDS_RS = false; static constexpr bool PAIRED = false;
    const bf16* YS5; bf16* YG;
    struct PF { uint4 y; };
    DI PF load(int row, int col) const { PF p; p.y = *(const uint4*)(YS5 + (size_t)row * 512 + col); return p; }
    DI const float* ssq_src() const { return nullptr; } DI float pre(int) const { return 0.f; }
    DI float operator()(int row, int col, const float (&a)[8], const float (&)[8], float, const PF& p) const {
        float y[8]; unpk8(p.y, y);
#pragma unroll
        for (int i = 0; i < 8; ++i) y[i] = y[i] * sigm(a[i]);
        *(uint4*)(YG + (size_t)row * 512 + col) = pk8(y);
        return 0.f;
    }
};
struct ET5 {
    static constexpr int ID = 5; static constexpr bool NEEDS_RS = false; static constexpr bool PAIRED = false;
    const bf16* GS5; bf16* T5;
    struct PF { uint4 g; };
    DI PF load(int row, int col) const { PF p; p.g = *(const uint4*)(GS5 + (size_t)row * 1024 + col); return p; }
    DI const float* ssq_src() const { return nullptr; } DI float pre(int) const { return 0.f; }
    DI float operator()(int row, int col, const float (&a)[8], const float (&)[8], float, const PF& p) const {
        float g[8]; unpk8(p.g, g);
#pragma unroll
        for (int i = 0; i < 8; ++i) g[i] *= a[i];
        *(uint4*)(T5 + (size_t)row * 1024 + col) = pk8(g);
        return 0.f;
    }
};
struct EMerged {
    static constexpr int ID = 6; static constexpr bool NEEDS_RS = false; static constexpr bool PAIRED = false;
    const bf16* T5; const bf16* GM; bf16* MRG;
    struct PF { uint4 t, g; };
    DI PF load(int row, int col) const { PF p; p.t = *(const uint4*)(T5 + (size_t)row * 1024 + col); p.g = *(const uint4*)(GM + (size_t)row * 1024 + col); return p; }
    DI const float* ssq_src() const { return nullptr; } DI float pre(int) const { return 0.f; }
    DI float operator()(int row, int col, const float (&a)[8], const float (&)[8], float, const PF& p) const {
        float g[8], o[8]; unpk8(p.g, g); unpk8(p.t, o);
#pragma unroll
        for (int i = 0; i < 8; ++i) o[i] += g[i] * a[i];
        *(uint4*)(MRG + (size_t)row * 1024 + col) = pk8(o);
        return 0.f;
    }
};
struct EGate {
    static constexpr int ID = 7; static constexpr bool NEEDS_RS = true; static constexpr bool PAIRED = false;
    const float* ssq_in; bf16* GT;
    typedef PF0 PF; DI PF load(int, int) const { return PF0{}; }
    DI const float* ssq_src() const { return ssq_in; } DI float pre(int row) const { return rstd_of(ssq_in, row); }
    DI float operator()(int row, int col, const float (&a)[8], const float (&)[8], float rs, const PF&) const {
        float o[8];
#pragma unroll
        for (int i = 0; i < 8; ++i) o[i] = sigm(a[i] * rs);
        *(uint4*)(GT + (size_t)row * 1024 + col) = pk8(o);
        return 0.f;
    }
};
struct EPle {
    static constexpr int ID = 8; static constexpr bool NEEDS_RS = false; static constexpr bool PAIRED = false;
    const bf16* XBin; bf16* XBout; const bf16* GT; float scale;
    struct PF { uint4 x, g; };
    DI PF load(int row, int col) const { PF p; p.x = *(const uint4*)(XBin + (size_t)row * D + col); p.g = *(const uint4*)(GT + (size_t)row * 1024 + col); return p; }
    DI const float* ssq_src() const { return nullptr; } DI float pre(int) const { return 0.f; }
    DI float operator()(int row, int col, const float (&a)[8], const float (&)[8], float, const PF& p) const {
        float g[8], o[8]; unpk8(p.g, g); unpk8(p.x, o);
        float s = 0.f;
#pragma unroll
        for (int i = 0; i < 8; ++i) { o[i] += scale * g[i] * a[i]; s += o[i] * o[i]; }
        *(uint4*)(XBout + (size_t)row * D + col) = pk8(o);
        return s;
    }
};

template <class F>
DI void gemm_ref(const Ctx& c, const bf16* A, int lda, const bf16* Bt, int ldb, int Mrows, int Ncols, int K, const F& f, float* ssq_out) {
    const int ng = Ncols >> 3;
    const long items = (long)Mrows * ng;
    for (long it = c.gtid; it < items; it += c.gthreads) {
        const int row = (int)(it % Mrows), c0 = (int)(it / Mrows) * 8;
        float a[8], b[8];
#pragma unroll
        for (int j = 0; j < 8; ++j) { a[j] = 0.f; b[j] = 0.f; }
        const bf16* ar = A + (size_t)row * lda;
        const int br0 = F::PAIRED ? ((c0 >> 7) * 256 + (c0 & 127)) : c0;
        const bf16* br = Bt + (size_t)br0 * ldb;
        for (int k0 = 0; k0 < K; k0 += 8) {
            const uint4 av = *(const uint4*)(ar + k0);
#pragma unroll
            for (int j = 0; j < 8; ++j) {
                a[j] = dot8(av, *(const uint4*)(br + (size_t)j * ldb + k0), a[j]);
                if (F::PAIRED) b[j] = dot8(av, *(const uint4*)(br + (size_t)(128 + j) * ldb + k0), b[j]);
            }
        }
        (void)f(row, c0, a, b, f.pre(row), f.load(row, c0)); (void)ssq_out;
    }
}

DI void tr_mat(const Ctx& c, bf16* dst, int N, int K, const float* srcA, const float* srcB, int Nsrc, const float* gain, int mode, int cut, int skip) {
    const long total = (long)N * (K >> 3);
    for (long idx = c.gtid; idx < total; idx += c.gthreads) {
        const int n = (int)(idx % N), kg = (int)(idx / N);
        const float* s; int sc;
        if (mode == 1) { const int tile = n >> 8, l = n & 255; s = l < 128 ? srcA : srcB; sc = tile * 128 + (l & 127); }
        else { s = srcA; sc = n + (n >= cut ? skip : 0); }
        float v[8];
#pragma unroll
        for (int i = 0; i < 8; ++i) { const int k = kg * 8 + i; float w = s[(size_t)k * Nsrc + sc]; if (gain) w *= gain[k]; v[i] = w; }
        *(uint4*)(dst + (size_t)n * (K + PADK) + kg * 8) = pk8(v);
    }
}
DI void tr_tile(LAS float* scr, const float* W, int Nsrc, int scol0, const float* gain, bf16* dst, int K, int n0, int k0, int lane) {
    float wv[32];
#pragma unroll
    for (int i = 0; i < 32; ++i) wv[i] = W[(size_t)(k0 + 2 * i + (lane >> 5)) * Nsrc + scol0 + (lane & 31)];
    if (gain) {
#pragma unroll
        for (int i = 0; i < 32; ++i) wv[i] *= gain[k0 + 2 * i + (lane >> 5)];
    }
#pragma unroll
    for (int i = 0; i < 32; ++i) scr[(2 * i + (lane >> 5)) * 33 + (lane & 31)] = wv[i];
    asm volatile("s_waitcnt lgkmcnt(0)" ::: "memory");
    const int ch = lane & 7;
#pragma unroll
    for (int j = 0; j < 4; ++j) {
        const int n = (lane >> 3) + 8 * j; const LAS float* sp = scr + (8 * ch) * 33 + n;
        float v[8];
#pragma unroll
        for (int i = 0; i < 8; ++i) v[i] = sp[i * 33];
        *(uint4*)(dst + (size_t)(n0 + n) * (K + PADK) + k0 + 8 * ch) = pk8(v);
    }
    asm volatile("s_waitcnt lgkmcnt(0)" ::: "memory");
}
DI void stage_prologue(const Args& a, const Ctx& c, unsigned char* lds_) {
    LAS float* scr = (LAS float*)lds_ + c.wave * (64 * 33);
    constexpr int T_W1GU = 16 * 128, T_W1D = 32 * 32, T_WIN = 16 * (INN / 32), T_WGLU = 8 * 16, T_WS5UP = 8 * 32, T_SQ = 16 * 32, T_WPLE = 4 * 32;
    constexpr int T_LAYER = 2 * T_W1GU + 2 * T_W1D + T_WIN + T_WGLU + T_WS5UP + 3 * T_SQ + T_WPLE;
    for (int it = c.gwave; it < NL * T_LAYER; it += c.gwaves) {
        const int l = it / T_LAYER; int r = it % T_LAYER;
        unsigned char* lw = c.ws + WS_W + (size_t)l * LW_STRIDE;
        if (r < 2 * T_W1GU) {
            const int which = r / T_W1GU; r %= T_W1GU; const int kb = r / 128, nb = r % 128, n0 = nb * 32, tile = n0 >> 8, lrow = n0 & 255;
            const float* src = inptr(which ? (lrow < 128 ? I_W2G : I_W2U) : (lrow < 128 ? I_W1G : I_W1U)) + (size_t)l * D * FF;
            tr_tile(scr, src, FF, tile * 128 + (lrow & 127), inptr(which ? I_GFFN2 : I_GFFN1) + l * D, (bf16*)(lw + (which ? LW_W2GU : LW_W1GU)), 1024, n0, kb * 64, c.lane); continue; }
        r -= 2 * T_W1GU;
        if (r < 2 * T_W1D) { const int which = r / T_W1D; r %= T_W1D; const int kb = r / 32, nb = r % 32;
            tr_tile(scr, inptr(which ? I_W2D : I_W1D) + (size_t)l * FF * D, D, nb * 32, nullptr, (bf16*)(lw + (which ? LW_W2D : LW_W1D)), 2048, nb * 32, kb * 64, c.lane); continue; }
        r -= 2 * T_W1D;
        if (r < T_WIN) { const int kb = r / (INN / 32), nb = r % (INN / 32), n0 = nb * 32;
            tr_tile(scr, inptr(I_WIN) + (size_t)l * D * INC, INC, n0 + (n0 >= 4608 ? 8 : 0), inptr(I_GMIX) + l * D, (bf16*)(lw + LW_WIN), 1024, n0, kb * 64, c.lane); continue; }
        r -= T_WIN;
        if (r < T_WGLU) { const int kb = r / 16, nb = r % 16; tr_tile(scr, inptr(I_WGLU) + (size_t)l * 512 * 512, 512, nb * 32, nullptr, (bf16*)(lw + LW_WGLU), 512, nb * 32, kb * 64, c.lane); continue; }
        r -= T_WGLU;
        if (r < T_WS5UP) { const int kb = r / 32, nb = r % 32; tr_tile(scr, inptr(I_WS5UP) + (size_t)l * 512 * 1024, 1024, nb * 32, nullptr, (bf16*)(lw + LW_WS5UP), 512, nb * 32, kb * 64, c.lane); continue; }
        r -= T_WS5UP;
        if (r < 3 * T_SQ) { const int which = r / T_SQ; r %= T_SQ; const int kb = r / 32, nb = r % 32;
            const float* src = inptr(which == 0 ? I_WMUP : (which == 1 ? I_WOUT : I_WPG)) + (size_t)l * 1024 * 1024;
            const float* gain = which == 2 ? inptr(I_GPLE) + l * D : nullptr;
            tr_tile(scr, src, 1024, nb * 32, gain, (bf16*)(lw + (which == 0 ? LW_WMUP : (which == 1 ? LW_WOUT : LW_WPG))), 1024, nb * 32, kb * 64, c.lane); continue; }
        r -= 3 * T_SQ;
        { const int kb = r / 32, nb = r % 32; tr_tile(scr, inptr(I_WPLE) + (size_t)l * 256 * 1024, 1024, nb * 32, nullptr, (bf16*)(lw + LW_WPLE), 256, nb * 32, kb * 64, c.lane); }
    }
    for (int l = 0; l < NL; ++l) {
        float* wg = (float*)(c.ws + WS_W + (size_t)l * LW_STRIDE + LW_WG);
        for (int idx = c.gtid; idx < 8 * 1024; idx += c.gthreads) { const int j = idx >> 10, k = idx & 1023; wg[idx] = inptr(I_WIN)[(size_t)l * D * INC + (size_t)k * INC + 4608 + j] * inptr(I_GMIX)[l * D + k]; }
    }
    bf16* XB = wsb(c, WS_XB); float* ssq0 = ssq_ptr(c, 0);
    for (int row = c.gwave; row < M; row += c.gwaves) {
        const float* src = row < MP ? inptr(I_XP) + (size_t)row * D : inptr(I_XS) + (size_t)(row - MP) * D;
        float s = 0.f;
        float4 xv[4];
#pragma unroll
        for (int j = 0; j < 4; ++j) xv[j] = *(const float4*)(src + (c.lane + 64 * j) * 4);
#pragma unroll
        for (int j = 0; j < 4; ++j) {
            const int col = (c.lane + 64 * j) * 4;
            const float4 v = xv[j];
            uint2 w; w.x = pk2(v.x, v.y); w.y = pk2(v.z, v.w); *(uint2*)(XB + (size_t)row * D + col) = w;
            s += v.x * v.x + v.y * v.y + v.z * v.z + v.w * v.w;
        }
        s = wave_sum(s);
        if (c.lane < 16) ssq0[(size_t)row * 16 + c.lane] = c.lane == 0 ? s : 0.f;
    }
    bf16* PB = wsb(c, WS_PB);
    const long tp = (long)NL * M * (DPLE / 8);
    for (long idx0 = c.gtid; idx0 < tp; idx0 += 4L * c.gthreads) {
        float4 pa[4], pb[4];
#pragma unroll
        for (int j = 0; j < 4; ++j) {
            const long idx = idx0 + (long)j * c.gthreads;
            if (idx < tp) {
                const int cg = (int)(idx % (DPLE / 8)); const long rl = idx / (DPLE / 8); const int row = (int)(rl % M), l = (int)(rl / M);
                const float* src = row < MP ? inptr(I_PP) + ((size_t)l * MP + row) * DPLE + cg * 8 : inptr(I_PS) + ((size_t)l * MS + (row - MP)) * DPLE + cg * 8;
                pa[j] = *(const float4*)src; pb[j] = *(const float4*)(src + 4);
            }
        }
#pragma unroll
        for (int j = 0; j < 4; ++j) {
            const long idx = idx0 + (long)j * c.gthreads;
            if (idx < tp) {
                const int cg = (int)(idx % (DPLE / 8)); const long rl = idx / (DPLE / 8); const int row = (int)(rl % M), l = (int)(rl / M);
                float v[8] = {pa[j].x, pa[j].y, pa[j].z, pa[j].w, pb[j].x, pb[j].y, pb[j].z, pb[j].w};
                *(uint4*)(PB + ((size_t)l * M + row) * DPLE + cg * 8) = pk8(v);
            }
        }
    }
}

DI void conv_row(const float (&w)[4][8], const float (&bias)[8], const float (&x0)[8], const float (&x1)[8], const float (&x2)[8], const float (&x3)[8], int c0, size_t row, bf16* Q, bf16* Kb) {
    float o[8];
#pragma unroll
    for (int i = 0; i < 8; ++i) { const float v = bias[i] + w[0][i] * x0[i] + w[1][i] * x1[i] + w[2][i] * x2[i] + w[3][i] * x3[i]; o[i] = v * sigm(v) * (c0 < 1024 ? 0.0625f : 1.f); }
    if (c0 < 1024) *(uint4*)(Q + row * 1024 + c0) = pk8(o); else *(uint4*)(Kb + row * 1024 + (c0 - 1024)) = pk8(o);
}
DI void stage_conv(const Args& a, const Ctx& c, int l) {
    const bf16* QKR = wsb(c, WS_QKR); bf16* Q = wsb(c, WS_Q); bf16* Kb = wsb(c, WS_K);
    const float* cw = inptr(I_CONVW) + (size_t)l * 4 * 2048; const float* cb = inptr(I_CONVB) + (size_t)l * 2048;
    const float* st = inptr(I_CONV) + (size_t)l * NBS * 3 * 2048;
    constexpr int NPI = NBP * 256 * 64, NSI = NBS * 256;
    for (int it = c.gtid; it < NPI + NSI; it += c.gthreads) {
        const bool smp = it >= NPI; const int j = smp ? it - NPI : it, cg = j & 255, c0 = cg * 8;
        float w[4][8], bias[8];
#pragma unroll
        for (int q = 0; q < 4; ++q) { const float4 w0 = *(const float4*)(cw + q * 2048 + c0), w1 = *(const float4*)(cw + q * 2048 + c0 + 4); w[q][0] = w0.x; w[q][1] = w0.y; w[q][2] = w0.z; w[q][3] = w0.w; w[q][4] = w1.x; w[q][5] = w1.y; w[q][6] = w1.z; w[q][7] = w1.w; }
        { const float4 b0 = *(const float4*)(cb + c0), b1 = *(const float4*)(cb + c0 + 4); bias[0] = b0.x; bias[1] = b0.y; bias[2] = b0.z; bias[3] = b0.w; bias[4] = b1.x; bias[5] = b1.y; bias[6] = b1.z; bias[7] = b1.w; }
        float x0[8], x1[8], x2[8];
        if (!smp) {
            const int seg = (j >> 8) & 63, b = j >> 14, t0 = seg * 32; const size_t rb = (size_t)b * SEQ + t0;
            if (t0 == 0) {
#pragma unroll
                for (int i = 0; i < 8; ++i) { x0[i] = 0.f; x1[i] = 0.f; x2[i] = 0.f; }
            } else { unpk8(*(const uint4*)(QKR + (rb - 3) * 2048 + c0), x0); unpk8(*(const uint4*)(QKR + (rb - 2) * 2048 + c0), x1); unpk8(*(const uint4*)(QKR + (rb - 1) * 2048 + c0), x2); }
#pragma unroll 1
            for (int t8 = 0; t8 < 32; t8 += 8) {
                uint4 xr[8];
#pragma unroll
                for (int i = 0; i < 8; ++i) xr[i] = *(const uint4*)(QKR + (rb + t8 + i) * 2048 + c0);
#pragma unroll
                for (int i = 0; i < 8; ++i) {
                    float x3[8]; unpk8(xr[i], x3);
                    conv_row(w, bias, x0, x1, x2, x3, c0, rb + t8 + i, Q, Kb);
#pragma unroll
                    for (int e = 0; e < 8; ++e) { x0[e] = x1[e]; x1[e] = x2[e]; x2[e] = x3[e]; }
                }
            }
            if (seg == 63) {
                float* o = c.out + O_CONV_P + (((size_t)l * NBP + b) * 3) * 2048 + c0;
                *(float4*)o = make_float4(x0[0], x0[1], x0[2], x0[3]); *(float4*)(o + 4) = make_float4(x0[4], x0[5], x0[6], x0[7]);
                *(float4*)(o + 2048) = make_float4(x1[0], x1[1], x1[2], x1[3]); *(float4*)(o + 2048 + 4) = make_float4(x1[4], x1[5], x1[6], x1[7]);
                *(float4*)(o + 4096) = make_float4(x2[0], x2[1], x2[2], x2[3]); *(float4*)(o + 4096 + 4) = make_float4(x2[4], x2[5], x2[6], x2[7]);
            }
        } else {
            const int bs = j >> 8; const size_t rb = (size_t)MP + (size_t)bs * SS;
            const float* sp = st + (size_t)bs * 3 * 2048 + c0;
            { const float4 p0 = *(const float4*)sp, p1 = *(const float4*)(sp + 4); x0[0] = p0.x; x0[1] = p0.y; x0[2] = p0.z; x0[3] = p0.w; x0[4] = p1.x; x0[5] = p1.y; x0[6] = p1.z; x0[7] = p1.w; }
            { const float4 p0 = *(const float4*)(sp + 2048), p1 = *(const float4*)(sp + 2048 + 4); x1[0] = p0.x; x1[1] = p0.y; x1[2] = p0.z; x1[3] = p0.w; x1[4] = p1.x; x1[5] = p1.y; x1[6] = p1.z; x1[7] = p1.w; }
            { const float4 p0 = *(const float4*)(sp + 4096), p1 = *(const float4*)(sp + 4096 + 4); x2[0] = p0.x; x2[1] = p0.y; x2[2] = p0.z; x2[3] = p0.w; x2[4] = p1.x; x2[5] = p1.y; x2[6] = p1.z; x2[7] = p1.w; }
            uint4 xr[4];
#pragma unroll
            for (int i = 0; i < 4; ++i) xr[i] = *(const uint4*)(QKR + (rb + i) * 2048 + c0);
#pragma unroll
            for (int i = 0; i < 4; ++i) {
                float x3[8]; unpk8(xr[i], x3);
                conv_row(w, bias, x0, x1, x2, x3, c0, rb + i, Q, Kb);
#pragma unroll
                for (int e = 0; e < 8; ++e) { x0[e] = x1[e]; x1[e] = x2[e]; x2[e] = x3[e]; }
            }
            float* o = c.out + O_CONV_S + (((size_t)l * NBS + bs) * 3) * 2048 + c0;
            *(float4*)o = make_float4(x0[0], x0[1], x0[2], x0[3]); *(float4*)(o + 4) = make_float4(x0[4], x0[5], x0[6], x0[7]);
            *(float4*)(o + 2048) = make_float4(x1[0], x1[1], x1[2], x1[3]); *(float4*)(o + 2048 + 4) = make_float4(x1[4], x1[5], x1[6], x1[7]);
            *(float4*)(o + 4096) = make_float4(x2[0], x2[1], x2[2], x2[3]); *(float4*)(o + 4096 + 4) = make_float4(x2[4], x2[5], x2[6], x2[7]);
        }
    }
}

DI void stage_gates(const Args& a, const Ctx& c, int l, const float* ssq_in, const bf16* XB) {
    const float* wg = (const float*)(c.ws + WS_W + (size_t)l * LW_STRIDE + LW_WG);
    float* LI = wsf(c, WS_LI); float* LF = wsf(c, WS_LF);
    float w[8][16];
#pragma unroll
    for (int j = 0; j < 8; ++j)
#pragma unroll
        for (int q = 0; q < 4; ++q) { const float4 wv = *(const float4*)(wg + j * 1024 + c.lane * 16 + 4 * q); w[j][4 * q] = wv.x; w[j][4 * q + 1] = wv.y; w[j][4 * q + 2] = wv.z; w[j][4 * q + 3] = wv.w; }
    const float bi = c.lane < 4 ? inptr(I_BIG)[l * 4 + c.lane] : 0.f, bfg = c.lane < 4 ? inptr(I_BFG)[l * 4 + c.lane] : 0.f;
    int row = c.gwave;
    uint4 n0 = make_uint4(0, 0, 0, 0), n1 = n0;
    if (row < M) { n0 = *(const uint4*)(XB + (size_t)row * D + c.lane * 16); n1 = *(const uint4*)(XB + (size_t)row * D + c.lane * 16 + 8); }
    for (; row < M; row += c.gwaves) {
        float x[16];
        { float t0[8], t1[8]; unpk8(n0, t0); unpk8(n1, t1);
#pragma unroll
          for (int i = 0; i < 8; ++i) { x[i] = t0[i]; x[8 + i] = t1[i]; } }
        const int nr = row + c.gwaves;
        if (nr < M) { n0 = *(const uint4*)(XB + (size_t)nr * D + c.lane * 16); n1 = *(const uint4*)(XB + (size_t)nr * D + c.lane * 16 + 8); }
        float acc[8];
#pragma unroll
        for (int j = 0; j < 8; ++j) {
            float s = 0.f;
#pragma unroll
            for (int q = 0; q < 16; ++q) s += w[j][q] * x[q];
            acc[j] = wave_sum(s);
        }
        const float rstd = rstd_of(ssq_in, row);
        if (c.lane < 4) {
            float ig = acc[0]; ig = c.lane == 1 ? acc[1] : ig; ig = c.lane == 2 ? acc[2] : ig; ig = c.lane == 3 ? acc[3] : ig;
            float fg = acc[4]; fg = c.lane == 1 ? acc[5] : fg; fg = c.lane == 2 ? acc[6] : fg; fg = c.lane == 3 ? acc[7] : fg;
            LI[(size_t)row * 4 + c.lane] = ig * rstd + bi;
            const float z = fg * rstd + bfg;
            LF[(size_t)row * 4 + c.lane] = (z >= 0.f) ? -__logf(1.f + __expf(-z)) : (z - __logf(1.f + __expf(z)));
        }
    }
}

DI void stage_s5_ref(const Args& a, const Ctx& c, int l, unsigned char* lds) {
    float* hst = (float*)lds + c.wave * 128;
    const bf16* UP = wsb(c, WS_UP); const bf16* US = wsb(c, WS_US); bf16* YS5 = wsb(c, WS_YS5);
    const int nitems = (NBP + NBS) * NG;
    for (int it = (FAST_S5 ? NBP * NG : 0) + c.gwave; it < nitems; it += c.gwaves) {
        const int seq = it / NG, g = it % NG, n = c.lane;
        const float lre = inptr(I_LRE)[((size_t)l * NG + g) * NST + n], lim = inptr(I_LIM)[((size_t)l * NG + g) * NST + n];
        const float dt = expf(inptr(I_LDT)[l * NG + g]);
        const float mag = expf(lre * dt), ar = mag * cosf(lim * dt), ai = mag * sinf(lim * dt);
        const float den = lre * lre + lim * lim, pr = ar - 1.f;
        const float wre = (pr * lre + ai * lim) / den, wim = (ai * lre - pr * lim) / den;
        float bbr[16], bbi[16];
        { const float* bre = inptr(I_BRE) + (((size_t)l * NG + g) * NST + n) * 16; const float* bim = inptr(I_BIM) + (((size_t)l * NG + g) * NST + n) * 16;
#pragma unroll
          for (int j = 0; j < 16; ++j) { const float r = bre[j], i = bim[j]; bbr[j] = wre * r - wim * i; bbi[j] = wre * i + wim * r; } }
        const int hh = c.lane & 15, part = c.lane >> 4;
        float cre[16], cim[16];
        { const float* pr_ = inptr(I_CRE) + (((size_t)l * NG + g) * 16 + hh) * NST + part * 16; const float* pi_ = inptr(I_CIM) + (((size_t)l * NG + g) * 16 + hh) * NST + part * 16;
#pragma unroll
          for (int i = 0; i < 16; ++i) { cre[i] = pr_[i]; cim[i] = pi_[i]; } }
        const float dsk = inptr(I_S5D)[l * S5W + g * 16 + hh];
        float hr = 0.f, hi = 0.f; int S, row0;
        if (seq < NBP) { S = SEQ; row0 = seq * SEQ; }
        else { const int bs = seq - NBP; S = SS; row0 = MP + bs * SS; hr = inptr(I_S5RE)[(((size_t)l * NBS + bs) * NG + g) * NST + n]; hi = inptr(I_S5IM)[(((size_t)l * NBS + bs) * NG + g) * NST + n]; }
        for (int t = 0; t < S; ++t) {
            const int row = row0 + t;
            const bf16* up = row < MP ? UP + up_off(row, g * 16) : US + (size_t)(row - MP) * 512 + g * 16;
            float u[16];
            { float t0[8], t1[8]; unpk8(*(const uint4*)up, t0); unpk8(*(const uint4*)(up + 8), t1);
#pragma unroll
              for (int i = 0; i < 8; ++i) { u[i] = t0[i]; u[8 + i] = t1[i]; } }
            float bur = 0.f, bui = 0.f;
#pragma unroll
            for (int j = 0; j < 16; ++j) { bur += bbr[j] * u[j]; bui += bbi[j] * u[j]; }
            const float nr = ar * hr - ai * hi + bur, ni = ar * hi + ai * hr + bui;
            hr = nr; hi = ni;
            hst[2 * n] = hr; hst[2 * n + 1] = hi;
            asm volatile("s_waitcnt lgkmcnt(0)" ::: "memory");
            float y = 0.f;
#pragma unroll
            for (int i = 0; i < 16; ++i) { const float2 hv = *(const float2*)(hst + 2 * (part * 16 + i)); y += cre[i] * hv.x - cim[i] * hv.y; }
            asm volatile("s_waitcnt lgkmcnt(0)" ::: "memory");
            y += __shfl_xor(y, 16); y += __shfl_xor(y, 32);
            y += dsk * bf2f(up[hh]);
            if (c.lane < 16) YS5[(size_t)row * 512 + g * 16 + hh] = (bf16)f2bf(gelu_tanh(y));
        }
        float* ore = c.out + (seq < NBP ? O_S5RE_P + (((size_t)l * NBP + seq) * NG + g) * NST : O_S5RE_S + (((size_t)l * NBS + (seq - NBP)) * NG + g) * NST);
        float* oim = c.out + (seq < NBP ? O_S5IM_P + (((size_t)l * NBP + seq) * NG + g) * NST : O_S5IM_S + (((size_t)l * NBS + (seq - NBP)) * NG + g) * NST);
        ore[n] = hr; oim[n] = hi;
    }
}

DI void stage_s5_sample(const Args& a, const Ctx& c, int l, unsigned char* lds_) {
    LAS float* hst = (LAS float*)lds_ + c.wave * 128;
    const bf16* US = wsb(c, WS_US); bf16* YS5 = wsb(c, WS_YS5);
    for (int it = c.gwave; it < NG * (NBS / 2); it += c.gwaves) {
        const int g = it & 31, bsp = it >> 5, n = c.lane;
        const float lre = inptr(I_LRE)[((size_t)l * NG + g) * NST + n], lim = inptr(I_LIM)[((size_t)l * NG + g) * NST + n];
        const float dt = expf(inptr(I_LDT)[l * NG + g]);
        const float mag = expf(lre * dt), ar = mag * cosf(lim * dt), ai = mag * sinf(lim * dt);
        const float den = lre * lre + lim * lim, pr = ar - 1.f;
        const float wre = (pr * lre + ai * lim) / den, wim = (ai * lre - pr * lim) / den;
        float bbr[16], bbi[16];
        { const float4* bre = (const float4*)(inptr(I_BRE) + (((size_t)l * NG + g) * NST + n) * 16); const float4* bim = (const float4*)(inptr(I_BIM) + (((size_t)l * NG + g) * NST + n) * 16);
#pragma unroll
          for (int j = 0; j < 4; ++j) { const float4 r = bre[j], i = bim[j];
              bbr[4 * j] = wre * r.x - wim * i.x; bbi[4 * j] = wre * i.x + wim * r.x; bbr[4 * j + 1] = wre * r.y - wim * i.y; bbi[4 * j + 1] = wre * i.y + wim * r.y;
              bbr[4 * j + 2] = wre * r.z - wim * i.z; bbi[4 * j + 2] = wre * i.z + wim * r.z; bbr[4 * j + 3] = wre * r.w - wim * i.w; bbi[4 * j + 3] = wre * i.w + wim * r.w; } }
        const int hh = c.lane & 15, part = c.lane >> 4;
        float cre[16], cim[16];
        { const float4* pr_ = (const float4*)(inptr(I_CRE) + (((size_t)l * NG + g) * 16 + hh) * NST + part * 16); const float4* pi_ = (const float4*)(inptr(I_CIM) + (((size_t)l * NG + g) * 16 + hh) * NST + part * 16);
#pragma unroll
          for (int i = 0; i < 4; ++i) { const float4 r = pr_[i], m = pi_[i]; cre[4 * i] = r.x; cre[4 * i + 1] = r.y; cre[4 * i + 2] = r.z; cre[4 * i + 3] = r.w; cim[4 * i] = m.x; cim[4 * i + 1] = m.y; cim[4 * i + 2] = m.z; cim[4 * i + 3] = m.w; } }
        const float dsk = inptr(I_S5D)[l * S5W + g * 16 + hh];
#pragma unroll 1
        for (int s2 = 0; s2 < 2; ++s2) {
            const int bs = 2 * bsp + s2;
            float hr = inptr(I_S5RE)[(((size_t)l * NBS + bs) * NG + g) * NST + n], hi = inptr(I_S5IM)[(((size_t)l * NBS + bs) * NG + g) * NST + n];
#pragma unroll
            for (int t = 0; t < SS; ++t) {
                const int row = MP + bs * SS + t;
                const bf16* up = US + (size_t)(row - MP) * 512 + g * 16;
                float u[16];
                { float t0[8], t1[8]; unpk8(*(const uint4*)up, t0); unpk8(*(const uint4*)(up + 8), t1);
#pragma unroll
                  for (int i = 0; i < 8; ++i) { u[i] = t0[i]; u[8 + i] = t1[i]; } }
                float bur = 0.f, bui = 0.f;
#pragma unroll
                for (int j = 0; j < 16; ++j) { bur += bbr[j] * u[j]; bui += bbi[j] * u[j]; }
                const float nr = ar * hr - ai * hi + bur, ni = ar * hi + ai * hr + bui;
                hr = nr; hi = ni;
                hst[2 * n] = hr; hst[2 * n + 1] = hi;
                asm volatile("s_waitcnt lgkmcnt(0)" ::: "memory");
                float y = 0.f;
#pragma unroll
                for (int i = 0; i < 16; ++i) { const float hvx = hst[2 * (part * 16 + i)], hvy = hst[2 * (part * 16 + i) + 1]; y += cre[i] * hvx - cim[i] * hvy; }
                asm volatile("s_waitcnt lgkmcnt(0)" ::: "memory");
                y += __shfl_xor(y, 16); y += __shfl_xor(y, 32);
                y += dsk * bf2f(up[hh]);
                if (c.lane < 16) YS5[(size_t)row * 512 + g * 16 + hh] = (bf16)f2bf(gelu_tanh(y));
            }
            c.out[O_S5RE_S + (((size_t)l * NBS + bs) * NG + g) * NST + n] = hr;
            c.out[O_S5IM_S + (((size_t)l * NBS + bs) * NG + g) * NST + n] = hi;
        }
    }
}

DI void stage_mlstm_ref(const Args& a, const Ctx& c, int l, unsigned char* lds) {
    float* Cs = (float*)lds;
    float* ns = Cs + 256 * 64;
    float* red = ns + 256;
    float* nqr = red + 512;
    const bf16* Q = wsb(c, WS_Q); const bf16* Kb = wsb(c, WS_K); const bf16* V = wsb(c, WS_V);
    const float* LI = wsf(c, WS_LI); const float* LF = wsf(c, WS_LF); float* Hh = wsf(c, WS_H);
    const int v = c.tid & 63, kg = c.tid >> 6;
    const int nitems = (NBP + NBS) * NH * 4;
    for (int it = c.blk; it < nitems; it += c.nblk) {
        const int seq = it >> 4, h = (it >> 2) & 3, vb = it & 3;
        int S, row0; float m = 0.f;
        __syncthreads();
        if (seq < NBP) {
            S = SEQ; row0 = seq * SEQ;
#pragma unroll 4
            for (int kk = 0; kk < 32; ++kk) Cs[(kg * 32 + kk) * 64 + v] = 0.f;
            if (c.tid < 256) ns[c.tid] = 0.f;
        } else {
            const int bs = seq - NBP; S = SS; row0 = MP + bs * SS;
            const float* c0 = inptr(I_MC) + (((size_t)l * NBS + bs) * NH + h) * DH * DH;
#pragma unroll 4
            for (int kk = 0; kk < 32; ++kk) Cs[(kg * 32 + kk) * 64 + v] = c0[(size_t)(kg * 32 + kk) * DH + vb * 64 + v];
            if (c.tid < 256) ns[c.tid] = inptr(I_MN)[(((size_t)l * NBS + bs) * NH + h) * DH + c.tid];
            m = inptr(I_MM)[((size_t)l * NBS + bs) * NH + h];
        }
        __syncthreads();
        for (int t = 0; t < S; ++t) {
            const int row = row0 + t;
            const float li = LI[(size_t)row * 4 + h], lf = LF[(size_t)row * 4 + h];
            const float mn = fmaxf(lf + m, li), fd = __expf(lf + m - mn), iw = __expf(li - mn);
            m = mn;
            const bf16* qp = Q + (size_t)row * 1024 + h * 256; const bf16* kp = Kb + (size_t)row * 1024 + h * 256;
            const float vv = bf2f(V[(size_t)row * 1024 + h * 256 + vb * 64 + v]) * iw;
            float part = 0.f;
#pragma unroll
            for (int q8 = 0; q8 < 4; ++q8) {
                float qf[8], kf[8];
                unpk8(*(const uint4*)(qp + kg * 32 + q8 * 8), qf); unpk8(*(const uint4*)(kp + kg * 32 + q8 * 8), kf);
#pragma unroll
                for (int i = 0; i < 8; ++i) { float* cp = Cs + (kg * 32 + q8 * 8 + i) * 64 + v; const float cn = fd * (*cp) + kf[i] * vv; *cp = cn; part += qf[i] * cn; }
            }
            red[kg * 64 + v] = part;
            if (c.tid < 256) {
                const float nn = fd * ns[c.tid] + iw * bf2f(kp[c.tid]); ns[c.tid] = nn;
                const float pq = wave_sum(bf2f(qp[c.tid]) * nn);
                if (c.lane == 0) nqr[c.wave] = pq;
            }
            __syncthreads();
            if (c.tid < 64) {
                float num = 0.f;
#pragma unroll
                for (int g8 = 0; g8 < 8; ++g8) num += red[g8 * 64 + c.tid];
                const float nq = (nqr[0] + nqr[1]) + (nqr[2] + nqr[3]);
                Hh[(size_t)row * 1024 + h * 256 + vb * 64 + c.tid] = num / fmaxf(fabsf(nq), __expf(-m));
            }
            __syncthreads();
        }
        float* oc = c.out + (seq < NBP ? O_C_P + (((size_t)l * NBP + seq) * NH + h) * DH * DH : O_C_S + (((size_t)l * NBS + (seq - NBP)) * NH + h) * DH * DH);
#pragma unroll 4
        for (int kk = 0; kk < 32; ++kk) oc[(size_t)(kg * 32 + kk) * DH + vb * 64 + v] = Cs[(kg * 32 + kk) * 64 + v];
        if (vb == 0) {
            float* on = c.out + (seq < NBP ? O_N_P + (((size_t)l * NBP + seq) * NH + h) * DH : O_N_S + (((size_t)l * NBS + (seq - NBP)) * NH + h) * DH);
            if (c.tid < 256) on[c.tid] = ns[c.tid];
            if (c.tid == 0) { float* om = c.out + (seq < NBP ? O_M_P + ((size_t)l * NBP + seq) * NH + h : O_M_S + ((size_t)l * NBS + (seq - NBP)) * NH + h); *om = m; }
        }
    }
    __syncthreads();
}

DI void stage_headnorm(const Args& a, const Ctx& c, int l, int row_lo) {
    const float* Hh = wsf(c, WS_H); const bf16* OS = wsb(c, WS_OS); bf16* HM = wsb(c, WS_HM);
    const float* gm = inptr(I_GMH) + (size_t)l * MW;
    for (int it = row_lo * NH + c.gwave; it < M * NH; it += c.gwaves) {
        const int row = it >> 2, h = it & 3; const size_t off = (size_t)row * 1024 + h * 256 + c.lane * 4;
        const float4 x = *(const float4*)(Hh + off);
        const float ss = wave_sum(x.x * x.x + x.y * x.y + x.z * x.z + x.w * x.w);
        const float rs = rsqrtf(ss * (1.f / DH) + EPS);
        const float4 g = *(const float4*)(gm + h * 256 + c.lane * 4);
        const uint2 ow = *(const uint2*)(OS + off);
        uint2 w; w.x = pk2(x.x * rs * g.x * bflo(ow.x), x.y * rs * g.y * bfhi(ow.x)); w.y = pk2(x.z * rs * g.z * bflo(ow.y), x.w * rs * g.w * bfhi(ow.y));
        *(uint2*)(HM + off) = w;
    }
}

DI void stage_final(const Args& a, const Ctx& c, const bf16* XB) {
    const float* ssq = ssq_ptr(c, 16); const float* gf = inptr(I_GFIN);
    for (int row = c.gwave; row < M; row += c.gwaves) {
        const float rstd = rstd_of(ssq, row);
#pragma unroll
        for (int j = 0; j < 2; ++j) {
            const int col = (c.lane + 64 * j) * 8;
            float x[8]; unpk8(*(const uint4*)(XB + (size_t)row * D + col), x);
            const float4 g0 = *(const float4*)(gf + col), g1 = *(const float4*)(gf + col + 4);
            float* o = c.out + O_Y + (size_t)row * D + col;
            *(float4*)o = make_float4(x[0] * rstd * g0.x, x[1] * rstd * g0.y, x[2] * rstd * g0.z, x[3] * rstd * g0.w);
            *(float4*)(o + 4) = make_float4(x[4] * rstd * g1.x, x[5] * rstd * g1.y, x[6] * rstd * g1.z, x[7] * rstd * g1.w);
        }
    }
}

DI void stage_ssq(const Ctx& c, float* ssq_out, const bf16* XB) {
    for (int row = c.gwave; row < M; row += c.gwaves) {
        float s = 0.f;
#pragma unroll
        for (int j = 0; j < 2; ++j) { float x[8]; unpk8(*(const uint4*)(XB + (size_t)row * D + (c.lane + 64 * j) * 8), x);
#pragma unroll
            for (int i = 0; i < 8; ++i) s += x[i] * x[i]; }
        s = wave_sum(s);
        if (c.lane < 16) ssq_out[(size_t)row * 16 + c.lane] = c.lane == 0 ? s : 0.f;
    }
}

template <class F> struct EpiA {
    static constexpr bool PERM = true, AFTER_DRAIN = false;
    F f; float* ssq_part;
    LAS float* rc;
    DI void operator()(const pg8::f32x4 (&acc)[2][2][4][2], const pg8::Unit& u, int wr, int wc, int fr, int fq, int ui) const {
        float rsv[8];
        if (F::NEEDS_RS) {
            bool hit = false;
            if (ui != 0) { const int tg = ((const LAS int*)rc)[256]; hit = (tg & 0xffff) == u.pm && (tg >> 16) <= ui; }
            if (hit) {
#pragma unroll
                for (int i = 0; i < 8; ++i) rsv[i] = rc[(i >> 2) * 128 + wr * 64 + (i & 3) * 16 + fr];
            } else {
                const float* P = f.ssq_src(); pg8::f32x4 q[8];
#pragma unroll
                for (int i = 0; i < 8; ++i) q[i] = *(const pg8::f32x4*)(P + (size_t)(u.pm * 256 + (i >> 2) * 128 + wr * 64 + (i & 3) * 16 + fr) * 16 + 4 * fq);
#pragma unroll
                for (int i = 0; i < 8; ++i) { float t = (q[i][0] + q[i][1]) + (q[i][2] + q[i][3]); t += __shfl_xor(t, 16); t += __shfl_xor(t, 32); rsv[i] = rsqrtf(t * (1.f / D) + EPS); }
                if (wc == 0 && fq == 0) {
#pragma unroll
                    for (int i = 0; i < 8; ++i) rc[(i >> 2) * 128 + wr * 64 + (i & 3) * 16 + fr] = rsv[i];
                    if (wr == 0 && fr == 0) ((LAS int*)rc)[256] = u.pm | ((ui + 1) << 16);
                }
            }
        } else {
#pragma unroll
            for (int i = 0; i < 8; ++i) rsv[i] = 0.f;
        }
        constexpr int NC = F::PAIRED ? 8 : 16;
        constexpr int PD = sizeof(typename F::PF) <= 4 ? 1 : (sizeof(typename F::PF) <= 16 ? 8 : 4);
        const int colb = F::PAIRED ? (u.pn * 128 + wc * 32 + 8 * fq) : (u.pn * 256 + wc * 32 + 8 * fq);
        typename F::PF ring[PD];
#pragma unroll
        for (int q = 0; q < PD && q < NC; ++q) {
            const int g8n = F::PAIRED ? q : (q >> 1), bjn = F::PAIRED ? 0 : (q & 1);
            int rown = u.pm * 256 + (g8n >> 2) * 128 + wr * 64 + (g8n & 3) * 16 + fr; asm volatile("" : "+v"(rown)); ring[q] = f.load(rown, colb + bjn * 128);
        }
        float srow = 0.f;
#pragma unroll
        for (int q = 0; q < NC; ++q) {
            const int g8 = F::PAIRED ? q : (q >> 1), bj = F::PAIRED ? 0 : (q & 1), ai = g8 >> 2, m = g8 & 3;
            int row = u.pm * 256 + ai * 128 + wr * 64 + m * 16 + fr; asm volatile("" : "+v"(row));
            const typename F::PF pf = ring[q % PD];
            if (q + PD < NC) { const int g8n = F::PAIRED ? (q + PD) : ((q + PD) >> 1), bjn = F::PAIRED ? 0 : ((q + PD) & 1);
                               int rown = u.pm * 256 + (g8n >> 2) * 128 + wr * 64 + (g8n & 3) * 16 + fr; asm volatile("" : "+v"(rown)); ring[q % PD] = f.load(rown, colb + bjn * 128); }
            const float rs = rsv[g8];
            float s;
            if (F::PAIRED) {
                const float a[8] = {acc[ai][0][m][0][0], acc[ai][0][m][0][1], acc[ai][0][m][0][2], acc[ai][0][m][0][3], acc[ai][0][m][1][0], acc[ai][0][m][1][1], acc[ai][0][m][1][2], acc[ai][0][m][1][3]};
                const float b[8] = {acc[ai][1][m][0][0], acc[ai][1][m][0][1], acc[ai][1][m][0][2], acc[ai][1][m][0][3], acc[ai][1][m][1][0], acc[ai][1][m][1][1], acc[ai][1][m][1][2], acc[ai][1][m][1][3]};
                s = f(row, colb, a, b, rs, pf);
            } else {
                const float a[8] = {acc[ai][bj][m][0][0], acc[ai][bj][m][0][1], acc[ai][bj][m][0][2], acc[ai][bj][m][0][3], acc[ai][bj][m][1][0], acc[ai][bj][m][1][1], acc[ai][bj][m][1][2], acc[ai][bj][m][1][3]};
                s = f(row, colb + bj * 128, a, a, rs, pf);
            }
            srow = (F::PAIRED || bj == 0) ? s : srow + s;
            if (ssq_part && (F::PAIRED || bj == 1)) { float t = srow; t += __shfl_xor(t, 16); t += __shfl_xor(t, 32); if (fq == 0) ssq_part[(size_t)row * 16 + u.pn * 4 + wc] = t; }
            asm volatile("" ::: "memory");
        }
    }
};
template <class F>
DI void gemm_fast(const Ctx& c, unsigned char* lds, const bf16* A, int lda, const bf16* Bt, int ldb, int Mrows, int Nbt, int K, const F& f, float* ssq_part) {
    pg8::Gemm g{A, Bt, Mrows, Nbt, K, lda, ldb};
    pg8::StaticOrder S; S.init(Mrows, Nbt, c.nblk, c.blk);
    EpiA<F> E{f, ssq_part, (LAS float*)((LAS unsigned char*)lds + pg8::STAGE_BYTES)};
    pg8::gemm_phase<EpiA<F>, pg8::StaticOrder, GEMM_ALIGN, true>((PG8_LAS unsigned char*)lds, g, S, E, c.tid);
}

template <class F, int WR, int TR, int WC, int KS>
DI void gemm_thin(const Ctx& c, unsigned char* lds_, const bf16* A, int lda, const bf16* Bt, int ldb, int Ncols, int K, const F& f, float* ssq_part) {
    static_assert(WR * WC * KS == 8, "eight waves");
    constexpr int NB = F::PAIRED ? 4 : 2, UR = WR * TR * 16, UC = WC * 32, UB = F::PAIRED ? 2 * UC : UC, RT = UR + UB, NRB = MS / UR, NI = RT * 32 / NTHR, TP = 528;
    static_assert(RT * 32 % NTHR == 0 && RT * TP + 8192 + 1024 <= MISC_OFF, "thin GEMM LDS map");
    LAS unsigned char* lds = (LAS unsigned char*)lds_;
    LAS unsigned char* sA = lds; LAS unsigned char* sB = lds + UR * TP;
    LAS pg8::f32x4* red = (LAS pg8::f32x4*)(lds + RT * TP);
    LAS float* ssqr = (LAS float*)(lds + RT * TP + 8192);
    const int tid = c.tid, lane = c.lane, l15 = lane & 15, q4 = lane >> 4, w = c.wave, wc = w % WC, wr = (w / WC) % WR, ks = w / (WC * WR), wg = w % (WC * WR);
    const int ncb = Ncols / UC, nch = K >> 8;
    const int upx = (NRB * ncb) >> 3, xcd = c.blk & 7, bpx = c.nblk >> 3;
    for (int ui = c.blk >> 3; ui < upx; ui += bpx) {
        const int u = xcd * upx + ui;
        const int rb = u % NRB, cb = u / NRB, r0u = rb * UR, c0u = cb * UC;
        const bf16* src[NI];
#pragma unroll
        for (int i = 0; i < NI; ++i) {
            const int it = tid + NTHR * i, row = it >> 5, seg = it & 31;
            if (row < UR) src[i] = A + (size_t)(r0u + row) * lda + seg * 8;
            else { const int j = row - UR; int brow;
                   if (F::PAIRED) brow = (c0u >> 7) * 256 + (c0u & 127) + (j < UC ? j : 128 + (j - UC)); else brow = c0u + j;
                   src[i] = Bt + (size_t)brow * ldb + seg * 8; }
        }
        uint4 pre[NI];
#pragma unroll
        for (int i = 0; i < NI; ++i) pre[i] = *(const uint4*)(src[i]);
        pg8::f32x4 acc[TR][NB];
#pragma unroll
        for (int tr = 0; tr < TR; ++tr)
#pragma unroll
            for (int n = 0; n < NB; ++n) acc[tr][n] = (pg8::f32x4){0.f, 0.f, 0.f, 0.f};
        float prv[TR]; typename F::PF pfv[TR];
#pragma unroll
        for (int tr = 0; tr < TR; ++tr) { const int row = MP + r0u + wr * TR * 16 + tr * 16 + l15, col = c0u + wc * 32 + 8 * q4; prv[tr] = f.pre(row); pfv[tr] = f.load(row, col); }
        for (int kc = 0; kc < nch; ++kc) {
            lds_sync();
#pragma unroll
            for (int i = 0; i < NI; ++i) { const int it = tid + NTHR * i; *(LAS u32x4t*)(lds + (it >> 5) * TP + (it & 31) * 16) = (u32x4t){pre[i].x, pre[i].y, pre[i].z, pre[i].w}; }
            lds_sync();
            if (kc + 1 < nch) {
#pragma unroll
                for (int i = 0; i < NI; ++i) pre[i] = *(const uint4*)(src[i] + (kc + 1) * 256);
            }
#pragma unroll
            for (int kk = 0; kk < 8 / KS; ++kk) {
                const int kof = ((ks * (8 / KS) + kk) * 32 + 8 * q4) * 2;
                pg8::bf16x8 av[TR], bv[NB];
#pragma unroll
                for (int tr = 0; tr < TR; ++tr) av[tr] = *(const LAS pg8::bf16x8*)(sA + (wr * TR * 16 + tr * 16 + l15) * TP + kof);
#pragma unroll
                for (int n = 0; n < NB; ++n) bv[n] = *(const LAS pg8::bf16x8*)(sB + (wc * 32 + 8 * (l15 >> 2) + 4 * (n & 1) + (l15 & 3) + (n >> 1) * UC) * TP + kof);
#pragma unroll
                for (int tr = 0; tr < TR; ++tr)
#pragma unroll
                    for (int n = 0; n < NB; ++n) acc[tr][n] = __builtin_amdgcn_mfma_f32_16x16x32_bf16(bv[n], av[tr], acc[tr][n], 0, 0, 0);
            }
        }
        const int r0 = r0u + wr * TR * 16, c0 = c0u + wc * 32;
        if (KS > 1) {
            lds_sync();
            if (ks > 0) {
#pragma unroll
                for (int tr = 0; tr < TR; ++tr)
#pragma unroll
                    for (int n = 0; n < NB; ++n) red[(((ks - 1) * (WR * WC) + wg) * (TR * NB) + tr * NB + n) * 64 + lane] = acc[tr][n];
            }
            lds_sync();
            if (ks == 0) {
#pragma unroll
                for (int kk = 1; kk < KS; ++kk)
#pragma unroll
                    for (int tr = 0; tr < TR; ++tr)
#pragma unroll
                        for (int n = 0; n < NB; ++n) acc[tr][n] += red[(((kk - 1) * (WR * WC) + wg) * (TR * NB) + tr * NB + n) * 64 + lane];
            }
        }
        float ssv[TR];
#pragma unroll
        for (int tr = 0; tr < TR; ++tr) {
            ssv[tr] = 0.f;
            if (ks == 0) {
                const int row = MP + r0 + tr * 16 + l15, col = c0 + 8 * q4;
                const float a8[8] = {acc[tr][0][0], acc[tr][0][1], acc[tr][0][2], acc[tr][0][3], acc[tr][1][0], acc[tr][1][1], acc[tr][1][2], acc[tr][1][3]};
                if (F::PAIRED) { const float b8[8] = {acc[tr][NB - 2][0], acc[tr][NB - 2][1], acc[tr][NB - 2][2], acc[tr][NB - 2][3], acc[tr][NB - 1][0], acc[tr][NB - 1][1], acc[tr][NB - 1][2], acc[tr][NB - 1][3]}; ssv[tr] = f(row, col, a8, b8, prv[tr], pfv[tr]); }
                else ssv[tr] = f(row, col, a8, a8, prv[tr], pfv[tr]);
            }
        }
        if (ssq_part) {
            lds_sync();
#pragma unroll
            for (int tr = 0; tr < TR; ++tr) { float s = ssv[tr]; s += __shfl_xor(s, 16); s += __shfl_xor(s, 32); if (ks == 0 && q4 == 0) ssqr[wc * UR + wr * TR * 16 + tr * 16 + l15] = s; }
            lds_sync();
            if (c.tid < UR) ssq_part[(size_t)(MP + rb * UR + c.tid) * 16 + cb] = ssqr[c.tid] + ssqr[UR + c.tid];
        }
    }
}
typedef short s16x4 __attribute__((ext_vector_type(4)));
using pg8::bf16x8; using pg8::f32x4;
constexpr int PT = 528, PHB = 272;
constexpr int L_Q = 0, L_P = 0, L_VH = 35840, L_K = 71680, L_F = 139264;
constexpr int F_AL = 0, F_PM = 128, F_BT = 256, F_QN = 384, F_NQP = 512, F_SUM = 1024  , F_NP = 1056, F_SSP = 1312, F_END = 1824;
static_assert(L_P + 128 * PHB <= L_VH && L_VH + 128 * PHB <= L_K && L_K + 128 * PT <= L_F && L_F + F_END * 4 <= MISC_OFF, "mLSTM LDS map");
constexpr size_t UNIT_E = 65536;

#define MFMA16(a, b, c) __builtin_amdgcn_mfma_f32_16x16x32_bf16((a), (b), (c), 0, 0, 0)
#define TR_2F(o, a, P4) asm volatile("ds_read_b64_tr_b16 %0, %4\n\tds_read_b64_tr_b16 %1, %4 offset:" #P4 "\n\tds_read_b64_tr_b16 %2, %4 offset:32\n\tds_read_b64_tr_b16 %3, %4 offset:32+" #P4 "\n\ts_waitcnt lgkmcnt(0)" \
    : "=&v"(o[0]), "=&v"(o[1]), "=&v"(o[2]), "=&v"(o[3]) : "v"(a) : "memory")
#define TR_4F(o, a, P4) asm volatile("ds_read_b64_tr_b16 %0, %8\n\tds_read_b64_tr_b16 %1, %8 offset:" #P4 "\n\tds_read_b64_tr_b16 %2, %8 offset:32\n\tds_read_b64_tr_b16 %3, %8 offset:32+" #P4 "\n\t" \
    "ds_read_b64_tr_b16 %4, %8 offset:64\n\tds_read_b64_tr_b16 %5, %8 offset:64+" #P4 "\n\tds_read_b64_tr_b16 %6, %8 offset:96\n\tds_read_b64_tr_b16 %7, %8 offset:96+" #P4 "\n\ts_waitcnt lgkmcnt(0)" \
    : "=&v"(o[0]), "=&v"(o[1]), "=&v"(o[2]), "=&v"(o[3]), "=&v"(o[4]), "=&v"(o[5]), "=&v"(o[6]), "=&v"(o[7]) : "v"(a) : "memory")
typedef unsigned u32x4n __attribute__((ext_vector_type(4)));
typedef unsigned u32x2n __attribute__((ext_vector_type(2)));
DI uint4 lds_ld16(const LAS unsigned char* p) { const u32x4n v = *(const LAS u32x4n*)p; return make_uint4(v[0], v[1], v[2], v[3]); }
DI void lds_st16(LAS unsigned char* p, uint4 v) { *(LAS u32x4n*)p = (u32x4n){v.x, v.y, v.z, v.w}; }
DI void lds_st8(LAS unsigned char* p, uint2 v) { *(LAS u32x2n*)p = (u32x2n){v.x, v.y}; }
DI f32x4 lds_ldf4(const LAS float* p) { return *(const LAS f32x4*)p; }
DI void lds_stf4(LAS float* p, float4 v) { *(LAS f32x4*)p = (f32x4){v.x, v.y, v.z, v.w}; }
DI bf16x8 cat8(s16x4 lo, s16x4 hi) { return __builtin_shufflevector(lo, hi, 0, 1, 2, 3, 4, 5, 6, 7); }

DI void load_tile(LAS unsigned char* lds, int lbase, int lpitch, const bf16* g, int gpitch, int rows, int lgc, int tid) {
    const int total = rows << lgc;
    for (int idx = tid; idx < total; idx += NTHR) {
        const int r = idx >> lgc, chn = idx & ((1 << lgc) - 1);
        const uint4 v = *(const uint4*)(g + (size_t)r * gpitch + chn * 8);
        lds_st16(lds + lbase + r * lpitch + chn * 16, v);
    }
}
template <int NI> DI void tile_fetch(uint4 (&r)[NI], const bf16* g, int gpitch, int lgc, int tid) {
#pragma unroll
    for (int i = 0; i < NI; ++i) { const int idx = tid + NTHR * i, rr = idx >> lgc, chn = idx & ((1 << lgc) - 1); r[i] = *(const uint4*)(g + (size_t)rr * gpitch + chn * 8); }
}
template <int NI> DI void tile_store(LAS unsigned char* lds, int lbase, int lpitch, const uint4 (&r)[NI], int lgc, int tid) {
#pragma unroll
    for (int i = 0; i < NI; ++i) { const int idx = tid + NTHR * i, rr = idx >> lgc, chn = idx & ((1 << lgc) - 1); lds_st16(lds + lbase + rr * lpitch + chn * 16, r[i]); }
}
DI void gate_part1(const float* LI, const float* LF, int seq_row0, int h, int ch, LAS float* F, int lane, int wave) {
#pragma unroll
    for (int rep = 0; rep < 2; ++rep) {
        const int cc = wave + 8 * rep;
        if (cc <= ch) {
            const size_t r0 = (size_t)(seq_row0 + cc * 128 + 2 * lane);
            const float lf0 = LF[r0 * 4 + h], lf1 = LF[(r0 + 1) * 4 + h], li0 = LI[r0 * 4 + h], li1 = LI[(r0 + 1) * 4 + h];
            const float ps = lf0 + lf1; float incl = ps;
#pragma unroll
            for (int o = 1; o < 64; o <<= 1) { const float t = __shfl_up(incl, o); if (lane >= o) incl += t; }
            const float b0 = (incl - ps) + lf0, b1 = incl;
            const float a0 = li0 - b0, a1 = li1 - b1;
            float cm = fmaxf(a0, a1);
#pragma unroll
            for (int o = 1; o < 64; o <<= 1) { const float t = __shfl_up(cm, o); if (lane >= o) cm = fmaxf(cm, t); }
            if (lane == 63) { F[F_SUM + 2 * cc] = incl; F[F_SUM + 2 * cc + 1] = cm; }
            if (cc == ch) {
                float prev = __shfl_up(cm, 1); if (lane == 0) prev = -3.0e38f;
                F[F_AL + 2 * lane] = a0; F[F_AL + 2 * lane + 1] = a1;
                F[F_PM + 2 * lane] = fmaxf(prev, a0); F[F_PM + 2 * lane + 1] = cm;
                F[F_BT + 2 * lane] = b0; F[F_BT + 2 * lane + 1] = b1;
            }
        }
    }
}
DI float gate_mprev(const LAS float* F, int ch) {
    float m = 0.f;
    for (int cc = 0; cc < ch; ++cc) m = F[F_SUM + 2 * cc] + fmaxf(m, F[F_SUM + 2 * cc + 1]);
    return m;
}

template <int PM>
DI void mlstm_A_unit(const Ctx& c, unsigned char* lds_, int u) {
    LAS unsigned char* lds = (LAS unsigned char*)lds_;
    LAS float* F = (LAS float*)(lds + L_F);
    const unsigned ldsb = (unsigned)(size_t)lds_;
    const int b = u >> 6, h = (u >> 4) & 3, ch = u & 15, row0 = b * SEQ + ch * 128;
    const int tid = c.tid, lane = c.lane, wr = c.wave >> 2, wc = c.wave & 3, l15 = lane & 15, q4 = lane >> 4;
    const bf16* Qg = wsb(c, WS_Q) + (size_t)row0 * 1024 + h * 256; const bf16* Kg = wsb(c, WS_K) + (size_t)row0 * 1024 + h * 256; const bf16* Vg = wsb(c, WS_V) + (size_t)row0 * 1024 + h * 256;
    { uint4 tq[8], tk[8];
      tile_fetch<8>(tq, Qg, 1024, 5, tid); tile_fetch<8>(tk, Kg, 1024, 5, tid);
      tile_store<8>(lds, L_Q, PT, tq, 5, tid); tile_store<8>(lds, L_K, PT, tk, 5, tid); }
    uint4 vpre[4]; tile_fetch<4>(vpre, Vg, 1024, 4, tid);
    gate_part1(wsf(c, WS_LI), wsf(c, WS_LF), b * SEQ, h, ch, F, lane, c.wave);
    lds_sync();
    const float mprev = gate_mprev(F, ch), pml = fmaxf(mprev, F[F_SUM + 2 * ch + 1]), blast = F[F_SUM + 2 * ch];
    f32x4 acc[2][4];
#pragma unroll
    for (int si = 0; si < 2; ++si)
#pragma unroll
        for (int ti = 0; ti < 4; ++ti) acc[si][ti] = (f32x4){0.f, 0.f, 0.f, 0.f};
#pragma unroll 4
    for (int ks = 0; ks < 8; ++ks) {
        bf16x8 a[2], bq[4];
#pragma unroll
        for (int si = 0; si < 2; ++si) a[si] = *(const LAS bf16x8*)(lds + L_K + (32 * wc + 16 * si + l15) * PT + (32 * ks + 8 * q4) * 2);
#pragma unroll
        for (int ti = 0; ti < 4; ++ti) bq[ti] = *(const LAS bf16x8*)(lds + L_Q + (64 * wr + 16 * ti + l15) * PT + (32 * ks + 8 * q4) * 2);
#pragma unroll
        for (int si = 0; si < 2; ++si)
#pragma unroll
            for (int ti = 0; ti < 4; ++ti) acc[si][ti] = MFMA16(a[si], bq[ti], acc[si][ti]);
    }
    uint2 pp[2][4];
#pragma unroll
    for (int ti = 0; ti < 4; ++ti) {
        const int t = 64 * wr + 16 * ti + l15; const float pmt = fmaxf(mprev, F[F_PM + t]); float nqs = 0.f;
#pragma unroll
        for (int si = 0; si < 2; ++si) {
            const int s0 = 32 * wc + 16 * si + 4 * q4;
            const f32x4 al4 = lds_ldf4(F + F_AL + s0); const float4 al = make_float4(al4[0], al4[1], al4[2], al4[3]);
            const float p0 = (s0 + 0 <= t) ? acc[si][ti][0] * __expf(al.x - pmt) : 0.f;
            const float p1 = (s0 + 1 <= t) ? acc[si][ti][1] * __expf(al.y - pmt) : 0.f;
            const float p2 = (s0 + 2 <= t) ? acc[si][ti][2] * __expf(al.z - pmt) : 0.f;
            const float p3 = (s0 + 3 <= t) ? acc[si][ti][3] * __expf(al.w - pmt) : 0.f;
            nqs += (p0 + p1) + (p2 + p3);
            pp[si][ti].x = pk2(p0, p1); pp[si][ti].y = pk2(p2, p3);
        }
        nqs += __shfl_xor(nqs, 16); nqs += __shfl_xor(nqs, 32);
        if (q4 == 0) F[F_NQP + t * 4 + wc] = nqs;
    }
    lds_sync();
#pragma unroll
    for (int ti = 0; ti < 4; ++ti)
#pragma unroll
        for (int si = 0; si < 2; ++si) lds_st8(lds + L_P + (64 * wr + 16 * ti + l15) * PHB + (32 * wc + 16 * si + 4 * q4) * 2, pp[si][ti]);
    {
        const int s = tid >> 2, seg = tid & 3; const float wk = __expf(F[F_AL + s] - pml);
#pragma unroll
        for (int j = 0; j < 8; ++j) {
            LAS unsigned char* p = lds + L_K + s * PT + (seg * 64 + j * 8) * 2;
            float x[8]; unpk8(lds_ld16(p), x);
#pragma unroll
            for (int i = 0; i < 8; ++i) x[i] *= wk;
            lds_st16(p, pk8(x));
        }
    }
    tile_store<4>(lds, L_VH, PHB, vpre, 4, tid);
    tile_fetch<4>(vpre, Vg + 128, 1024, 4, tid);
    lds_sync();
    if (PM & 2) {
    if (tid < 128) wsf(c, WS_NQI)[(size_t)(row0 + tid) * 4 + h] = (F[F_NQP + tid * 4 + 0] + F[F_NQP + tid * 4 + 1]) + (F[F_NQP + tid * 4 + 2] + F[F_NQP + tid * 4 + 3]);
    if (tid < 256) {
        float s = 0.f;
#pragma unroll 8
        for (int r = 0; r < 128; ++r) s += bf2f(*(const LAS bf16*)(lds + L_K + r * PT + tid * 2));
        wsf(c, WS_DN)[(size_t)u * 256 + tid] = s;
    }
    if (tid == 0) { wsf(c, WS_DEC)[u] = __expf(mprev - pml); wsf(c, WS_MNEW)[u] = blast + pml; }
    }
    bf16* NI = wsb(c, WS_NI); bf16* DCT = wsb(c, WS_DCT) + (size_t)u * UNIT_E;
    for (int half = 0; half < 2; ++half) {
        if (half) { lds_sync(); tile_store<4>(lds, L_VH, PHB, vpre, 4, tid); lds_sync(); }
        if (PM & 4) {
            f32x4 a2[2][4];
#pragma unroll
            for (int vi = 0; vi < 2; ++vi)
#pragma unroll
                for (int ti = 0; ti < 4; ++ti) a2[vi][ti] = (f32x4){0.f, 0.f, 0.f, 0.f};
#pragma unroll
            for (int ks = 0; ks < 4; ++ks) {
                s16x4 o[4]; const unsigned va = ldsb + L_VH + (32 * ks + 8 * q4 + (l15 >> 2)) * PHB + (32 * wc + 4 * (lane & 3)) * 2;
                TR_2F(o, va, 1088);
                const bf16x8 av0 = cat8(o[0], o[1]), av1 = cat8(o[2], o[3]);
                bf16x8 bp[4];
#pragma unroll
                for (int ti = 0; ti < 4; ++ti) bp[ti] = *(const LAS bf16x8*)(lds + L_P + (64 * wr + 16 * ti + l15) * PHB + (32 * ks + 8 * q4) * 2);
#pragma unroll
                for (int ti = 0; ti < 4; ++ti) { a2[0][ti] = MFMA16(av0, bp[ti], a2[0][ti]); a2[1][ti] = MFMA16(av1, bp[ti], a2[1][ti]); }
            }
#pragma unroll
            for (int ti = 0; ti < 4; ++ti)
#pragma unroll
                for (int vi = 0; vi < 2; ++vi)
                    { uint2 w2; w2.x = pk2(a2[vi][ti][0], a2[vi][ti][1]); w2.y = pk2(a2[vi][ti][2], a2[vi][ti][3]); if (PM & 8) *(uint2*)(NI + (size_t)(row0 + 64 * wr + 16 * ti + l15) * 1024 + h * 256 + 128 * half + 32 * wc + 16 * vi + 4 * q4) = w2; else if (w2.x == 0x12345678u) NI[0] = (bf16)w2.y; }
        }
        if (PM & 16) {
            f32x4 a3[4][4];
#pragma unroll
            for (int ki = 0; ki < 4; ++ki)
#pragma unroll
                for (int vi = 0; vi < 4; ++vi) a3[ki][vi] = (f32x4){0.f, 0.f, 0.f, 0.f};
#pragma unroll
            for (int ks = 0; ks < 4; ++ks) {
                s16x4 ok[8], ov[8];
                const unsigned ka = ldsb + L_K + (32 * ks + 8 * q4 + (l15 >> 2)) * PT + (64 * wc + 4 * (lane & 3)) * 2;
                const unsigned va = ldsb + L_VH + (32 * ks + 8 * q4 + (l15 >> 2)) * PHB + (64 * wr + 4 * (lane & 3)) * 2;
                TR_4F(ok, ka, 2112); TR_4F(ov, va, 1088);
#pragma unroll
                for (int ki = 0; ki < 4; ++ki)
#pragma unroll
                    for (int vi = 0; vi < 4; ++vi) a3[ki][vi] = MFMA16(cat8(ok[2 * ki], ok[2 * ki + 1]), cat8(ov[2 * vi], ov[2 * vi + 1]), a3[ki][vi]);
            }
#pragma unroll
            for (int vi = 0; vi < 4; ++vi)
#pragma unroll
                for (int ki = 0; ki < 4; ++ki) {
                    uint2 w; w.x = pk2(a3[ki][vi][0], a3[ki][vi][1]); w.y = pk2(a3[ki][vi][2], a3[ki][vi][3]);
                    if (PM & 32) *(uint2*)(DCT + (size_t)(128 * half + 64 * wr + 16 * vi + l15) * 256 + 64 * wc + 16 * ki + 4 * q4) = w; else if (w.x == 0x12345678u) DCT[0] = (bf16)w.y;
                }
        }
    }
    lds_sync();
}

DI void mlstm_B(const Ctx& c, int l, unsigned char* lds_) {
    const bf16* __restrict__ DCT = wsb(c, WS_DCT); bf16* __restrict__ CTP = wsb(c, WS_CTP); const float* __restrict__ DEC = wsf(c, WS_DEC);
    LAS float* T = (LAS float*)lds_;
    for (int it = c.blk; it < 32 * 8; it += c.nblk) {
        const int bh = it >> 3, vb = it & 7, v = c.tid >> 4, k0 = (c.tid & 15) * 16;
        const size_t e = (size_t)(vb * 32 + v) * 256 + k0;
        float C[16];
#pragma unroll
        for (int i = 0; i < 16; ++i) C[i] = 0.f;
#pragma unroll 1
        for (int c4 = 0; c4 < 16; c4 += 4) {
        uint4 dd[4][2]; float dc[4];
#pragma unroll
        for (int j = 0; j < 4; ++j) { const size_t u = (size_t)bh * 16 + c4 + j; dd[j][0] = *(const uint4*)(DCT + u * UNIT_E + e); dd[j][1] = *(const uint4*)(DCT + u * UNIT_E + e + 8); dc[j] = DEC[u]; }
#pragma unroll
        for (int j = 0; j < 4; ++j) {
            const size_t u = (size_t)bh * 16 + c4 + j;
            { float lo[8], hi[8];
#pragma unroll
              for (int i = 0; i < 8; ++i) { lo[i] = C[i]; hi[i] = C[8 + i]; }
              *(uint4*)(CTP + u * UNIT_E + e) = pk8(lo); *(uint4*)(CTP + u * UNIT_E + e + 8) = pk8(hi); }
            const float dec = dc[j]; float d0[8], d1[8]; unpk8(dd[j][0], d0); unpk8(dd[j][1], d1);
#pragma unroll
            for (int i = 0; i < 8; ++i) { C[i] = dec * C[i] + d0[i]; C[8 + i] = dec * C[8 + i] + d1[i]; }
        }
        }
        lds_sync();
#pragma unroll
        for (int i = 0; i < 16; ++i) T[v * 257 + k0 + i] = C[i];
        lds_sync();
        float* oc = c.out + O_C_P + ((size_t)l * NBP * NH + bh) * UNIT_E + vb * 32;
        {
            const int k = c.tid >> 1, vh = (c.tid & 1) * 16;
#pragma unroll
            for (int q = 0; q < 4; ++q) *(float4*)(oc + (size_t)k * 256 + vh + 4 * q) = make_float4(T[(vh + 4 * q) * 257 + k], T[(vh + 4 * q + 1) * 257 + k], T[(vh + 4 * q + 2) * 257 + k], T[(vh + 4 * q + 3) * 257 + k]);
        }
    }
    const float* DN = wsf(c, WS_DN); float* NPv = wsf(c, WS_NP);
    for (int it = c.gtid; it < 32 * 256; it += c.gthreads) {
        const int bh = it >> 8, k = it & 255; float n = 0.f;
        float dnv[16], dcv[16];
#pragma unroll
        for (int ch = 0; ch < 16; ++ch) { const size_t u = (size_t)bh * 16 + ch; dnv[ch] = DN[u * 256 + k]; dcv[ch] = DEC[u]; }
#pragma unroll
        for (int ch = 0; ch < 16; ++ch) { const size_t u = (size_t)bh * 16 + ch; NPv[u * 256 + k] = n; n = dcv[ch] * n + dnv[ch]; }
        c.out[O_N_P + ((size_t)l * NBP * NH + bh) * DH + k] = n;
        if (k == 0) c.out[O_M_P + (size_t)l * NBP * NH + bh] = wsf(c, WS_MNEW)[(size_t)bh * 16 + 15];
    }
    lds_sync();
}

DI void mlstm_C_unit(const Ctx& c, unsigned char* lds_, int u, const float* gmh) {
    LAS unsigned char* lds = (LAS unsigned char*)lds_;
    LAS float* F = (LAS float*)(lds + L_F);
    const int b = u >> 6, h = (u >> 4) & 3, ch = u & 15, row0 = b * SEQ + ch * 128;
    const int tid = c.tid, lane = c.lane, wr = c.wave >> 2, wc = c.wave & 3, l15 = lane & 15, q4 = lane >> 4;
    const bf16* Qg = wsb(c, WS_Q) + (size_t)row0 * 1024 + h * 256; const bf16* CT = wsb(c, WS_CTP) + (size_t)u * UNIT_E;
    { uint4 tq[8], tk[8];
      tile_fetch<8>(tq, Qg, 1024, 5, tid); tile_fetch<8>(tk, CT, 256, 5, tid);
      tile_store<8>(lds, L_Q, PT, tq, 5, tid); tile_store<8>(lds, L_K, PT, tk, 5, tid); }
    if (tid < 256) F[F_NP + tid] = wsf(c, WS_NP)[(size_t)u * 256 + tid];
    gate_part1(wsf(c, WS_LI), wsf(c, WS_LF), b * SEQ, h, ch, F, lane, c.wave);
    lds_sync();
    const float mprev = gate_mprev(F, ch);
    uint4 cpre[8]; tile_fetch<8>(cpre, CT + 128 * 256, 256, 5, tid);
    {
        const int t = tid >> 2, kq = tid & 3; float s = 0.f;
#pragma unroll
        for (int j = 0; j < 8; ++j) {
            float x[8]; unpk8(lds_ld16(lds + L_Q + t * PT + (kq * 64 + j * 8) * 2), x);
#pragma unroll
            for (int i = 0; i < 8; ++i) s += x[i] * F[F_NP + kq * 64 + j * 8 + i];
        }
        s += __shfl_xor(s, 1); s += __shfl_xor(s, 2);
        if (kq == 0) F[F_QN + t] = s;
    }
    uint2 nip[2][2][4];
    { const bf16* NIp = wsb(c, WS_NI);
#pragma unroll
      for (int ti = 0; ti < 4; ++ti)
#pragma unroll
          for (int hf = 0; hf < 2; ++hf)
#pragma unroll
              for (int vi = 0; vi < 2; ++vi) nip[hf][vi][ti] = *(const uint2*)(NIp + (size_t)(row0 + 64 * wr + 16 * ti + l15) * 1024 + h * 256 + 128 * hf + 32 * wc + 16 * vi + 4 * q4); }
    f32x4 acc[2][2][4];
#pragma unroll
    for (int hf = 0; hf < 2; ++hf)
#pragma unroll
        for (int vi = 0; vi < 2; ++vi)
#pragma unroll
            for (int ti = 0; ti < 4; ++ti) acc[hf][vi][ti] = (f32x4){0.f, 0.f, 0.f, 0.f};
#pragma unroll
    for (int hf = 0; hf < 2; ++hf) {
        if (hf) { lds_sync(); tile_store<8>(lds, L_K, PT, cpre, 5, tid); lds_sync(); }
#pragma unroll 4
        for (int ks = 0; ks < 8; ++ks) {
            bf16x8 a[2], bq[4];
#pragma unroll
            for (int vi = 0; vi < 2; ++vi) a[vi] = *(const LAS bf16x8*)(lds + L_K + (32 * wc + 16 * vi + l15) * PT + (32 * ks + 8 * q4) * 2);
#pragma unroll
            for (int ti = 0; ti < 4; ++ti) bq[ti] = *(const LAS bf16x8*)(lds + L_Q + (64 * wr + 16 * ti + l15) * PT + (32 * ks + 8 * q4) * 2);
#pragma unroll
            for (int vi = 0; vi < 2; ++vi)
#pragma unroll
                for (int ti = 0; ti < 4; ++ti) acc[hf][vi][ti] = MFMA16(a[vi], bq[ti], acc[hf][vi][ti]);
        }
    }
    const float* NQI = wsf(c, WS_NQI);
#pragma unroll
    for (int ti = 0; ti < 4; ++ti) {
        const int t = 64 * wr + 16 * ti + l15; const size_t row = (size_t)(row0 + t);
        const float pmt = fmaxf(mprev, F[F_PM + t]), at = __expf(mprev - pmt);
        const float nq = NQI[row * 4 + h] + at * F[F_QN + t];
        const float inv = 1.f / fmaxf(fabsf(nq), __expf(-(F[F_BT + t] + pmt)));
        float ss = 0.f;
#pragma unroll
        for (int hf = 0; hf < 2; ++hf)
#pragma unroll
            for (int vi = 0; vi < 2; ++vi) {
                const uint2 nw = nip[hf][vi][ti]; const f32x4 ni = (f32x4){bflo(nw.x), bfhi(nw.x), bflo(nw.y), bfhi(nw.y)};
                const f32x4 hv = (ni + acc[hf][vi][ti] * at) * inv;
                acc[hf][vi][ti] = hv; ss += (hv[0] * hv[0] + hv[1] * hv[1]) + (hv[2] * hv[2] + hv[3] * hv[3]);
            }
        ss += __shfl_xor(ss, 16); ss += __shfl_xor(ss, 32);
        if (q4 == 0) F[F_SSP + t * 4 + wc] = ss;
    }
    lds_sync();
    const bf16* OS = wsb(c, WS_OS); bf16* HM = wsb(c, WS_HM);
#pragma unroll
    for (int ti = 0; ti < 4; ++ti) {
        const int t = 64 * wr + 16 * ti + l15; const size_t row = (size_t)(row0 + t);
        const float rs = rsqrtf(((F[F_SSP + t * 4 + 0] + F[F_SSP + t * 4 + 1]) + (F[F_SSP + t * 4 + 2] + F[F_SSP + t * 4 + 3])) * (1.f / DH) + EPS);
#pragma unroll
        for (int hf = 0; hf < 2; ++hf)
#pragma unroll
            for (int vi = 0; vi < 2; ++vi) {
                const int col = h * 256 + 128 * hf + 32 * wc + 16 * vi + 4 * q4;
                const float4 g = *(const float4*)(gmh + col); const uint2 ow = *(const uint2*)(OS + row * 1024 + col);
                const f32x4 hv = acc[hf][vi][ti];
                uint2 w; w.x = pk2(hv[0] * rs * g.x * bflo(ow.x), hv[1] * rs * g.y * bfhi(ow.x)); w.y = pk2(hv[2] * rs * g.z * bflo(ow.y), hv[3] * rs * g.w * bfhi(ow.y));
                *(uint2*)(HM + row * 1024 + col) = w;
            }
    }
    lds_sync();
}

template <bool first, bool has>
DI void mlstm_sample_item(const Ctx& c, unsigned char* lds_, int l, int it, float4 (&Cr)[32], int nxt) {
    LAS float* F = (LAS float*)lds_;
    LAS float* red = F;
    LAS float* qs = F + 2048;
    LAS float* ksm = F + 3072;
    LAS float* nqr = F + 4096;
    const int bs = it >> 2, h = it & 3, row0 = MP + bs * SS, tid = c.tid, kg = c.wave, v0 = c.lane * 4;
    const bf16* Q = wsb(c, WS_Q); const bf16* Kb = wsb(c, WS_K); const bf16* V = wsb(c, WS_V);
    const float* LI = wsf(c, WS_LI); const float* LF = wsf(c, WS_LF); float* Hh = wsf(c, WS_H);
    lds_sync();
    {
        static_assert(NTHR == 512, "two pieces per thread");
        const int i0 = tid, i1 = tid + NTHR;
        const bf16 q0 = Q[(size_t)(row0 + (i0 >> 8)) * 1024 + h * 256 + (i0 & 255)], k0 = Kb[(size_t)(row0 + (i0 >> 8)) * 1024 + h * 256 + (i0 & 255)];
        const bf16 q1 = Q[(size_t)(row0 + (i1 >> 8)) * 1024 + h * 256 + (i1 & 255)], k1 = Kb[(size_t)(row0 + (i1 >> 8)) * 1024 + h * 256 + (i1 & 255)];
        qs[i0] = bf2f(q0); ksm[i0] = bf2f(k0); qs[i1] = bf2f(q1); ksm[i1] = bf2f(k1);
    }
    const float* cn = inptr(I_MC) + ((size_t)l * NBS * NH + nxt) * UNIT_E;
    if (first) {
        const float* c0 = inptr(I_MC) + ((size_t)l * NBS * NH + it) * UNIT_E;
#pragma unroll
        for (int i = 0; i < 32; ++i) { const f32x4 t4 = __builtin_nontemporal_load((const f32x4*)(c0 + (size_t)(kg * 32 + i) * 256 + v0)); Cr[i] = make_float4(t4[0], t4[1], t4[2], t4[3]); }
    }
    float* oc = c.out + O_C_S + (((size_t)l * NBS + bs) * NH + h) * UNIT_E;
    float nval = 0.f; if (tid < 256) nval = inptr(I_MN)[(((size_t)l * NBS + bs) * NH + h) * DH + tid];
    float m = inptr(I_MM)[((size_t)l * NBS + bs) * NH + h];
    lds_sync();
#pragma unroll
    for (int t = 0; t < 4; ++t) {
        const size_t row = (size_t)(row0 + t);
        const float li = LI[row * 4 + h], lf = LF[row * 4 + h];
        const float mn = fmaxf(lf + m, li), fd = __expf(lf + m - mn), iw = __expf(li - mn); m = mn;
        const uint2 vw = *(const uint2*)(V + row * 1024 + h * 256 + v0);
        const float4 vv = make_float4(bflo(vw.x) * iw, bfhi(vw.x) * iw, bflo(vw.y) * iw, bfhi(vw.y) * iw);
        float4 part = make_float4(0.f, 0.f, 0.f, 0.f);
#pragma unroll
        for (int g = 0; g < 8; ++g) {
#pragma unroll
            for (int i = 4 * g; i < 4 * g + 4; ++i) {
                const float kk = ksm[t * 256 + kg * 32 + i], qq = qs[t * 256 + kg * 32 + i];
                Cr[i].x = fd * Cr[i].x + kk * vv.x; Cr[i].y = fd * Cr[i].y + kk * vv.y; Cr[i].z = fd * Cr[i].z + kk * vv.z; Cr[i].w = fd * Cr[i].w + kk * vv.w;
                part.x += qq * Cr[i].x; part.y += qq * Cr[i].y; part.z += qq * Cr[i].z; part.w += qq * Cr[i].w;
            }
            if (t == 3) {
#pragma unroll
                for (int i = 4 * g; i < 4 * g + 4; ++i) { const f32x4 t4 = {Cr[i].x, Cr[i].y, Cr[i].z, Cr[i].w}; __builtin_nontemporal_store(t4, (f32x4*)(oc + (size_t)(kg * 32 + i) * 256 + v0)); }
                asm volatile("" : "+v"(part.x), "+v"(part.y), "+v"(part.z), "+v"(part.w) :: "memory");
                if (has) {
#pragma unroll
                    for (int i = 4 * g; i < 4 * g + 4; ++i) { const f32x4 n4 = __builtin_nontemporal_load((const f32x4*)(cn + (size_t)(kg * 32 + i) * 256 + v0)); Cr[i] = make_float4(n4[0], n4[1], n4[2], n4[3]); }
                }
            }
        }
        lds_stf4(red + kg * 256 + v0, part);
        if (tid < 256) { nval = fd * nval + iw * ksm[t * 256 + tid]; const float pq = wave_sum(qs[t * 256 + tid] * nval); if (c.lane == 0) nqr[c.wave] = pq; }
        lds_sync();
        if (tid < 256) {
            float num = 0.f;
#pragma unroll
            for (int g8 = 0; g8 < 8; ++g8) num += red[g8 * 256 + tid];
            const float nq = (nqr[0] + nqr[1]) + (nqr[2] + nqr[3]);
            Hh[row * 1024 + h * 256 + tid] = num / fmaxf(fabsf(nq), __expf(-m));
        }
        lds_sync();
    }
    if (tid < 256) c.out[O_N_S + (((size_t)l * NBS + bs) * NH + h) * DH + tid] = nval;
    if (tid == 0) c.out[O_M_S + ((size_t)l * NBS + bs) * NH + h] = m;
}

DI void stage_mlstm_A(const Ctx& c, int l, unsigned char* lds) {
    for (int u = c.blk; u < NBP * NH * 16; u += c.nblk) mlstm_A_unit<63>(c, lds, u);
#ifdef PROBE_PARTS
    for (int u = c.blk; u < NBP * NH * 16; u += c.nblk) mlstm_A_unit<PROBE_PARTS>(c, lds, u);
#endif
    if (c.blk < NBS * NH) {
        float4 Cr[32];
        const int it1 = c.blk + c.nblk; const bool has1 = it1 < NBS * NH;
        if (has1) { mlstm_sample_item<true, true>(c, lds, l, c.blk, Cr, it1); mlstm_sample_item<false, false>(c, lds, l, it1, Cr, it1); }
        else mlstm_sample_item<true, false>(c, lds, l, c.blk, Cr, c.blk);
    }
    lds_sync();
}
DI void stage_mlstm_C(const Ctx& c, int l, unsigned char* lds) {
    const float* gmh = inptr(I_GMH) + (size_t)l * MW;
    for (int u = c.blk; u < NBP * NH * 16; u += c.nblk) mlstm_C_unit(c, lds, u, gmh);
}
struct DiagOrder {
    int G, c;
    DI bool next(int i, pg8::Unit& u) const { const int L = i * G + c; if (L >= 128) return false; u.pm = L; u.pn = L >> 2; return true; }
    DI void a_ready(const pg8::Unit&) const {}
    DI void done(const pg8::Unit&) const {}
};
struct EEs5 {
    static constexpr int ID = 9; static constexpr bool NEEDS_RS = false; static constexpr bool PAIRED = false;
    float* ES;
    typedef PF0 PF; DI PF load(int, int) const { return PF0{}; }
    DI const float* ssq_src() const { return nullptr; } DI float pre(int) const { return 0.f; }
    DI float operator()(int row, int col, const float (&a)[8], const float (&)[8], float, const PF&) const {
        const int cl = col & 255;
        if (cl < 128) { float* p = ES + (size_t)row * 128 + cl; *(float4*)p = make_float4(a[0], a[1], a[2], a[3]); *(float4*)(p + 4) = make_float4(a[4], a[5], a[6], a[7]); }
        return 0.f;
    }
};
struct EYs5 {
    static constexpr int ID = 10; static constexpr bool NEEDS_RS = false; static constexpr bool PAIRED = false;
    bf16* YS5;
    typedef PF0 PF; DI PF load(int, int) const { return PF0{}; }
    DI const float* ssq_src() const { return nullptr; } DI float pre(int) const { return 0.f; }
    DI float operator()(int row, int col, const float (&a)[8], const float (&)[8], float, const PF&) const {
        const int cl = col & 255, t = cl >> 4, hh0 = cl & 15, g = row >> 10, b = (row >> 7) & 7, ch = row & 127;
        float o[8];
#pragma unroll
        for (int i = 0; i < 8; ++i) o[i] = gelu_tanh(a[i]);
        *(uint4*)(YS5 + (size_t)(b * SEQ + ch * 16 + t) * 512 + g * 16 + hh0) = pk8(o);
        return 0.f;
    }
};
template <class F>
DI void gemm_diag(const Ctx& c, unsigned char* lds, const bf16* A, int lda, const bf16* Bt, int ldb, int K, const F& f) {
    pg8::Gemm g{A, Bt, 32768, 8192, K, lda, ldb};
    DiagOrder S{c.nblk, c.blk};
    EpiA<F> E{f, nullptr};
    pg8::gemm_phase<EpiA<F>, DiagOrder, true, true>((PG8_LAS unsigned char*)lds, g, S, E, c.tid);
}

DI void s5_build_item(const Ctx& c, unsigned char* lds_, int item) {
    LAS float* PWr = (LAS float*)lds_;
    LAS float* PWi = PWr + 17 * 64;
    LAS float* BBr = PWi + 17 * 64;
    LAS float* BBi = BBr + 1024;
    LAS float* CCr = BBi + 1024;
    LAS float* CCi = CCr + 1024;
    LAS float* KT = CCi + 1024;
    const int half = item & 1, l = item >> 6, g = (item >> 1) & 31, tid = c.tid;
    __syncthreads();
    if (tid < 64) {
        const int n = tid;
        const float lre = inptr(I_LRE)[((size_t)l * NG + g) * NST + n], lim = inptr(I_LIM)[((size_t)l * NG + g) * NST + n];
        const float dt = expf(inptr(I_LDT)[l * NG + g]);
        for (int tau = 0; tau <= 16; ++tau) { const float mag = expf((float)tau * lre * dt), th = (float)tau * (lim * dt); PWr[tau * 64 + n] = mag * cosf(th); PWi[tau * 64 + n] = mag * sinf(th); }
        const float mag = expf(lre * dt), ar = mag * cosf(lim * dt), ai = mag * sinf(lim * dt);
        const float den = lre * lre + lim * lim, pr = ar - 1.f;
        const float wre = (pr * lre + ai * lim) / den, wim = (ai * lre - pr * lim) / den;
        const float* bre = inptr(I_BRE) + (((size_t)l * NG + g) * NST + n) * 16; const float* bim = inptr(I_BIM) + (((size_t)l * NG + g) * NST + n) * 16;
        for (int j = 0; j < 16; ++j) { const float r = bre[j], i = bim[j]; BBr[n * 16 + j] = wre * r - wim * i; BBi[n * 16 + j] = wre * i + wim * r; }
    }
    for (int idx = tid; idx < 1024; idx += NTHR) { CCr[idx] = inptr(I_CRE)[((size_t)l * NG + g) * 1024 + idx]; CCi[idx] = inptr(I_CIM)[((size_t)l * NG + g) * 1024 + idx]; }
    __syncthreads();
    if (half == 0) for (int idx = tid; idx < 4096; idx += NTHR) {
        const int tau = idx >> 8, hh = (idx >> 4) & 15, j = idx & 15; float s = 0.f;
        for (int n = 0; n < 64; ++n) {
            const float cr = CCr[hh * 64 + n], ci = CCi[hh * 64 + n], pr = PWr[tau * 64 + n], pi = PWi[tau * 64 + n];
            const float xr = cr * pr - ci * pi, xi = cr * pi + ci * pr;
            s += xr * BBr[n * 16 + j] - xi * BBi[n * 16 + j];
        }
        KT[idx] = s;
    }
    __syncthreads();
    bf16* Km = wsb(c, WS_S5K) + ((size_t)l * 8192 + (size_t)g * 256) * 384;
    bf16* Em = wsb(c, WS_S5E) + ((size_t)l * 8192 + (size_t)g * 256) * 256;
    const float* dsk = inptr(I_S5D) + (size_t)l * S5W + g * 16;
    for (int idx = tid + (half ? 256 * 32 : 0); idx < (half ? 256 * 48 : 256 * 32); idx += NTHR) {
        const int r = idx & 255, chn = idx >> 8, t = r >> 4, hh = r & 15, kk0 = chn * 8; float v[8];
        if (kk0 < 256) {
            const int s = kk0 >> 4, j0 = kk0 & 15;
#pragma unroll
            for (int i = 0; i < 8; ++i) { float x = 0.f; if (s <= t) { x = KT[((t - s) * 16 + hh) * 16 + j0 + i]; if (s == t && j0 + i == hh) x += dsk[hh]; } v[i] = x; }
        } else {
            const int n0 = (kk0 - 256) & 63; const bool im = (kk0 - 256) >= 64;
#pragma unroll
            for (int i = 0; i < 8; ++i) { const int n = n0 + i; const float cr = CCr[hh * 64 + n], ci = CCi[hh * 64 + n], pr = PWr[(t + 1) * 64 + n], pi = PWi[(t + 1) * 64 + n]; v[i] = im ? -(cr * pi + ci * pr) : (cr * pr - ci * pi); }
        }
        *(uint4*)(Km + (size_t)r * 384 + kk0) = pk8(v);
    }
    if (half == 1) for (int idx = tid; idx < 256 * 32; idx += NTHR) {
        const int r = idx >> 5, chn = idx & 31, kk0 = chn * 8, s = kk0 >> 4, j0 = kk0 & 15; float v[8];
#pragma unroll
        for (int i = 0; i < 8; ++i) {
            float x = 0.f;
            if (r < 128) { const int n = r & 63; const float pr = PWr[(15 - s) * 64 + n], pi = PWi[(15 - s) * 64 + n], br = BBr[n * 16 + j0 + i], bi = BBi[n * 16 + j0 + i]; x = (r < 64) ? (pr * br - pi * bi) : (pr * bi + pi * br); }
            v[i] = x;
        }
        *(uint4*)(Em + (size_t)r * 256 + kk0) = pk8(v);
    }
}
DI void stage_s5_build(const Ctx& c, unsigned char* lds) { for (int it = c.blk; it < NL * NG * 2; it += c.nblk) s5_build_item(c, lds, it); __syncthreads(); }

DI void stage_s5_carry(const Ctx& c, int l, unsigned char* lds_) {
    const float* __restrict__ ES = wsf(c, WS_ES); bf16* __restrict__ UP = wsb(c, WS_UP);
    LAS float* segr = (LAS float*)lds_; LAS float* segi = segr + 512;
    for (int it = c.blk; it < NBP * NG; it += c.nblk) {
        const int b = it >> 5, g = it & 31, n = c.lane, w = c.wave;
        const float lre = inptr(I_LRE)[((size_t)l * NG + g) * NST + n], lim = inptr(I_LIM)[((size_t)l * NG + g) * NST + n];
        const float dt = expf(inptr(I_LDT)[l * NG + g]);
        const float m16 = expf(16.f * lre * dt), t16 = 16.f * (lim * dt), ar = m16 * cosf(t16), ai = m16 * sinf(t16);
        const float m256 = expf(256.f * lre * dt), t256 = 256.f * (lim * dt), Ar = m256 * cosf(t256), Ai = m256 * sinf(t256);
        const size_t rbase = (size_t)g * 1024 + (size_t)b * 128 + (size_t)w * 16;
        float er[16], ei[16];
#pragma unroll
        for (int j = 0; j < 16; ++j) { er[j] = ES[(rbase + j) * 128 + n]; ei[j] = ES[(rbase + j) * 128 + 64 + n]; }
        float pr[16], pi[16]; float hr = 0.f, hi = 0.f;
#pragma unroll
        for (int j = 0; j < 16; ++j) { pr[j] = hr; pi[j] = hi; const float nr = ar * hr - ai * hi + er[j], ni = ar * hi + ai * hr + ei[j]; hr = nr; hi = ni; }
        lds_sync();
        segr[w * 64 + n] = hr; segi[w * 64 + n] = hi;
        lds_sync();
        float sr = 0.f, si = 0.f;
        for (int ww = 0; ww < w; ++ww) { const float nr = Ar * sr - Ai * si + segr[ww * 64 + n], ni = Ar * si + Ai * sr + segi[ww * 64 + n]; sr = nr; si = ni; }
        float qr = 1.f, qi = 0.f;
#pragma unroll
        for (int j = 0; j < 16; ++j) {
            const float xr = pr[j] + (qr * sr - qi * si), xi = pi[j] + (qr * si + qi * sr);
            UP[(rbase + j) * 384 + 256 + n] = (bf16)f2bf(xr); UP[(rbase + j) * 384 + 320 + n] = (bf16)f2bf(xi);
            const float tr = qr * ar - qi * ai, ti = qr * ai + qi * ar; qr = tr; qi = ti;
        }
        if (w == 7) {
            c.out[O_S5RE_P + (((size_t)l * NBP + b) * NG + g) * NST + n] = hr + (qr * sr - qi * si);
            c.out[O_S5IM_P + (((size_t)l * NBP + b) * NG + g) * NST + n] = hi + (qr * si + qi * sr);
        }
    }
    lds_sync();
}
#ifndef MULTI_LAUNCH
#define MULTI_LAUNCH 0
#endif
#if FAST_GEMM
#ifndef ONLY_EPI
#define ONLY_EPI 0
#endif
#ifndef THIN_SAMPLE
#define THIN_SAMPLE 1
#endif
#define RUN_GEMM(A_, lda_, Bt_, ldb_, M_, Nc_, K_, e_, ssq_) do { if constexpr (ONLY_EPI == 0 || decltype(e_)::ID == ONLY_EPI) { \
    if (!(((PROBE_MASK >> 27) & 1) && rep_ == 1)) gemm_fast(c, lds, A_, lda_, Bt_, (ldb_) + PADK, ((THIN_SAMPLE && (Nc_) != INN && (Nc_) != 512) ? MP : (M_)), (e_.PAIRED ? 2 * (Nc_) : (Nc_)), K_, e_, ssq_); \
    if (THIN_SAMPLE && (Nc_) != INN && (Nc_) != 512 && !(((PROBE_MASK >> 26) & 1) && rep_ == 1)) for (int r_ = 0; r_ < ((((PROBE_MASK >> 20) & 1) && (decltype(e_)::ID == 1 || decltype(e_)::ID == 3 || decltype(e_)::ID == 4)) ? 3 : 1); ++r_) { \
        if (e_.PAIRED) gemm_thin<decltype(e_), 4, 1, 2, 1>(c, lds, (A_) + (size_t)MP * (lda_), lda_, Bt_, (ldb_) + PADK, Nc_, K_, e_, ssq_); \
        else if ((Nc_) == INN) gemm_thin<decltype(e_), 4, 2, 2, 1>(c, lds, (A_) + (size_t)MP * (lda_), lda_, Bt_, (ldb_) + PADK, Nc_, K_, e_, ssq_); \
        else gemm_thin<decltype(e_), 2, 1, 2, 2>(c, lds, (A_) + (size_t)MP * (lda_), lda_, Bt_, (ldb_) + PADK, Nc_, K_, e_, ssq_); } } } while (0)
#define SSQ_PHASE(p_)
constexpr int PH_PER_LAYER = 11 + (FAST_MLSTM ? 1 : 0);
#else
#define RUN_GEMM(A_, lda_, Bt_, ldb_, M_, Nc_, K_, e_, ssq_) gemm_ref(c, A_, lda_, Bt_, (ldb_) + PADK, M_, Nc_, K_, e_, ssq_)
#define SSQ_PHASE(p_) PH_BEGIN(0) stage_ssq(c, p_, XB); PH_END
constexpr int PH_PER_LAYER = 15 + (FAST_MLSTM ? 1 : 0);
#endif
constexpr int PH_TOTAL = 1 + NL * PH_PER_LAYER + 1;

__global__ void __launch_bounds__(NTHR, 2) fwd(Args args) {
    extern __shared__ __attribute__((aligned(16))) unsigned char lds[];
#define MKCTX Ctx c; { int ln_; asm volatile("v_mbcnt_lo_u32_b32 %0, -1, 0\n\tv_mbcnt_hi_u32_b32 %0, -1, %0" : "=v"(ln_)); int ws_ = wave_s; asm volatile("" : "+s"(ws_)); \
    { int z_ = 0; asm volatile("" : "+s"(z_)); c.out = args.out + z_; c.ws = args.ws + z_; }     \
    c.tid = ws_ * 64 + ln_; c.lane = ln_; c.wave = ws_; \
    { int b_ = blockIdx.x; asm volatile("" : "+s"(b_)); c.blk = b_; } c.nblk = gridDim.x; c.gtid = c.blk * NTHR + c.tid; c.gthreads = c.nblk * NTHR; c.gwave = c.blk + c.nblk * c.wave; c.gwaves = c.nblk * NWV; }
    volatile LAS unsigned* MISC = (volatile LAS unsigned*)((LAS unsigned char*)lds + MISC_OFF);
    const int wave_s = __builtin_amdgcn_readfirstlane(threadIdx.x >> 6);
    if (threadIdx.x < 32) MISC[threadIdx.x] = 0u;
    __syncthreads();
    if (!MULTI_LAUNCH) (void)xcd_barrier_post((unsigned*)(args.ws + WS_BAR), MISC + 8, threadIdx.x == 0);
    const int lo = args.lo, hi = args.hi;
    int gp = 0;
#ifndef PROBE_MASK
#define PROBE_MASK 0
#endif
#define PH_BEGIN(id_) if (lo <= gp && gp < hi) { for (int rep_ = 0; rep_ < (((PROBE_MASK >> (id_)) & 1) ? 2 : 1); ++rep_) { { MKCTX LAYER_PTRS
#define PH_FRESH } { MKCTX LAYER_PTRS
#define PH_END   } if (gp + 1 < hi) { MKCTX XcdBarrier b_; b_.bar = (unsigned*)(c.ws + WS_BAR); b_.x = xb_xcc_id(); b_.st = (volatile LAS unsigned*)((LAS unsigned char*)lds + MISC_OFF) + 8; xcd_barrier(b_, c.tid == 0); } } } ++gp;

#define LAYER_PTRS
    PH_BEGIN(1) stage_prologue(args, c, lds);
#if FAST_S5
    PH_FRESH stage_s5_build(c, lds);
#endif
    PH_END
#undef LAYER_PTRS
#define LAYER_PTRS unsigned char* lw = c.ws + WS_W + (size_t)l * LW_STRIDE; bf16* XB = (bf16*)(c.ws + ((l & 1) ? WS_XB2 : WS_XB)); bf16* XBn = (bf16*)(c.ws + ((l & 1) ? WS_XB : WS_XB2)); float* X = (float*)(c.ws + WS_X); (void)lw; (void)XB; (void)XBn; (void)X;

    for (int l = 0; l < NL; ++l) {
        PH_BEGIN(2) { ESwiGLU e{ssq_ptr(c, 4 * l + 0), wsb(c, WS_ACT)}; RUN_GEMM(XB, D, (const bf16*)(lw + LW_W1GU), D, M, FF, D, e, nullptr); } PH_END
        PH_BEGIN(3) { EResid e{XB, XB, rep_ ? 0.f : 0.5f}; RUN_GEMM(wsb(c, WS_ACT), FF, (const bf16*)(lw + LW_W1D), FF, M, D, FF, e, ssq_ptr(c, 4 * l + 1)); } PH_END
        SSQ_PHASE(ssq_ptr(c, 4 * l + 1))
        PH_BEGIN(4) { EWin e{ssq_ptr(c, 4 * l + 1), wsb(c, WS_UP), wsb(c, WS_US), wsb(c, WS_QKR), wsb(c, WS_V), wsb(c, WS_OS)};
                   RUN_GEMM(XB, D, (const bf16*)(lw + LW_WIN), D, M, INN, D, e, nullptr); } PH_END
        PH_BEGIN(5)
#if FAST_S5
                 { EEs5 e{wsf(c, WS_ES)}; gemm_diag(c, lds, wsb(c, WS_UP), 384, wsb(c, WS_S5E) + (size_t)l * 8192 * 256, 256, 256, e); }
        PH_FRESH
#endif
                 stage_conv(args, c, l); stage_gates(args, c, l, ssq_ptr(c, 4 * l + 1), XB); PH_END
#if FAST_MLSTM
        PH_BEGIN(6) stage_mlstm_A(c, l, lds);
#if FAST_S5
        PH_FRESH for (int r_ = 0; r_ < (((PROBE_MASK >> 23) & 1) ? 2 : 1); ++r_) stage_s5_carry(c, l, lds);
#endif
        PH_FRESH stage_s5_sample(args, c, l, lds); PH_END
        PH_BEGIN(7)
#if FAST_S5
                 { EYs5 e{wsb(c, WS_YS5)}; gemm_diag(c, lds, wsb(c, WS_UP), 384, wsb(c, WS_S5K) + (size_t)l * 8192 * 384, 384, 384, e); }
        PH_FRESH
#endif
                 mlstm_B(c, l, lds); PH_END
        PH_BEGIN(8) stage_mlstm_C(c, l, lds); stage_headnorm(args, c, l, MP);
#else
        PH_BEGIN(9) stage_mlstm_ref(args, c, l, lds); stage_s5_ref(args, c, l, lds); PH_END
        PH_BEGIN(10) stage_headnorm(args, c, l, 0);
#endif
                 { EGlu e{wsb(c, WS_YS5), wsb(c, WS_YG)}; RUN_GEMM(wsb(c, WS_YS5), 512, (const bf16*)(lw + LW_WGLU), 512, M, 512, 512, e, nullptr); } PH_END
        PH_BEGIN(11) { ET5 e{wsb(c, WS_GS5), wsb(c, WS_T5)}; RUN_GEMM(wsb(c, WS_YG), 512, (const bf16*)(lw + LW_WS5UP), 512, M, D, 512, e, nullptr); }
                 { EMerged e{wsb(c, WS_T5), wsb(c, WS_GM), wsb(c, WS_MRG)}; RUN_GEMM(wsb(c, WS_HM), 1024, (const bf16*)(lw + LW_WMUP), 1024, M, D, 1024, e, nullptr); } PH_END
        PH_BEGIN(12) { EResid e{XB, XB, rep_ ? 0.f : 1.0f}; RUN_GEMM(wsb(c, WS_MRG), 1024, (const bf16*)(lw + LW_WOUT), 1024, M, D, 1024, e, ssq_ptr(c, 4 * l + 2)); } PH_END
        SSQ_PHASE(ssq_ptr(c, 4 * l + 2))
        PH_BEGIN(13) { ESwiGLU e{ssq_ptr(c, 4 * l + 2), wsb(c, WS_ACT)}; RUN_GEMM(XB, D, (const bf16*)(lw + LW_W2GU), D, M, FF, D, e, nullptr); } PH_END
        PH_BEGIN(14) { EResid e{XB, XB, rep_ ? 0.f : 0.5f}; RUN_GEMM(wsb(c, WS_ACT), FF, (const bf16*)(lw + LW_W2D), FF, M, D, FF, e, ssq_ptr(c, 4 * l + 3)); } PH_END
        SSQ_PHASE(ssq_ptr(c, 4 * l + 3))
        PH_BEGIN(15) { EGate e{ssq_ptr(c, 4 * l + 3), wsb(c, WS_GT)}; RUN_GEMM(XB, D, (const bf16*)(lw + LW_WPG), D, M, D, D, e, nullptr); }
                 { EPle e{XB, XBn, wsb(c, WS_GT), rep_ ? 0.f : 1.f}; RUN_GEMM(wsb(c, WS_PB) + (size_t)l * M * DPLE, DPLE, (const bf16*)(lw + LW_WPLE), DPLE, M, D, DPLE, e, ssq_ptr(c, 4 * l + 4)); } PH_END
        SSQ_PHASE(ssq_ptr(c, 4 * l + 4))
    }
#undef LAYER_PTRS
#define LAYER_PTRS
    PH_BEGIN(16) stage_final(args, c, wsb(c, (NL & 1) ? WS_XB2 : WS_XB)); PH_END
#undef LAYER_PTRS
#undef PH_BEGIN
#undef PH_END
}

extern "C" void kernel_launch(void* const* d_in, const int* in_sizes, int n_in, void* d_out, int out_size, void* d_ws, size_t ws_size, hipStream_t stream) {
    static int grid = 0;
    if (grid == 0) {
        if (n_in != N_IN || (size_t)out_size != O_END || ws_size < WS_END) { fprintf(stderr, "kernel_launch: unexpected shapes (n_in %d, out %d, ws %zu)\n", n_in, out_size, ws_size); grid = -1; return; }
        int dev = 0, cus = 0, per_cu = 0;
        if (hipGetDevice(&dev) != hipSuccess || hipDeviceGetAttribute(&cus, hipDeviceAttributeMultiprocessorCount, dev) != hipSuccess) { grid = -1; return; }
        if (hipFuncSetAttribute((const void*)fwd, hipFuncAttributeMaxDynamicSharedMemorySize, LDS_BYTES) != hipSuccess) { fprintf(stderr, "kernel_launch: hipFuncSetAttribute failed\n"); grid = -1; return; }
        if (hipOccupancyMaxActiveBlocksPerMultiprocessor(&per_cu, (const void*)fwd, NTHR, LDS_BYTES) != hipSuccess || per_cu < 1) { fprintf(stderr, "kernel_launch: occupancy query says %d\n", per_cu); per_cu = 1; }
        (void)hipGetLastError();
        if (2 * cus < NBS * NH) { fprintf(stderr, "kernel_launch: %d CUs, the sample-state stream is written for >= %d workgroups\n", cus, NBS * NH / 2); grid = -1; return; }
        grid = cus;
    }
    if (grid < 0) return;
    (void)hipMemsetAsync((char*)d_ws + WS_ZERO, 0, ZERO_BYTES, stream);
    Args a{};
    for (int i = 0; i < N_IN; ++i) a.in[i] = (const float*)d_in[i];
    a.out = (float*)d_out; a.ws = (unsigned char*)d_ws;
#if MULTI_LAUNCH
    for (int p = 0; p < PH_TOTAL; ++p) { a.lo = p; a.hi = p + 1; hipLaunchKernelGGL(fwd, dim3(grid), dim3(NTHR), LDS_BYTES, stream, a); }
#else
    a.lo = 0; a.hi = PH_TOTAL;
    hipLaunchKernelGGL(fwd, dim3(grid), dim3(NTHR), LDS_BYTES, stream, a);
#endif
    const hipError_t le = hipPeekAtLastError();
    if (le != hipSuccess) fprintf(stderr, "kernel_launch: launch failed: %s\n", hipGetErrorName(le));
}
```
